# Optimizing an MI355X kernel written in HIP

```python
import jax, jax.numpy as jnp
from jax import lax
import numpy as np

D_MODEL = 1024
BATCH = 8
SEQ = 8192
DEPTH = 2

GRID_W = 64
CTX_LEN = 256
EPS = 1e-6
CHUNK = 64

A_HEADS = 4
A_DK = 64
A_DV = 128
A_RANK = 16
GATE_TAU = 16.0
B_HEADS = 4
B_DK = 128
B_DV = 128
N_B_LAYERS = (DEPTH + 1) // 2
C_HEADS = 4
C_DK = 128
C_DV = 128
CONV_W = 5
D_HEADS = 8
D_KV_HEADS = 2
D_HD = 64
WINDOW = 128
WBLK = 128
ROPE_BASE = 10000.0
N_EXPERTS = 32
TOP_K = 4
D_FF = 1024
SWIGLU_LIMIT = 7.0
SWIGLU_ALPHA = 1.702

EVEN_SPLITS = (A_HEADS * A_DK, A_HEADS * A_DK, A_HEADS * A_DV, A_RANK, A_RANK, A_HEADS * A_DV,
               B_HEADS * B_DK, B_HEADS * B_DK, B_HEADS * B_DK, B_HEADS * B_DV, B_HEADS * B_DV)
ODD_SPLITS = (C_HEADS * C_DK, C_HEADS * C_DK, C_HEADS * C_DV, C_HEADS, C_HEADS, C_HEADS, C_HEADS,
              C_HEADS * C_DV, D_HEADS * D_HD, D_KV_HEADS * D_HD, D_KV_HEADS * D_HD)
EVEN_IN = sum(EVEN_SPLITS)
ODD_IN = sum(ODD_SPLITS)
EVEN_MIX = A_HEADS * A_DV + B_HEADS * B_DV
ODD_MIX = C_HEADS * C_DV + D_HEADS * D_HD

kernel_name = 'hybrid_gla_hgrn2_deltanet_swa_moe_dit'


def rms_norm(x, w):
    xf = x.astype(jnp.float32)
    y = xf * lax.rsqrt(jnp.mean(xf * xf, axis=-1, keepdims=True) + EPS)
    return (y * w.astype(jnp.float32)).astype(x.dtype)


def modulate(h, shift, scale):
    return h * (1.0 + scale) + shift


def split_cols(h, sizes):
    return jnp.split(h, np.cumsum(sizes)[:-1].tolist(), axis=-1)


def heads(x, n):
    B, T, _ = x.shape
    return x.reshape(B, T, n, -1).transpose(0, 2, 1, 3)


def merge_heads(x):
    B, n, T, d = x.shape
    return x.transpose(0, 2, 1, 3).reshape(B, T, n * d)


def l2_normalize(x):
    return x * lax.rsqrt(jnp.sum(x * x, axis=-1, keepdims=True) + EPS)


def gated_head_norm(o, w, og):
    o = o * lax.rsqrt(jnp.mean(o * o, axis=-1, keepdims=True) + EPS) * w.astype(jnp.float32)
    return merge_heads(o) * jax.nn.silu(og)


def axial_rope(T):
    rows = T // GRID_W
    row = jnp.repeat(jnp.arange(rows, dtype=jnp.float32), GRID_W)
    col = jnp.tile(jnp.arange(GRID_W, dtype=jnp.float32), rows)
    n_freq = D_HD // 4
    inv = ROPE_BASE ** (-jnp.arange(n_freq, dtype=jnp.float32) / n_freq)
    ang = jnp.concatenate([row[:, None] * inv, col[:, None] * inv], axis=-1)
    return jnp.cos(ang), jnp.sin(ang)


def apply_rope(x, cos, sin):
    x1, x2 = jnp.split(x, 2, axis=-1)
    return jnp.concatenate([x1 * cos - x2 * sin, x2 * cos + x1 * sin], axis=-1)


def centred_conv(x, w):
    pad = CONV_W // 2
    return lax.conv_general_dilated(x, w[:, None, :].astype(x.dtype), window_strides=(1,),
                                    padding=[(pad, pad)], dimension_numbers=('NWC', 'WIO', 'NWC'),
                                    feature_group_count=x.shape[-1])


def chunked_gated_scan(q, k, v, log_f, s0, with_output):
    B, H, T, dk = q.shape
    n = T // CHUNK

    def to_chunks(a):
        return jnp.moveaxis(a.reshape(B, H, n, CHUNK, a.shape[-1]), 2, 0)

    incl = jnp.tril(jnp.ones((CHUNK, CHUNK), dtype=bool))[:, :, None]

    def step(S, inp):
        qc, kc, vc, fc = inp
        b = jnp.cumsum(fc, axis=-2)
        b_last = b[..., -1, :]
        o = None
        if with_output:
            diff = b[..., :, None, :] - b[..., None, :, :]
            decay = jnp.where(incl, jnp.exp(jnp.where(incl, diff, 0.0)), 0.0)
            scores = jnp.einsum('bhtk,bhsk,bhtsk->bhts', qc, kc, decay)
            o = (jnp.einsum('bhtk,bhkv->bhtv', qc * jnp.exp(b), S)
                 + jnp.einsum('bhts,bhsv->bhtv', scores, vc))
        S = (jnp.exp(b_last)[..., None] * S
             + jnp.einsum('bhsk,bhsv->bhkv', kc * jnp.exp(b_last[..., None, :] - b), vc))
        return S, o

    S, o = lax.scan(step, s0, (to_chunks(q), to_chunks(k), to_chunks(v), to_chunks(log_f)))
    if with_output:
        o = jnp.moveaxis(o, 0, 2).reshape(B, H, T, -1)
    return S, o


def chunked_delta_scan(q, k, v, g, beta, s0, with_output):
    B, H, T, dk = q.shape
    n = T // CHUNK
    q, k, v = [a.reshape(B, H, n, CHUNK, a.shape[-1]) for a in (q, k, v)]
    g = g.reshape(B, H, n, CHUNK)
    beta = beta.reshape(B, H, n, CHUNK)
    gam = jnp.cumsum(g, axis=-1)
    incl = jnp.tril(jnp.ones((CHUNK, CHUNK), dtype=bool))
    strict = jnp.tril(jnp.ones((CHUNK, CHUNK), dtype=bool), -1)
    diff = gam[..., :, None] - gam[..., None, :]
    L = jnp.where(incl, jnp.exp(jnp.where(incl, diff, 0.0)), 0.0)
    kb = k * beta[..., None]
    a_mat = jnp.where(strict, jnp.einsum('bhntk,bhnsk->bhnts', kb, k) * L, 0.0)
    eye = jnp.eye(CHUNK, dtype=q.dtype)
    t_inv = lax.linalg.triangular_solve(a_mat + eye, jnp.broadcast_to(eye, a_mat.shape),
                                        left_side=True, lower=True, unit_diagonal=True)
    u = jnp.einsum('bhnts,bhnsv->bhntv', t_inv, v * beta[..., None])
    w = jnp.einsum('bhnts,bhnsk->bhntk', t_inv, kb * jnp.exp(gam)[..., None])

    def step(S, inp):
        qc, kc, uc, wc, gc, Lc = inp
        v_new = uc - jnp.einsum('bhtk,bhkv->bhtv', wc, S)
        o = None
        if with_output:
            scores = jnp.einsum('bhtk,bhsk->bhts', qc, kc) * Lc
            o = (jnp.einsum('bhtk,bhkv->bhtv', qc * jnp.exp(gc)[..., None], S)
                 + jnp.einsum('bhts,bhsv->bhtv', scores, v_new))
        g_last = gc[..., -1]
        S = (jnp.exp(g_last)[..., None, None] * S
             + jnp.einsum('bhsk,bhsv->bhkv', kc * jnp.exp(g_last[..., None] - gc)[..., None], v_new))
        return S, o

    xs = tuple(jnp.moveaxis(a, 2, 0) for a in (q, k, u, w, gam, L))
    S, o = lax.scan(step, s0, xs)
    if with_output:
        o = jnp.moveaxis(o, 0, 2).reshape(B, H, T, -1)
    return S, o


def flip_t(a):
    return jnp.flip(a, axis=2)


def bidirectional(scan_fn, ctx_fwd, ctx_bwd, lat_fwd, lat_bwd, s0, ctx_out):
    sc_f, oc_f = scan_fn(*ctx_fwd, s0, ctx_out)
    _, ox_f = scan_fn(*lat_fwd, sc_f, True)
    sc_b, oc_b = scan_fn(*[flip_t(a) for a in ctx_bwd], s0, ctx_out)
    _, ox_b = scan_fn(*[flip_t(a) for a in lat_bwd], sc_b, True)
    ox = ox_f + flip_t(ox_b)
    oc = oc_f + flip_t(oc_b) if ctx_out else None
    return oc, ox


def window_attention(q, k, v, kc, vc, sinks):
    B, KVH, G, T, d = q.shape
    nb = T // WBLK
    qb = q.reshape(B, KVH, G, nb, WBLK, d)

    def band(a):
        ap = jnp.pad(a, ((0, 0), (0, 0), (WBLK, WBLK), (0, 0))).reshape(B, KVH, nb + 2, WBLK, d)
        return jnp.concatenate([ap[:, :, :-2], ap[:, :, 1:-1], ap[:, :, 2:]], axis=3)

    kband, vband = band(k), band(v)
    qpos = jnp.arange(WBLK)
    kpos = jnp.arange(3 * WBLK) - WBLK
    rel = kpos[None, :] - qpos[:, None]
    abs_k = (jnp.arange(nb) * WBLK)[:, None] + kpos[None, :]
    valid = ((jnp.abs(rel) <= WINDOW)[None]
             & ((abs_k >= 0) & (abs_k < T))[:, None, :])
    scale = d ** -0.5
    s_loc = jnp.einsum('bhgnqd,bhnkd->bhgnqk', qb, kband) * scale
    s_loc = jnp.where(valid, s_loc, -jnp.inf)
    s_ctx = jnp.einsum('bhgnqd,bhcd->bhgnqc', qb, kc) * scale
    sink = jnp.broadcast_to(sinks.astype(jnp.float32).reshape(KVH, G)[None, :, :, None, None, None],
                            (B, KVH, G, nb, WBLK, 1))
    p = jax.nn.softmax(jnp.concatenate([sink, s_loc, s_ctx], axis=-1), axis=-1)
    p_loc = p[..., 1:1 + 3 * WBLK]
    p_ctx = p[..., 1 + 3 * WBLK:]
    out = (jnp.einsum('bhgnqk,bhnkd->bhgnqd', p_loc, vband)
           + jnp.einsum('bhgnqc,bhcd->bhgnqd', p_ctx, vc))
    return out.reshape(B, KVH, G, T, d)


def context_attention(q, k, v, sinks):
    B, KVH, G, Tc, d = q.shape
    s = jnp.einsum('bhgqd,bhkd->bhgqk', q, k) * d ** -0.5
    sink = jnp.broadcast_to(sinks.astype(jnp.float32).reshape(KVH, G)[None, :, :, None, None],
                            (B, KVH, G, Tc, 1))
    p = jax.nn.softmax(jnp.concatenate([sink, s], axis=-1), axis=-1)
    return jnp.einsum('bhgqk,bhkd->bhgqd', p[..., 1:], v)


def mixer_gla_hgrn(hc, hx, ctx_out, w_in, w_out, gla_w2_f, gla_b_f, gla_w2_b, gla_b_b,
                   gla_norm_w, hgrn_norm_w, lb):
    f32 = jnp.float32
    lb = lb.astype(f32)

    def prep(h):
        parts = [p_.astype(f32) for p_ in split_cols(h @ w_in, EVEN_SPLITS)]
        aq, ak, av, ar_f, ar_b, aog, bq, bz_f, bz_b, bi, bog = parts
        aq = heads(aq, A_HEADS) * A_DK ** -0.5
        ak = heads(ak, A_HEADS)
        av = heads(av, A_HEADS)

        def a_dir(r, w2, b2):
            log_a = jax.nn.log_sigmoid(r @ w2.astype(f32) + b2.astype(f32)) / GATE_TAU
            return (aq, ak, av, heads(log_a, A_HEADS))

        bq = heads(bq, B_HEADS)
        bi = heads(bi, B_HEADS)

        def b_dir(z):
            log_f = jnp.logaddexp(jnp.log(lb), jnp.log1p(-lb) + jax.nn.log_sigmoid(z))
            key = (1.0 - lb) * jax.nn.sigmoid(-z)
            return (bq, heads(key, B_HEADS), bi, heads(log_f, B_HEADS))

        return (a_dir(ar_f, gla_w2_f, gla_b_f), a_dir(ar_b, gla_w2_b, gla_b_b),
                b_dir(bz_f), b_dir(bz_b), aog, bog)

    ca_f, ca_b, cb_f, cb_b, c_aog, c_bog = prep(hc)
    xa_f, xa_b, xb_f, xb_b, x_aog, x_bog = prep(hx)
    B = hx.shape[0]
    sa0 = jnp.zeros((B, A_HEADS, A_DK, A_DV), f32)
    sb0 = jnp.zeros((B, B_HEADS, B_DK, B_DV), f32)
    oc_a, ox_a = bidirectional(chunked_gated_scan, ca_f, ca_b, xa_f, xa_b, sa0, ctx_out)
    oc_b, ox_b = bidirectional(chunked_gated_scan, cb_f, cb_b, xb_f, xb_b, sb0, ctx_out)

    def readout(oa, ob, aog, bog, dtype):
        y = jnp.concatenate([gated_head_norm(oa, gla_norm_w, aog),
                             gated_head_norm(ob, hgrn_norm_w, bog)], axis=-1)
        return y.astype(dtype) @ w_out

    yx = readout(ox_a, ox_b, x_aog, x_bog, hx.dtype)
    yc = readout(oc_a, oc_b, c_aog, c_bog, hc.dtype) if ctx_out else None
    return yc, yx


def mixer_delta_swa(hc, hx, ctx_out, w_in, w_out, conv_w, a_log_f, dt_bias_f, a_log_b, dt_bias_b,
                    dn_norm_w, sinks, cos, sin):
    f32 = jnp.float32

    def prep(h, rope):
        cq, ck, cv, bt_f, bt_b, a_f, a_b, og, dq, dk, dv = split_cols(h @ w_in, ODD_SPLITS)
        qkv = jax.nn.silu(centred_conv(jnp.concatenate([cq, ck, cv], axis=-1), conv_w)).astype(f32)
        cq, ck, cv = split_cols(qkv, (C_HEADS * C_DK, C_HEADS * C_DK, C_HEADS * C_DV))
        cq = l2_normalize(heads(cq, C_HEADS)) * C_DK ** -0.5
        ck = l2_normalize(heads(ck, C_HEADS))
        cv = heads(cv, C_HEADS)

        def c_dir(bt, a, a_log, dt_bias):
            g = -jnp.exp(a_log.astype(f32)) * jax.nn.softplus(a.astype(f32) + dt_bias.astype(f32))
            beta = jax.nn.sigmoid(bt.astype(f32))
            return (cq, ck, cv, g.transpose(0, 2, 1), beta.transpose(0, 2, 1))

        dq = heads(dq.astype(f32), D_HEADS)
        dk = heads(dk.astype(f32), D_KV_HEADS)
        dv = heads(dv.astype(f32), D_KV_HEADS)
        if rope:
            dq = apply_rope(dq, cos, sin)
            dk = apply_rope(dk, cos, sin)
        B, _, T, _ = dq.shape
        dq = dq.reshape(B, D_KV_HEADS, D_HEADS // D_KV_HEADS, T, D_HD)
        return (c_dir(bt_f, a_f, a_log_f, dt_bias_f), c_dir(bt_b, a_b, a_log_b, dt_bias_b),
                og.astype(f32), dq, dk, dv)

    cc_f, cc_b, c_og, c_dq, c_dk, c_dv = prep(hc, False)
    xc_f, xc_b, x_og, x_dq, x_dk, x_dv = prep(hx, True)
    B = hx.shape[0]
    s0 = jnp.zeros((B, C_HEADS, C_DK, C_DV), f32)
    oc_c, ox_c = bidirectional(chunked_delta_scan, cc_f, cc_b, xc_f, xc_b, s0, ctx_out)
    ox_d = window_attention(x_dq, x_dk, x_dv, c_dk, c_dv, sinks)

    def readout(o_c, o_d, og, dtype):
        B_, _, T, _ = o_c.shape
        y = jnp.concatenate([gated_head_norm(o_c, dn_norm_w, og),
                             merge_heads(o_d.reshape(B_, D_HEADS, T, D_HD))], axis=-1)
        return y.astype(dtype) @ w_out

    yx = readout(ox_c, ox_d, x_og, hx.dtype)
    yc = None
    if ctx_out:
        oc_d = context_attention(c_dq, c_dk, c_dv, sinks)
        yc = readout(oc_c, oc_d, c_og, hc.dtype)
    return yc, yx


def moe_ffn(h, router_w, router_b, w_up, b_up, w_down, b_down):
    f32 = jnp.float32
    logits = (h @ router_w + router_b).astype(f32)
    top_val, top_idx = lax.top_k(logits, TOP_K)
    top_w = jax.nn.softmax(top_val, axis=-1)
    gates = jnp.sum(jax.nn.one_hot(top_idx, N_EXPERTS, dtype=f32) * top_w[..., None], axis=-2)
    out = jnp.zeros(h.shape, f32)
    for e in range(N_EXPERTS):
        u = (h @ w_up[e] + b_up[e]).astype(f32)
        glu, lin = jnp.split(u, 2, axis=-1)
        glu = jnp.minimum(glu, SWIGLU_LIMIT)
        lin = jnp.clip(lin, -SWIGLU_LIMIT, SWIGLU_LIMIT)
        act = glu * jax.nn.sigmoid(SWIGLU_ALPHA * glu) * (lin + 1.0)
        y = act.astype(h.dtype) @ w_down[e] + b_down[e]
        out = out + gates[..., e:e + 1] * y.astype(f32)
    return out.astype(h.dtype)


def setup_inputs(seed: int = 0) -> dict:
    key = jax.random.key(seed)
    ks = iter(jax.random.split(key, 64))
    f32 = jnp.float32
    d = D_MODEL

    def nrm(shape, scale):
        return jax.random.normal(next(ks), shape, f32) * scale

    def gain(n):
        return 1.0 + nrm((n,), 0.02)

    def a_log(n):
        return jnp.log(jax.random.uniform(next(ks), (n,), f32, 1.0, 16.0))

    def dt_bias(n):
        dt = jnp.exp(jax.random.uniform(next(ks), (n,), f32, float(np.log(1e-3)), float(np.log(1e-1))))
        return dt + jnp.log(-jnp.expm1(-dt))

    inp = {}
    inp['x'] = nrm((BATCH, SEQ, d), 1.0)
    inp['c'] = nrm((BATCH, d), 1.0)
    inp['ctx'] = nrm((BATCH, CTX_LEN, d), 1.0)
    inp['c_ctx'] = nrm((d,), 1.0)
    inp['l0_ada_w'] = nrm((d, 6 * d), 0.5 * d ** -0.5)
    inp['l0_ada_b'] = nrm((6 * d,), 0.02)
    inp['l0_norm_mix_w'] = gain(d)
    inp['l0_w_in'] = nrm((d, EVEN_IN), d ** -0.5)
    inp['l0_w_out'] = nrm((EVEN_MIX, d), EVEN_MIX ** -0.5)
    inp['l0_gla_w2_f'] = nrm((A_RANK, A_HEADS * A_DK), A_RANK ** -0.5)
    inp['l0_gla_b_f'] = nrm((A_HEADS * A_DK,), 0.1)
    inp['l0_gla_w2_b'] = nrm((A_RANK, A_HEADS * A_DK), A_RANK ** -0.5)
    inp['l0_gla_b_b'] = nrm((A_HEADS * A_DK,), 0.1)
    inp['l0_gla_norm_w'] = gain(A_DV)
    inp['l0_hgrn_norm_w'] = gain(B_DV)
    inp['hgrn_lb_logits'] = nrm((N_B_LAYERS + 1, B_HEADS * B_DK), 0.5)
    inp['l0_norm_ffn_w'] = gain(d)
    inp['l0_router_w'] = nrm((d, N_EXPERTS), d ** -0.5)
    inp['l0_router_b'] = nrm((N_EXPERTS,), 0.01)
    inp['l0_w_up'] = nrm((N_EXPERTS, d, 2 * D_FF), d ** -0.5)
    inp['l0_b_up'] = nrm((N_EXPERTS, 2 * D_FF), 0.02)
    inp['l0_w_down'] = nrm((N_EXPERTS, D_FF, d), D_FF ** -0.5)
    inp['l0_b_down'] = nrm((N_EXPERTS, d), 0.02)
    inp['l1_ada_w'] = nrm((d, 6 * d), 0.5 * d ** -0.5)
    inp['l1_ada_b'] = nrm((6 * d,), 0.02)
    inp['l1_norm_mix_w'] = gain(d)
    inp['l1_w_in'] = nrm((d, ODD_IN), d ** -0.5)
    inp['l1_w_out'] = nrm((ODD_MIX, d), ODD_MIX ** -0.5)
    inp['l1_conv_w'] = nrm((CONV_W, 2 * C_HEADS * C_DK + C_HEADS * C_DV), CONV_W ** -0.5)
    inp['l1_a_log_f'] = a_log(C_HEADS)
    inp['l1_dt_bias_f'] = dt_bias(C_HEADS)
    inp['l1_a_log_b'] = a_log(C_HEADS)
    inp['l1_dt_bias_b'] = dt_bias(C_HEADS)
    inp['l1_dn_norm_w'] = gain(C_DV)
    inp['l1_sinks'] = nrm((D_HEADS,), 1.0)
    inp['l1_norm_ffn_w'] = gain(d)
    inp['l1_router_w'] = nrm((d, N_EXPERTS), d ** -0.5)
    inp['l1_router_b'] = nrm((N_EXPERTS,), 0.01)
    inp['l1_w_up'] = nrm((N_EXPERTS, d, 2 * D_FF), d ** -0.5)
    inp['l1_b_up'] = nrm((N_EXPERTS, 2 * D_FF), 0.02)
    inp['l1_w_down'] = nrm((N_EXPERTS, D_FF, d), D_FF ** -0.5)
    inp['l1_b_down'] = nrm((N_EXPERTS, d), 0.02)
    inp['final_norm_w'] = gain(d)
    return inp


def reference(x, c, ctx, c_ctx,
              l0_ada_w, l0_ada_b, l0_norm_mix_w, l0_w_in, l0_w_out,
              l0_gla_w2_f, l0_gla_b_f, l0_gla_w2_b, l0_gla_b_b, l0_gla_norm_w, l0_hgrn_norm_w,
              hgrn_lb_logits, l0_norm_ffn_w,
              l0_router_w, l0_router_b, l0_w_up, l0_b_up, l0_w_down, l0_b_down,
              l1_ada_w, l1_ada_b, l1_norm_mix_w, l1_w_in, l1_w_out,
              l1_conv_w, l1_a_log_f, l1_dt_bias_f, l1_a_log_b, l1_dt_bias_b, l1_dn_norm_w, l1_sinks,
              l1_norm_ffn_w,
              l1_router_w, l1_router_b, l1_w_up, l1_b_up, l1_w_down, l1_b_down,
              final_norm_w):
    T = x.shape[1]
    cos, sin = axial_rope(T)
    lb_table = jnp.cumsum(jax.nn.softmax(hgrn_lb_logits.astype(jnp.float32), axis=0), axis=0)
    layers = (
        dict(ada=(l0_ada_w, l0_ada_b), norm_mix_w=l0_norm_mix_w, norm_ffn_w=l0_norm_ffn_w,
             mix=(l0_w_in, l0_w_out, l0_gla_w2_f, l0_gla_b_f, l0_gla_w2_b, l0_gla_b_b,
                  l0_gla_norm_w, l0_hgrn_norm_w),
             moe=(l0_router_w, l0_router_b, l0_w_up, l0_b_up, l0_w_down, l0_b_down)),
        dict(ada=(l1_ada_w, l1_ada_b), norm_mix_w=l1_norm_mix_w, norm_ffn_w=l1_norm_ffn_w,
             mix=(l1_w_in, l1_w_out, l1_conv_w, l1_a_log_f, l1_dt_bias_f, l1_a_log_b, l1_dt_bias_b,
                  l1_dn_norm_w, l1_sinks),
             moe=(l1_router_w, l1_router_b, l1_w_up, l1_b_up, l1_w_down, l1_b_down)),
    )
    sc = jax.nn.silu(c)
    scc = jax.nn.silu(c_ctx)
    for l in range(DEPTH):
        p = layers[l]
        ctx_out = l < DEPTH - 1
        ada_w, ada_b = p['ada']
        sh1, sc1, g1, sh2, sc2, g2 = jnp.split((sc @ ada_w + ada_b)[:, None, :], 6, axis=-1)
        csh1, csc1, cg1, csh2, csc2, cg2 = jnp.split(scc @ ada_w + ada_b, 6, axis=-1)
        hx = modulate(rms_norm(x, p['norm_mix_w']), sh1, sc1)
        hc = modulate(rms_norm(ctx, p['norm_mix_w']), csh1, csc1)
        if l % 2 == 0:
            yc, yx = mixer_gla_hgrn(hc, hx, ctx_out, *p['mix'], lb_table[l // 2])
        else:
            yc, yx = mixer_delta_swa(hc, hx, ctx_out, *p['mix'], cos, sin)
        x = x + g1 * yx
        x = x + g2 * moe_ffn(modulate(rms_norm(x, p['norm_ffn_w']), sh2, sc2), *p['moe'])
        if ctx_out:
            ctx = ctx + cg1 * yc
            ctx = ctx + cg2 * moe_ffn(modulate(rms_norm(ctx, p['norm_ffn_w']), csh2, csc2), *p['moe'])
    return rms_norm(x, final_norm_w)
```

```cpp
#include <hip/hip_runtime.h>
#include <stdint.h>
#include <stdio.h>
#include <string.h>

#ifndef PROBE_DUPA
#define PROBE_DUPA 0
#endif
#ifndef PROBE_DUPB
#define PROBE_DUPB 0
#endif
#ifndef PROBE_DUP3
#define PROBE_DUP3 0
#endif
#ifndef PROBE_DUP12
#define PROBE_DUP12 0
#endif
#ifndef PROBE_DUP2
#define PROBE_DUP2 0
#endif
#ifndef PROBE_DUP7
#define PROBE_DUP7 0
#endif
#ifndef MK_PER_PHASE
#define MK_PER_PHASE 0
#endif

typedef unsigned short bf16_t;
typedef short bf16x8 __attribute__((ext_vector_type(8)));
typedef short bf16x4 __attribute__((ext_vector_type(4)));
typedef float f32x4 __attribute__((ext_vector_type(4)));
typedef unsigned u32x2 __attribute__((ext_vector_type(2)));
typedef unsigned u32x4 __attribute__((ext_vector_type(4)));
#define LAS __attribute__((address_space(3)))

constexpr int D = 1024, NB = 8, SEQ = 8192, CTX = 256, PB = SEQ + CTX  , MT = NB * PB  ;
constexpr int NIN0 = 4128, NIN0P = 4352, NIN1 = 2832, NIN1P = 3072;
constexpr int NE = 32, DFF = 1024;
constexpr int NTHR = 512;
constexpr float EPS = 1e-6f;
constexpr int LDS_CTL = 161792;
constexpr int LDS_BYTES = LDS_CTL + 2048;

constexpr size_t WS_CTL = 0;
constexpr size_t WS_CNT = 16384;
constexpr size_t WS_MOD = 65536;
constexpr size_t WS_ZERO_BYTES = 524288;
constexpr size_t WS_CTXS = 524288;
constexpr size_t WS_WIN0 = WS_CTXS + 8388608;
constexpr size_t WS_WIN1 = WS_WIN0 + 8912896;
constexpr size_t WS_WOUT = WS_WIN1 + 6291456;
constexpr size_t WS_TOK = WS_WOUT + 4194304;
constexpr size_t WS_GATE = WS_TOK + 34603008;
constexpr size_t WS_H = WS_GATE + 34603008;
constexpr size_t WS_BIG = WS_H + 138412032;
constexpr size_t WS_SCR = WS_BIG + 557973504;
constexpr size_t WS_OFB1 = WS_BIG + 382795776;
constexpr size_t WS_TM = WS_SCR + 207618048;
constexpr size_t WS_WUP = WS_SCR + 75497472;
constexpr size_t WS_WDN = WS_WUP + 134217728;
constexpr size_t WS_END = WS_SCR + 276824064;

#define XB_TMO      128
#define XB_XCNT(j)  (256  + 64 * (j))
#define XB_XSUB(j)  (1280 + 64 * (j))
#define XB_XGEN(j)  (2304 + 64 * (j))
#define XB_TOP      3328
#define XB_TOPGEN   3392
#define XCD_BAR_WORDS 3456
#define XB_SPIN_CAP (1u << 22)

__device__ __forceinline__ unsigned xb_ld(unsigned* p)              { return __hip_atomic_load(p, __ATOMIC_RELAXED, __HIP_MEMORY_SCOPE_AGENT); }
__device__ __forceinline__ unsigned xb_add(unsigned* p, unsigned v) { return __hip_atomic_fetch_add(p, v, __ATOMIC_RELAXED, __HIP_MEMORY_SCOPE_AGENT); }
__device__ __forceinline__ unsigned xb_xcc_id() { return (unsigned)__builtin_amdgcn_s_getreg((3 << 11) | 20) & 0xFu; }
#define XB_SPIN(cond, bar) do { unsigned _sp = 0; while (cond) { __builtin_amdgcn_s_sleep(1); \
    if ((++_sp & 255u) == 0u) { if (xb_ld(&(bar)[XB_TMO])) break; if (_sp > XB_SPIN_CAP) { atomicAdd(&(bar)[XB_TMO], 1u); break; } } } } while (0)

struct XcdBarrier { unsigned* bar; unsigned x; volatile LAS unsigned* st; };

__device__ __forceinline__ XcdBarrier xcd_barrier_post(unsigned* bar, volatile LAS unsigned* st) {
    XcdBarrier b; b.bar = bar; b.x = xb_xcc_id(); b.st = st;
    if (threadIdx.x == 0) (void)xb_add(&bar[XB_XCNT(b.x)], 1u);
    return b;
}
__device__ __forceinline__ void xcd_barrier_complete(unsigned* bar, unsigned x, unsigned& nloc, unsigned& nx) {
    const unsigned G = gridDim.x * gridDim.y * gridDim.z;
    unsigned sum, cnt, mine, sp = 0u;
    for (;;) {
        sum = 0u; cnt = 0u; mine = 0u;
#pragma unroll
        for (unsigned j = 0; j < 16; ++j) { const unsigned c = xb_ld(&bar[XB_XCNT(j)]); sum += c; cnt += (c > 0u) ? 1u : 0u; mine = (j == x) ? c : mine; }
        if (sum == G) break;
        __builtin_amdgcn_s_sleep(1);
        if ((++sp & 255u) == 0u) { if (xb_ld(&bar[XB_TMO])) break; if (sp > XB_SPIN_CAP) { atomicAdd(&bar[XB_TMO], 1u); break; } }
    }
    nloc = mine > 0u ? mine : 1u; nx = cnt > 0u ? cnt : 1u;
}
__device__ __forceinline__ void xcd_barrier(const XcdBarrier& b) {
    asm volatile("s_waitcnt vmcnt(0)" ::: "memory");
    __syncthreads();
    if (threadIdx.x == 0) {
        unsigned* bar = b.bar;
        __builtin_amdgcn_s_waitcnt(0);
        unsigned nloc = b.st[0], nx = b.st[1];
        if (nloc == 0u) { xcd_barrier_complete(bar, b.x, nloc, nx); b.st[0] = nloc; b.st[1] = nx; }
        const unsigned old = xb_add(&bar[XB_XSUB(b.x)], 1u);
        const unsigned gen = old / nloc;
        if (old + 1u == (gen + 1u) * nloc) {
            __builtin_amdgcn_fence(__ATOMIC_RELEASE, "agent");
            asm volatile("s_waitcnt vmcnt(0)" ::: "memory");
            const unsigned og = xb_add(&bar[XB_TOP], 1u);
            const unsigned tg = og / nx;
            if (og + 1u == (tg + 1u) * nx) xb_add(&bar[XB_TOPGEN], 1u);
            else XB_SPIN(xb_ld(&bar[XB_TOPGEN]) == tg, bar);
            __builtin_amdgcn_fence(__ATOMIC_ACQUIRE, "agent");
            xb_add(&bar[XB_XGEN(b.x)], 1u);
            asm volatile("s_waitcnt vmcnt(0)" ::: "memory");
        } else {
            XB_SPIN(xb_ld(&bar[XB_XGEN(b.x)]) == gen, bar);
            __builtin_amdgcn_fence(__ATOMIC_ACQUIRE, "agent");
            asm volatile("s_waitcnt vmcnt(0)" ::: "memory");
        }
    }
    __syncthreads();
}

__device__ __forceinline__ int otid() { int t = threadIdx.x; asm volatile("" : "+v"(t)); return t; }
__device__ __forceinline__ float bf2f(bf16_t v) { return __uint_as_float(((unsigned)v) << 16); }
__device__ __forceinline__ float bflo(unsigned w) { return __uint_as_float(w << 16); }
__device__ __forceinline__ float bfhi(unsigned w) { return __uint_as_float(w & 0xffff0000u); }
typedef __bf16 bf16v2 __attribute__((ext_vector_type(2)));
typedef float f32x2 __attribute__((ext_vector_type(2)));
__device__ __forceinline__ unsigned pk2(float lo, float hi) { const f32x2 v = {lo, hi}; const bf16v2 b = __builtin_convertvector(v, bf16v2); return __builtin_bit_cast(unsigned, b); }
__device__ __forceinline__ bf16_t f2bf(float f) { return (bf16_t)(pk2(f, f) & 0xffffu); }
__device__ __forceinline__ float sigmoidf_(float x) { return __builtin_amdgcn_rcpf(1.f + __expf(-x)); }
__device__ __forceinline__ float siluf_(float x) { return x * __builtin_amdgcn_rcpf(1.f + __expf(-x)); }
__device__ __forceinline__ float dppf(float v, const int ctrl_sel) {
    int r;
    if (ctrl_sel == 0) r = __builtin_amdgcn_update_dpp(0, __float_as_int(v), 0xB1, 0xf, 0xf, false);
    else if (ctrl_sel == 1) r = __builtin_amdgcn_update_dpp(0, __float_as_int(v), 0x4E, 0xf, 0xf, false);
    else r = __builtin_amdgcn_update_dpp(0, __float_as_int(v), 0x141, 0xf, 0xf, false);
    return __int_as_float(r);
}
__device__ __forceinline__ float red8(float v) { v += dppf(v, 0); v += dppf(v, 1); v += dppf(v, 2); return v; }
__device__ __forceinline__ float4 ntld4(const float* p) { const f32x4 v = __builtin_nontemporal_load((const f32x4*)p); return make_float4(v[0], v[1], v[2], v[3]); }
__device__ __forceinline__ uint4 ntldu4(const void* p) { const u32x4 v = __builtin_nontemporal_load((const u32x4*)p); return make_uint4(v[0], v[1], v[2], v[3]); }
__device__ __forceinline__ uint2 ntldu2(const void* p) { const u32x2 v = __builtin_nontemporal_load((const u32x2*)p); return make_uint2(v[0], v[1]); }
__device__ __forceinline__ float wave_sum(float v) {
#pragma unroll
    for (int o = 32; o > 0; o >>= 1) v += __shfl_xor(v, o);
    return v;
}

constexpr float FX_SCALE = 1048576.f, FX_INV = 1.f / 1048576.f;
#define LDS_SYNC() do { asm volatile("s_waitcnt lgkmcnt(0)" ::: "memory"); __builtin_amdgcn_s_barrier(); asm volatile("" ::: "memory"); } while (0)
#define WAVE_FENCE() do { asm volatile("s_waitcnt lgkmcnt(0)" ::: "memory"); __builtin_amdgcn_wave_barrier(); } while (0)
struct P { const float* in[43]; float* out; unsigned char* ws; int ph_lo, ph_hi, dupa, dupb; };

__device__ __forceinline__ void row_decode(int R, int& b, int& pp) { b = R / PB; pp = R - b * PB; }

__device__ __forceinline__ void ph0_mod(const P& p, float* ldsf, int bid, int nb) {
    float* MOD = (float*)(p.ws + WS_MOD);
    const int tid = otid();
    float* sc = ldsf;
    float* red = ldsf + 9 * 1024;
    for (int u = bid; u < 192; u += nb) {
        const int l = u / 96, cb = u % 96;
        const float* W = l ? p.in[23] : p.in[4]; const float* bias = l ? p.in[24] : p.in[5];
        __syncthreads();
        for (int i = tid; i < 9 * 1024; i += NTHR) { const int rr = i >> 10, k = i & 1023; const float v = rr < 8 ? p.in[1][rr * 1024 + k] : p.in[3][k]; sc[i] = siluf_(v); }
        __syncthreads();
        const int cq = tid & 15, ks = tid >> 4;
        const float* wp = W + (size_t)(ks * 32) * 6144 + cb * 64 + cq * 4;
        float4 acc[9];
#pragma unroll
        for (int rr = 0; rr < 9; ++rr) acc[rr] = make_float4(0.f, 0.f, 0.f, 0.f);
#pragma unroll 4
        for (int k4 = 0; k4 < 32; k4 += 4) {
            float4 w[4];
#pragma unroll
            for (int j = 0; j < 4; ++j) w[j] = ntld4(wp + (size_t)(k4 + j) * 6144);
#pragma unroll
            for (int rr = 0; rr < 9; ++rr) {
                const float4 s = *(const float4*)(sc + rr * 1024 + ks * 32 + k4);
                acc[rr].x += s.x * w[0].x + s.y * w[1].x + s.z * w[2].x + s.w * w[3].x; acc[rr].y += s.x * w[0].y + s.y * w[1].y + s.z * w[2].y + s.w * w[3].y;
                acc[rr].z += s.x * w[0].z + s.y * w[1].z + s.z * w[2].z + s.w * w[3].z; acc[rr].w += s.x * w[0].w + s.y * w[1].w + s.z * w[2].w + s.w * w[3].w;
            }
        }
#pragma unroll
        for (int rr = 0; rr < 9; ++rr) *(float4*)(red + (ks * 9 + rr) * 64 + cq * 4) = acc[rr];
        __syncthreads();
        for (int i = tid; i < 9 * 64; i += NTHR) { const int rr = i >> 6, c = i & 63;
            float s = 0.f;
#pragma unroll 8
            for (int k2 = 0; k2 < 32; ++k2) s += red[(k2 * 9 + rr) * 64 + c];
            MOD[(l * 9 + rr) * 6144 + cb * 64 + c] = s + bias[cb * 64 + c]; }
    }
}

template <int MAP>
__device__ __forceinline__ void cvt_tile(const float* __restrict__ src, int ldn, int nmax, int k0, int n0, bf16_t* __restrict__ dst, float* tile) {
    const int tid = otid();
    __syncthreads();
#pragma unroll
    for (int j = 0; j < 2; ++j) {
        const int r = (tid >> 4) + 32 * j, c4 = (tid & 15) * 4;
        float4 v = make_float4(0.f, 0.f, 0.f, 0.f);
        if (n0 + c4 < nmax) v = ntld4(src + (size_t)(k0 + r) * ldn + n0 + c4);
        tile[r * 65 + c4 + 0] = v.x; tile[r * 65 + c4 + 1] = v.y; tile[r * 65 + c4 + 2] = v.z; tile[r * 65 + c4 + 3] = v.w;
    }
    __syncthreads();
    const int n = tid >> 3, k8 = (tid & 7) * 8;
    if (n0 + n < nmax) {
        int nn = n0 + n;
        if (MAP == 1) { const int j = nn & 1023; nn = (j >> 7) * 256 + (nn >= 1024 ? 128 : 0) + (j & 127); }
        uint4 o;
        o.x = pk2(tile[(k8 + 0) * 65 + n], tile[(k8 + 1) * 65 + n]); o.y = pk2(tile[(k8 + 2) * 65 + n], tile[(k8 + 3) * 65 + n]);
        o.z = pk2(tile[(k8 + 4) * 65 + n], tile[(k8 + 5) * 65 + n]); o.w = pk2(tile[(k8 + 6) * 65 + n], tile[(k8 + 7) * 65 + n]);
        *(uint4*)(dst + (size_t)nn * 1024 + k0 + k8) = o;
    }
}

template <int MAP>
__device__ __forceinline__ void cvt_tile_wide(const float* __restrict__ src, int ldn, int k0, int n0, bf16_t* __restrict__ dst, float* tile) {
    const int tid = otid();
    __syncthreads();
    float4 v[8];
#pragma unroll
    for (int j = 0; j < 8; ++j) { const int r = (tid >> 6) + 8 * j, c4 = (tid & 63) * 4; v[j] = ntld4(src + (size_t)(k0 + r) * ldn + n0 + c4); }
#pragma unroll
    for (int j = 0; j < 8; ++j) { const int r = (tid >> 6) + 8 * j, c4 = (tid & 63) * 4; float* t = tile + r * 257 + c4; t[0] = v[j].x; t[1] = v[j].y; t[2] = v[j].z; t[3] = v[j].w; }
    __syncthreads();
#pragma unroll
    for (int j = 0; j < 4; ++j) {
        const int n = (tid >> 3) + 64 * j, k8 = (tid & 7) * 8;
        int nn = n0 + n;
        if (MAP == 1) { const int jj = nn & 1023; nn = (jj >> 7) * 256 + (nn >= 1024 ? 128 : 0) + (jj & 127); }
        uint4 o;
        o.x = pk2(tile[(k8 + 0) * 257 + n], tile[(k8 + 1) * 257 + n]); o.y = pk2(tile[(k8 + 2) * 257 + n], tile[(k8 + 3) * 257 + n]);
        o.z = pk2(tile[(k8 + 4) * 257 + n], tile[(k8 + 5) * 257 + n]); o.w = pk2(tile[(k8 + 6) * 257 + n], tile[(k8 + 7) * 257 + n]);
        *(uint4*)(dst + (size_t)nn * 1024 + k0 + k8) = o;
    }
}

__device__ __forceinline__ void ph0_convert(const P& p, float* ldsf, int bid, int nb) {
    for (int u = bid; u < 2272; u += nb) {
        if (u < 1040) { const int kt = u / 65, nt = u % 65; cvt_tile<0>(p.in[7], NIN0, NIN0, kt * 64, nt * 64, (bf16_t*)(p.ws + WS_WIN0), ldsf); }
        else if (u < 1760) { const int v = u - 1040, kt = v / 45, nt = v % 45; cvt_tile<0>(p.in[26], NIN1, NIN1, kt * 64, nt * 64, (bf16_t*)(p.ws + WS_WIN1), ldsf); }
        else if (u < 2016) { const int v = u - 1760, kt = v / 16, nt = v % 16; cvt_tile<0>(p.in[8], 1024, 1024, kt * 64, nt * 64, (bf16_t*)(p.ws + WS_WOUT), ldsf); }
        else { const int v = u - 2016, kt = v / 16, nt = v % 16; cvt_tile<0>(p.in[27], 1024, 1024, kt * 64, nt * 64, (bf16_t*)(p.ws + WS_WOUT) + 1024 * 1024, ldsf); }
    }
    const uint4 z = make_uint4(0u, 0u, 0u, 0u);
    uint4* z0 = (uint4*)(p.ws + WS_WIN0 + (size_t)NIN0 * 2048); const int n0 = (NIN0P - NIN0) * 2048 / 16;
    uint4* z1 = (uint4*)(p.ws + WS_WIN1 + (size_t)NIN1 * 2048); const int n1 = (NIN1P - NIN1) * 2048 / 16;
    for (int i = bid * NTHR + otid(); i < n0; i += nb * NTHR) z0[i] = z;
    for (int i = bid * NTHR + otid(); i < n1; i += nb * NTHR) z1[i] = z;
}

__device__ __forceinline__ void ph_convert_moe(const P& p, int layer, float* ldsf, int bid, int nb, int shift) {
    const float* wup = (layer ? p.in[38] : p.in[19]); const float* wdn = (layer ? p.in[40] : p.in[21]);
    bf16_t* up_t = (bf16_t*)(p.ws + WS_WUP); bf16_t* dn_t = (bf16_t*)(p.ws + WS_WDN);
    for (int u = (bid + shift) % nb; u < 6144; u += nb) {
        if (u < 4096) { const int e = u >> 7, v = u & 127, kt = v >> 3, nt = v & 7;
            cvt_tile_wide<1>(wup + (size_t)e * 1024 * 2048, 2048, kt * 64, nt * 256, up_t + (size_t)e * 2048 * 1024, ldsf); }
        else { const int w = u - 4096, e = w >> 6, v = w & 63, kt = v >> 2, nt = v & 3;
            cvt_tile_wide<0>(wdn + (size_t)e * 1024 * 1024, 1024, kt * 64, nt * 256, dn_t + (size_t)e * 1024 * 1024, ldsf); }
    }
}

template <int CONV>
__device__ __forceinline__ void norm_mod_row(float* __restrict__ src, const float* __restrict__ nw, const float* __restrict__ shift, const float* __restrict__ scale, int lane, float (&v)[16]) {
    float ss = 0.f;
#pragma unroll
    for (int i = 0; i < 4; ++i) {
        float4 x;
        if (CONV == 1) { const int4 xi = *(const int4*)(src + i * 256 + lane * 4); x.x = (float)xi.x * FX_INV; x.y = (float)xi.y * FX_INV; x.z = (float)xi.z * FX_INV; x.w = (float)xi.w * FX_INV; *(float4*)(src + i * 256 + lane * 4) = x; }
        else x = ntld4(src + i * 256 + lane * 4);
        if (CONV == 2) { int4 xi; xi.x = __float2int_rn(x.x * FX_SCALE); xi.y = __float2int_rn(x.y * FX_SCALE); xi.z = __float2int_rn(x.z * FX_SCALE); xi.w = __float2int_rn(x.w * FX_SCALE); *(int4*)(src + i * 256 + lane * 4) = xi; }
        v[i * 4 + 0] = x.x; v[i * 4 + 1] = x.y; v[i * 4 + 2] = x.z; v[i * 4 + 3] = x.w; ss += x.x * x.x + x.y * x.y + x.z * x.z + x.w * x.w; }
    ss = wave_sum(ss);
    const float rs = rsqrtf(ss * (1.f / 1024.f) + EPS);
#pragma unroll
    for (int i = 0; i < 4; ++i) {
        const float4 w = *(const float4*)(nw + i * 256 + lane * 4), sh = *(const float4*)(shift + i * 256 + lane * 4), sc = *(const float4*)(scale + i * 256 + lane * 4);
        v[i * 4 + 0] = v[i * 4 + 0] * rs * w.x * (1.f + sc.x) + sh.x; v[i * 4 + 1] = v[i * 4 + 1] * rs * w.y * (1.f + sc.y) + sh.y;
        v[i * 4 + 2] = v[i * 4 + 2] * rs * w.z * (1.f + sc.z) + sh.z; v[i * 4 + 3] = v[i * 4 + 3] * rs * w.w * (1.f + sc.w) + sh.w;
    }
}
__device__ __forceinline__ float* stream_row(const P& p, int layer_src  , int b, int pp) {
    if (pp < CTX) return (layer_src ? (float*)(p.ws + WS_CTXS) : (float*)p.in[2]) + (size_t)(b * CTX + pp) * D;
    return (layer_src ? p.out : (float*)p.in[0]) + (size_t)(b * SEQ + pp - CTX) * D;
}

__device__ __forceinline__ void ph_norm1(const P& p, int layer, int bid, int nb) {
    const int lane = otid() & 63, wv = otid() >> 6;
    const float* MOD = (const float*)(p.ws + WS_MOD);
    const float* nw = layer ? p.in[25] : p.in[6];
    bf16_t* H = (bf16_t*)(p.ws + WS_H);
    for (int R = bid * 8 + wv; R < MT; R += nb * 8) {
        int b, pp; row_decode(R, b, pp);
        float* src = stream_row(p, layer, b, pp);
        const float* m = MOD + (size_t)(layer * 9 + (pp < CTX ? 8 : b)) * 6144;
        float v[16];
        if (layer) {
            float ss = 0.f;
#pragma unroll
            for (int i = 0; i < 4; ++i) {
                float4 x = ntld4(src + i * 256 + lane * 4); const uint2 z = ntldu2(H + (size_t)R * D + i * 256 + lane * 4);
                x.x += bflo(z.x); x.y += bfhi(z.x); x.z += bflo(z.y); x.w += bfhi(z.y);
                if (pp >= CTX) *(float4*)(src + i * 256 + lane * 4) = x;
                v[i * 4 + 0] = x.x; v[i * 4 + 1] = x.y; v[i * 4 + 2] = x.z; v[i * 4 + 3] = x.w; ss += x.x * x.x + x.y * x.y + x.z * x.z + x.w * x.w;
            }
            ss = wave_sum(ss);
            const float rs = rsqrtf(ss * (1.f / 1024.f) + EPS);
#pragma unroll
            for (int i = 0; i < 4; ++i) {
                const float4 w = *(const float4*)(nw + i * 256 + lane * 4), sh = *(const float4*)(m + i * 256 + lane * 4), sc = *(const float4*)(m + 1024 + i * 256 + lane * 4);
                v[i * 4 + 0] = v[i * 4 + 0] * rs * w.x * (1.f + sc.x) + sh.x; v[i * 4 + 1] = v[i * 4 + 1] * rs * w.y * (1.f + sc.y) + sh.y;
                v[i * 4 + 2] = v[i * 4 + 2] * rs * w.z * (1.f + sc.z) + sh.z; v[i * 4 + 3] = v[i * 4 + 3] * rs * w.w * (1.f + sc.w) + sh.w;
            }
        } else norm_mod_row<0>(src, nw, m, m + 1024, lane, v);
#pragma unroll
        for (int i = 0; i < 4; ++i) { uint2 o; o.x = pk2(v[i * 4], v[i * 4 + 1]); o.y = pk2(v[i * 4 + 2], v[i * 4 + 3]); *(uint2*)(H + (size_t)R * D + i * 256 + lane * 4) = o; }
    }
}

namespace g8 {
constexpr int BK = 64, HALF = 128, HTB = HALF * BK * 2;
constexpr int STAGE_BYTES = 8 * HTB;
__device__ __forceinline__ int lds_byte(int r, int c) { const int st = (r >> 4) * 2 + (c >> 5), rr = r & 15, cc = c & 31, ob = rr * 64 + cc * 2; return st * 1024 + (ob ^ (((ob >> 9) & 1) << 5)); }
__device__ __forceinline__ void stage_rc(int b, int& R, int& C) { const int st = b / 1024, sb = b % 1024, swz = sb ^ (((sb >> 9) & 1) << 5); R = (st >> 1) * 16 + swz / 64; C = (st & 1) * 32 + (swz % 64) / 2; }
}

template <class Epi>
__device__ __forceinline__ void gemm_unit(LAS unsigned char* lds, const unsigned char* __restrict__ Abase, unsigned a00, unsigned a01, unsigned a10, unsigned a11,
                                          const unsigned char* __restrict__ Btile, const Epi& epi) {
    using namespace g8;
    const int tid = otid(), wid = __builtin_amdgcn_readfirstlane(tid >> 6), lane = tid & 63;
    int wr = wid >> 2, wc = wid & 3, fr = lane & 15, fq = lane >> 4;
    unsigned vb0, vb1;
    { int R, C; stage_rc(tid * 16, R, C); vb0 = (unsigned)(R * 1024 + C) * 2u; stage_rc(tid * 16 + 8192, R, C); vb1 = (unsigned)(R * 1024 + C) * 2u; }
    const unsigned ldsw = (unsigned)wid * 1024u;
    const int aoff = lds_byte(wr * 64 + fr, fq * 8), boff = lds_byte(wc * 32 + fr, fq * 8);
    constexpr unsigned hstepB = HALF * 1024 * 2;
#define G_SA(b, h) (((b) * 2 + (h)) * HTB)
#define G_SB(b, h) ((4 + (b) * 2 + (h)) * HTB)
#define G_GL(gp, lo) __builtin_amdgcn_global_load_lds((const unsigned*)(gp), (LAS unsigned*)(lds + (lo)), 16, 0, 0)
#define G_STA(bufoff, h, kt) do { const unsigned char* _ub = Abase + (size_t)((kt) * 128); G_GL(_ub + ((h) ? a10 : a00), (bufoff) + ldsw); G_GL(_ub + ((h) ? a11 : a01), (bufoff) + ldsw + 8192); } while (0)
#define G_STB(bufoff, h, kt) do { const unsigned char* _ub = Btile + (size_t)((h) * hstepB + (kt) * 128); G_GL(_ub + vb0, (bufoff) + ldsw); G_GL(_ub + vb1, (bufoff) + ldsw + 8192); } while (0)
#define G_LDA(dst, b, h) do { _Pragma("unroll") for (int m = 0; m < 4; ++m) _Pragma("unroll") for (int k = 0; k < 2; ++k) dst[m][k] = *(const LAS bf16x8*)(lds + G_SA(b, h) + aoff + m * 2048 + k * 1024); } while (0)
#define G_LDB(dst, b, h) do { _Pragma("unroll") for (int n = 0; n < 2; ++n) _Pragma("unroll") for (int k = 0; k < 2; ++k) dst[n][k] = *(const LAS bf16x8*)(lds + G_SB(b, h) + boff + n * 2048 + k * 1024); } while (0)
#define G_MMA(ai, bj, At_, Bt_) do { __builtin_amdgcn_s_setprio(1); _Pragma("unroll") for (int m = 0; m < 4; ++m) _Pragma("unroll") for (int n = 0; n < 2; ++n) _Pragma("unroll") for (int k = 0; k < 2; ++k) \
        acc[ai][bj][m][n] = __builtin_amdgcn_mfma_f32_16x16x32_bf16(Bt_[n][k], At_[m][k], acc[ai][bj][m][n], 0, 0, 0); __builtin_amdgcn_s_setprio(0); } while (0)
#define G_WV(n) asm volatile("s_waitcnt vmcnt(" #n ")" ::: "memory")
#define G_WL(n) asm volatile("s_waitcnt lgkmcnt(" #n ")" ::: "memory")
#define G_BAR __builtin_amdgcn_s_barrier()
#define G_SCHED __builtin_amdgcn_sched_barrier(0)
    f32x4 acc[2][2][4][2];
#pragma unroll
    for (int a = 0; a < 2; ++a)
#pragma unroll
        for (int b = 0; b < 2; ++b)
#pragma unroll
            for (int m = 0; m < 4; ++m)
#pragma unroll
                for (int n = 0; n < 2; ++n) acc[a][b][m][n] = (f32x4){0.f, 0.f, 0.f, 0.f};
    bf16x8 At[4][2], B0[2][2], B1[2][2];
    constexpr int nt = 1024 / BK;
    G_STB(G_SB(0, 0), 0, 0); G_STA(G_SA(0, 0), 0, 0); G_STB(G_SB(0, 1), 1, 0); G_STA(G_SA(0, 1), 1, 0);
    if (wr == 1) G_BAR;
    G_WV(4); G_BAR;
    G_STB(G_SB(1, 0), 0, 1); G_STA(G_SA(1, 0), 0, 1); G_STB(G_SB(1, 1), 1, 1);
    G_WV(6); G_BAR;
    for (int t = 0; t < nt - 2; t += 2) {
        G_LDB(B0, 0, 0); G_SCHED; G_LDA(At, 0, 0); G_STA(G_SA(1, 1), 1, t + 1);
        G_WL(8); G_BAR; G_WL(0); G_MMA(0, 0, At, B0); G_BAR; G_SCHED;
        G_LDB(B1, 0, 1); G_STB(G_SB(0, 0), 0, t + 2);
        G_BAR; G_WL(0); G_MMA(0, 1, At, B1); G_BAR;
        G_LDA(At, 0, 1); G_STA(G_SA(0, 0), 0, t + 2);
        G_BAR; G_WL(0); if (epi.is_full()) G_MMA(1, 0, At, B0); G_BAR; G_SCHED;
        G_STB(G_SB(0, 1), 1, t + 2);
        G_WV(6); G_BAR; if (epi.is_full()) G_MMA(1, 1, At, B1); G_BAR;
        G_LDB(B0, 1, 0); G_SCHED; G_LDA(At, 1, 0); G_STA(G_SA(0, 1), 1, t + 2);
        G_WL(8); G_BAR; G_WL(0); G_MMA(0, 0, At, B0); G_BAR; G_SCHED;
        G_LDB(B1, 1, 1); G_STB(G_SB(1, 0), 0, t + 3);
        G_BAR; G_WL(0); G_MMA(0, 1, At, B1); G_BAR;
        G_LDA(At, 1, 1); G_STA(G_SA(1, 0), 0, t + 3);
        G_BAR; G_WL(0); if (epi.is_full()) G_MMA(1, 0, At, B0); G_BAR; G_SCHED;
        G_STB(G_SB(1, 1), 1, t + 3);
        G_WV(6); G_BAR; if (epi.is_full()) G_MMA(1, 1, At, B1); G_BAR;
    }
    { G_LDB(B0, 0, 0); G_WV(0); G_LDA(At, 0, 0); G_STA(G_SA(1, 1), 1, nt - 1);
      G_BAR; G_WL(0); G_MMA(0, 0, At, B0); G_BAR;
      G_LDB(B1, 0, 1); G_BAR; G_WL(0); G_MMA(0, 1, At, B1); G_BAR;
      G_LDA(At, 0, 1); G_WV(4); G_BAR; G_WL(0); if (epi.is_full()) G_MMA(1, 0, At, B0); if (epi.is_full()) G_MMA(1, 1, At, B1); G_BAR; }
    { G_LDB(B0, 1, 0); G_LDA(At, 1, 0); G_WV(2); G_BAR; G_WL(0); G_MMA(0, 0, At, B0); G_BAR;
      G_LDB(B1, 1, 1); G_WV(0); G_BAR; G_WL(0); G_MMA(0, 1, At, B1); G_BAR;
      G_LDA(At, 1, 1); G_BAR; G_WL(0); if (epi.is_full()) G_MMA(1, 0, At, B0); if (epi.is_full()) G_MMA(1, 1, At, B1); G_BAR; }
    if (wr == 0) G_BAR;
    int tz = otid(); asm volatile("" : "+v"(tz));
    const int w2 = __builtin_amdgcn_readfirstlane(tz >> 6), l2 = tz & 63; wr = w2 >> 2; wc = w2 & 3; fr = l2 & 15; fq = l2 >> 4;
    LAS float* stg = (LAS float*)lds;
    if constexpr (Epi::ACT) {
#pragma unroll
        for (int ai = 0; ai < 2; ++ai)
#pragma unroll
            for (int m = 0; m < 4; ++m)
#pragma unroll
                for (int n = 0; n < 2; ++n) {
                    const f32x4 r = epi.act(acc[ai][0][m][n], acc[ai][1][m][n], wc * 32 + n * 16 + fq * 4);
                    u32x2 o; o.x = pk2(r[0], r[1]); o.y = pk2(r[2], r[3]);
                    *(LAS u32x2*)(lds + (ai * 128 + wr * 64 + m * 16 + fr) * 272 + (wc * 32 + n * 16 + fq * 4) * 2) = o;
                }
        __syncthreads();
#pragma unroll 2
        for (int i = 0; i < 8; ++i) { const int r = w2 * 32 + i * 4 + (l2 >> 4), c8 = (l2 & 15) * 8; epi.row(r, c8, *(const LAS u32x4*)(lds + r * 272 + c8 * 2)); }
        __syncthreads();
    } else {
#pragma unroll
    for (int ai = 0; ai < 2; ++ai) {
        if (ai == 1 && !epi.is_full()) break;
        typename Epi::Pre pre; epi.prefetch(ai, w2, l2, pre);
#pragma unroll
        for (int bj = 0; bj < 2; ++bj)
#pragma unroll
            for (int m = 0; m < 4; ++m)
#pragma unroll
                for (int n = 0; n < 2; ++n)
                    *(LAS f32x4*)(stg + (wr * 64 + m * 16 + fr) * 260 + bj * 128 + wc * 32 + n * 16 + fq * 4) = acc[ai][bj][m][n];
        __syncthreads();
        epi.rows(ai, w2, l2, stg, pre);
        __syncthreads();
    }
    }
#undef G_SA
#undef G_SB
#undef G_GL
#undef G_STA
#undef G_STB
#undef G_LDA
#undef G_LDB
#undef G_MMA
#undef G_WV
#undef G_WL
#undef G_BAR
#undef G_SCHED
}

__device__ __forceinline__ int perm32(int rho) { const int n = rho >> 4, i = rho & 15; return 8 * (i >> 2) + 4 * n + (i & 3); }
template <class Sched, class Epi>
__device__ __forceinline__ void gemm_stream(LAS unsigned char* lds, const unsigned char* __restrict__ Abase, Sched& S, const Epi& E) {
    using namespace g8;
    typedef typename Sched::UnitT UnitT;
    const int tid = otid(), wid = __builtin_amdgcn_readfirstlane(tid >> 6), lane = tid & 63;
    int wr = wid >> 2, wc = wid & 3, fr = lane & 15, fq = lane >> 4;
    unsigned vb0, vb1;
    { int R, C; stage_rc(tid * 16, R, C); const int Rb0 = Epi::PERM ? ((R & ~31) + perm32(R & 31)) : R; vb0 = (unsigned)(Rb0 * 1024 + C) * 2u;
      stage_rc(tid * 16 + 8192, R, C); const int Rb1 = Epi::PERM ? ((R & ~31) + perm32(R & 31)) : R; vb1 = (unsigned)(Rb1 * 1024 + C) * 2u; }
    const unsigned ldsw = (unsigned)wid * 1024u;
    const int aoff = lds_byte(wr * 64 + fr, fq * 8), boff = lds_byte(wc * 32 + fr, fq * 8);
    constexpr unsigned hstepB = HALF * 1024 * 2;
#define S_SA(b, h) (((b) * 2 + (h)) * HTB)
#define S_SB(b, h) ((4 + (b) * 2 + (h)) * HTB)
#define S_GL(gp, lo) __builtin_amdgcn_global_load_lds((const unsigned*)(gp), (LAS unsigned*)(lds + (lo)), 16, 0, 0)
#define S_STA(bufoff, U, h, kt) do { const unsigned char* _ub = Abase + (size_t)((kt) * 128); S_GL(_ub + (U).a[h][0], (bufoff) + ldsw); S_GL(_ub + (U).a[h][1], (bufoff) + ldsw + 8192); } while (0)
#define S_STB(bufoff, U, h, kt) do { const unsigned char* _ub = (U).Bt + (size_t)((h) * hstepB + (kt) * 128); S_GL(_ub + vb0, (bufoff) + ldsw); S_GL(_ub + vb1, (bufoff) + ldsw + 8192); } while (0)
#define S_LDA(dst, b, h) do { _Pragma("unroll") for (int m = 0; m < 4; ++m) _Pragma("unroll") for (int k = 0; k < 2; ++k) dst[m][k] = *(const LAS bf16x8*)(lds + S_SA(b, h) + aoff + m * 2048 + k * 1024); } while (0)
#define S_LDB(dst, b, h) do { _Pragma("unroll") for (int n = 0; n < 2; ++n) _Pragma("unroll") for (int k = 0; k < 2; ++k) dst[n][k] = *(const LAS bf16x8*)(lds + S_SB(b, h) + boff + n * 2048 + k * 1024); } while (0)
#define S_MMA(ai, bj, At_, Bt_) do { __builtin_amdgcn_s_setprio(1); _Pragma("unroll") for (int m = 0; m < 4; ++m) _Pragma("unroll") for (int n = 0; n < 2; ++n) _Pragma("unroll") for (int k = 0; k < 2; ++k) \
        acc[ai][bj][m][n] = __builtin_amdgcn_mfma_f32_16x16x32_bf16(Bt_[n][k], At_[m][k], acc[ai][bj][m][n], 0, 0, 0); __builtin_amdgcn_s_setprio(0); } while (0)
#define S_WV(n) asm volatile("s_waitcnt vmcnt(" #n ")" ::: "memory")
#define S_WL(n) asm volatile("s_waitcnt lgkmcnt(" #n ")" ::: "memory")
#define S_BAR __builtin_amdgcn_s_barrier()
#define S_SCHED __builtin_amdgcn_sched_barrier(0)
    UnitT cur, nxt; int ui = 0;
    if (!S.next(0, cur)) return;
    f32x4 acc[2][2][4][2];
#pragma unroll
    for (int a = 0; a < 2; ++a)
#pragma unroll
        for (int b = 0; b < 2; ++b)
#pragma unroll
            for (int m = 0; m < 4; ++m)
#pragma unroll
                for (int n = 0; n < 2; ++n) acc[a][b][m][n] = (f32x4){0.f, 0.f, 0.f, 0.f};
    bf16x8 At[4][2], B0[2][2], B1[2][2];
    constexpr int nt = 1024 / BK;
    S_STB(S_SB(0, 0), cur, 0, 0); S_STA(S_SA(0, 0), cur, 0, 0); S_STB(S_SB(0, 1), cur, 1, 0); S_STA(S_SA(0, 1), cur, 1, 0);
    if (wr == 1) S_BAR;
    S_WV(4); S_BAR;
    S_STB(S_SB(1, 0), cur, 0, 1); S_STA(S_SA(1, 0), cur, 0, 1); S_STB(S_SB(1, 1), cur, 1, 1);
    S_WV(6); S_BAR;
    for (;;) {
        const bool has_next = S.next(ui + 1, nxt);
        if (!has_next) nxt = cur;
#pragma unroll 1
        for (int t = 0; t < nt; t += 2) {
            const bool last = (t == nt - 2);
            S_LDB(B0, 0, 0); S_SCHED; S_LDA(At, 0, 0); S_STA(S_SA(1, 1), cur, 1, t + 1);
            S_WL(8); S_BAR; S_WL(0); S_MMA(0, 0, At, B0); S_BAR; S_SCHED;
            S_LDB(B1, 0, 1); if (last) S_STB(S_SB(0, 0), nxt, 0, 0); else S_STB(S_SB(0, 0), cur, 0, t + 2);
            S_BAR; S_WL(0); S_MMA(0, 1, At, B1); S_BAR;
            S_LDA(At, 0, 1); if (last) S_STA(S_SA(0, 0), nxt, 0, 0); else S_STA(S_SA(0, 0), cur, 0, t + 2);
            S_BAR; S_WL(0); S_MMA(1, 0, At, B0); S_BAR; S_SCHED;
            if (last) S_STB(S_SB(0, 1), nxt, 1, 0); else S_STB(S_SB(0, 1), cur, 1, t + 2);
            S_WV(6); S_BAR; S_MMA(1, 1, At, B1); S_BAR;
            S_LDB(B0, 1, 0); S_SCHED; S_LDA(At, 1, 0); if (last) S_STA(S_SA(0, 1), nxt, 1, 0); else S_STA(S_SA(0, 1), cur, 1, t + 2);
            S_WL(8); S_BAR; S_WL(0); S_MMA(0, 0, At, B0); S_BAR; S_SCHED;
            S_LDB(B1, 1, 1); if (last) S_STB(S_SB(1, 0), nxt, 0, 1); else S_STB(S_SB(1, 0), cur, 0, t + 3);
            S_BAR; S_WL(0); S_MMA(0, 1, At, B1); S_BAR;
            S_LDA(At, 1, 1); if (last) S_STA(S_SA(1, 0), nxt, 0, 1); else S_STA(S_SA(1, 0), cur, 0, t + 3);
            S_BAR; S_WL(0); S_MMA(1, 0, At, B0); S_BAR; S_SCHED;
            if (last) S_STB(S_SB(1, 1), nxt, 1, 1); else S_STB(S_SB(1, 1), cur, 1, t + 3);
            S_WV(6); S_BAR; S_MMA(1, 1, At, B1); S_BAR;
        }
        E(acc, cur, wr, wc, fr, fq);
        if (!has_next) break;
#pragma unroll
        for (int a = 0; a < 2; ++a)
#pragma unroll
            for (int b = 0; b < 2; ++b)
#pragma unroll
                for (int m = 0; m < 4; ++m)
#pragma unroll
                    for (int n = 0; n < 2; ++n) acc[a][b][m][n] = (f32x4){0.f, 0.f, 0.f, 0.f};
        cur = nxt; ++ui;
    }
    S_WV(0);
    if (wr == 0) S_BAR;
    S_BAR;
#undef S_SA
#undef S_SB
#undef S_GL
#undef S_STA
#undef S_STB
#undef S_LDA
#undef S_LDB
#undef S_MMA
#undef S_WV
#undef S_WL
#undef S_BAR
#undef S_SCHED
}

__device__ __forceinline__ void a_offsets_plain(unsigned row0, unsigned& a00, unsigned& a01, unsigned& a10, unsigned& a11) {
    int R0, C0, R1, C1; g8::stage_rc(otid() * 16, R0, C0); g8::stage_rc(otid() * 16 + 8192, R1, C1);
    a00 = (row0 + R0) * 2048u + C0 * 2u; a01 = (row0 + R1) * 2048u + C1 * 2u;
    a10 = (row0 + 128 + R0) * 2048u + C0 * 2u; a11 = (row0 + 128 + R1) * 2048u + C1 * 2u;
}

__device__ __forceinline__ void unit_decode(int L, int nM, int nN, int& pm, int& pn) {
    const int nig = 8 * nN, gid = L / nig, fm = gid * 8, gsz = (nM - fm) < 8 ? (nM - fm) : 8, rem = L - gid * nig;
    pm = fm + rem % gsz; pn = rem / gsz;
}
__device__ __forceinline__ bool unit_map(int i, int bid, int nb, int nM, int nN, int& pm, int& pn) {
    int L;
    if ((nb & 7) == 0) L = (i * 8 + (bid & 7)) * (nb >> 3) + (bid >> 3); else L = i * nb + bid;
    if (L >= nM * nN) return false;
    unit_decode(L, nM, nN, pm, pn);
    return true;
}

struct EpiNoPre { };
struct EpiProj {
    static constexpr bool ACT = false;
    __device__ __forceinline__ bool is_full() const { return true; }
    typedef EpiNoPre Pre;
    bf16_t* out; int ld, nreal, row0, col0;
    __device__ __forceinline__ void prefetch(int, int, int, Pre&) const {}
    __device__ __forceinline__ void rows(int ai, int w2, int lane, const LAS float* stg, const Pre&) const {
        const int col = col0 + lane * 4;
        if (col < nreal) {
#pragma unroll 4
            for (int i = 0; i < 16; ++i) { const int r = w2 * 16 + i; const f32x4 a = *(const LAS f32x4*)(stg + r * 260 + lane * 4);
                u32x2 o; o.x = pk2(a[0], a[1]); o.y = pk2(a[2], a[3]); __builtin_nontemporal_store(o, (u32x2*)(out + (size_t)(row0 + ai * 128 + r) * ld + col)); }
        }
    }
};

struct UnitPlain { unsigned a[2][2]; const unsigned char* Bt; int row0, col0; };
struct SchedPlain {
    typedef UnitPlain UnitT;
    const unsigned char* Bt; int bid, nb, nM, nN;
    __device__ __forceinline__ bool next(int i, UnitT& u) const {
        int pm, pn; if (!unit_map(i, bid, nb, nM, nN, pm, pn)) return false;
        a_offsets_plain(pm * 256, u.a[0][0], u.a[0][1], u.a[1][0], u.a[1][1]);
        u.Bt = Bt + (size_t)pn * 256 * 2048; u.row0 = pm * 256; u.col0 = pn * 256; return true;
    }
};
struct DEpiProj {
    static constexpr bool PERM = true;
    bf16_t* out; int ld, nreal;
    __device__ __forceinline__ void operator()(const f32x4 (&acc)[2][2][4][2], const UnitPlain& u, int wr, int wc, int fr, int fq) const {
#pragma unroll
        for (int ai = 0; ai < 2; ++ai)
#pragma unroll
            for (int m = 0; m < 4; ++m) {
                bf16_t* rowp = out + (size_t)(u.row0 + ai * 128 + wr * 64 + m * 16 + fr) * ld;
#pragma unroll
                for (int bj = 0; bj < 2; ++bj) {
                    const int col = u.col0 + bj * 128 + wc * 32 + 8 * fq;
                    if (col < nreal) { const f32x4 v0 = acc[ai][bj][m][0], v1 = acc[ai][bj][m][1];
                        u32x4 o; o.x = pk2(v0[0], v0[1]); o.y = pk2(v0[2], v0[3]); o.z = pk2(v1[0], v1[1]); o.w = pk2(v1[2], v1[3]);
                        __builtin_nontemporal_store(o, (u32x4*)(rowp + col)); }
                }
            }
    }
};
__device__ __forceinline__ void ph_inproj(const P& p, int layer, LAS unsigned char* lds, int bid, int nb) {
    SchedPlain S{p.ws + (layer ? WS_WIN1 : WS_WIN0), bid, nb, MT / 256, layer ? (NIN1P / 256) : (NIN0P / 256)};
    DEpiProj E{(bf16_t*)(p.ws + WS_BIG), layer ? NIN1 : NIN0, layer ? NIN1 : NIN0};
    __syncthreads();
    gemm_stream(lds, p.ws + WS_H, S, E);
    __syncthreads();
}

struct Pre8 { float4 x[8]; };
struct EpiOut {
    static constexpr bool ACT = false;
    __device__ __forceinline__ bool is_full() const { return true; }
    typedef Pre8 Pre;
    const float* src; float* dst; const float* g; size_t ro0; int col0;
    __device__ __forceinline__ void prefetch(int ai, int w2, int lane, Pre& pre) const {
#pragma unroll
        for (int i = 0; i < 8; ++i) pre.x[i] = ntld4(src + ro0 + (size_t)(ai * 128 + w2 * 16 + i) * D + col0 + lane * 4);
    }
    __device__ __forceinline__ void rows(int ai, int w2, int lane, const LAS float* stg, const Pre& pre) const {
        const int col = col0 + lane * 4; const float4 gg = *(const float4*)(g + col);
        float4 x2[8];
#pragma unroll
        for (int i = 0; i < 8; ++i) x2[i] = ntld4(src + ro0 + (size_t)(ai * 128 + w2 * 16 + 8 + i) * D + col);
#pragma unroll
        for (int i = 0; i < 16; ++i) {
            const int r = w2 * 16 + i; const f32x4 a = *(const LAS f32x4*)(stg + r * 260 + lane * 4);
            const float4 x = i < 8 ? pre.x[i & 7] : x2[i & 7];
            float4 y; y.x = x.x + gg.x * a[0]; y.y = x.y + gg.y * a[1]; y.z = x.z + gg.z * a[2]; y.w = x.w + gg.w * a[3];
            *(float4*)(dst + ro0 + (size_t)(ai * 128 + r) * D + col) = y;
        }
    }
};

__device__ __forceinline__ void ph_outproj(const P& p, int layer, LAS unsigned char* lds, int bid, int nb) {
    const int nrt = layer ? 256 : 264;
    const int nunits = nrt * 4;
    const unsigned char* A = p.ws + WS_H;
    const unsigned char* Bt = p.ws + WS_WOUT + (size_t)layer * 1024 * 2048;
    (void)nunits;
    for (int it = 0;; ++it) {
        int j, pn; if (!unit_map(it, bid, nb, nrt, 4, j, pn)) break;
        const int pm = layer ? ((j >> 5) * 33 + 1 + (j & 31)) : j;
        unsigned a00, a01, a10, a11; a_offsets_plain(pm * 256, a00, a01, a10, a11);
        int b, pp0; row_decode(pm * 256, b, pp0);
        const bool isctx = pp0 < CTX;
        const float* MOD = (const float*)(p.ws + WS_MOD);
        EpiOut E{isctx ? (layer ? (const float*)(p.ws + WS_CTXS) : p.in[2]) : (layer ? (const float*)p.out : p.in[0]), isctx ? (float*)(p.ws + WS_CTXS) : p.out,
                 MOD + (size_t)(layer * 9 + (isctx ? 8 : b)) * 6144 + 2048, isctx ? (size_t)(b * CTX + pp0) * D : (size_t)(b * SEQ + pp0 - CTX) * D, pn * 256};
        gemm_unit(lds, A, a00, a01, a10, a11, Bt + (size_t)pn * 256 * 2048, E);
    }
}

constexpr int TC = 32;
__device__ __forceinline__ int seq_pp(int n, int dir) { return dir == 0 ? n : (n < CTX ? (CTX - 1 - n) : (PB + CTX - 1 - n)); }

template <int DK, int MODE  >
__device__ __forceinline__ void scan_chunk(const float* qs, const float* ks_, const float* as_, const float* vs, const float* egs, const float* bts, float* os, float (&S)[DK / 8], int w, int cl, int ksl) {
    constexpr int NR = DK / 8;
    for (int tt = 0; tt < TC; ++tt) {
        const float vv = vs[tt * 64 + w * 8 + cl];
        float qv[NR], kv[NR], av[NR];
#pragma unroll
        for (int r4 = 0; r4 < NR / 4; ++r4) {
            const float4 q4 = *(const float4*)(qs + tt * DK + ksl * NR + r4 * 4); qv[r4 * 4] = q4.x; qv[r4 * 4 + 1] = q4.y; qv[r4 * 4 + 2] = q4.z; qv[r4 * 4 + 3] = q4.w;
            if (MODE != 1) { const float4 k4 = *(const float4*)(ks_ + tt * DK + ksl * NR + r4 * 4); kv[r4 * 4] = k4.x; kv[r4 * 4 + 1] = k4.y; kv[r4 * 4 + 2] = k4.z; kv[r4 * 4 + 3] = k4.w; }
            if (MODE != 2) { const float4 a4 = *(const float4*)(as_ + tt * DK + ksl * NR + r4 * 4); av[r4 * 4] = a4.x; av[r4 * 4 + 1] = a4.y; av[r4 * 4 + 2] = a4.z; av[r4 * 4 + 3] = a4.w; }
        }
        float o = 0.f;
        if (MODE == 0) {
#pragma unroll
            for (int r = 0; r < NR; ++r) { S[r] = av[r] * S[r] + kv[r] * vv; o += qv[r] * S[r]; }
        } else if (MODE == 1) {
#pragma unroll
            for (int r = 0; r < NR; ++r) { S[r] = av[r] * S[r] + (1.f - av[r]) * vv; o += qv[r] * S[r]; }
        } else {
            const float eg = egs[tt], bt = bts[tt];
            float kS = 0.f;
#pragma unroll
            for (int r = 0; r < NR; ++r) kS += kv[r] * S[r];
            kS = red8(kS);
            const float c = bt * (vv - eg * kS);
#pragma unroll
            for (int r = 0; r < NR; ++r) { S[r] = eg * S[r] + kv[r] * c; o += qv[r] * S[r]; }
        }
        o = red8(o);
        if (ksl == 0) os[tt * 64 + w * 8 + cl] = o;
    }
}

__device__ __forceinline__ void scan_unit_l0(const P& p, int u, float* ldsf) {
    const int type = u >> 7, idx = u & 127, b = idx >> 4, h = (idx >> 2) & 3, dir = (idx >> 1) & 1, half = idx & 1;
    const int tid = otid(), lane = tid & 63, w = tid >> 6, cl = lane >> 3, ksl = lane & 7;
    const bf16_t* PROJ = (const bf16_t*)(p.ws + WS_BIG);
    bf16_t* OD = (bf16_t*)(p.ws + WS_SCR) + (size_t)dir * MT * D;
    if (type == 0) {
        float* qs = ldsf; float* ks_ = qs + TC * 64; float* as_ = ks_ + TC * 64; float* vs = as_ + TC * 64; float* os = vs + TC * 64; float* rs = os + TC * 64;
        const float* W2 = (dir ? p.in[11] : p.in[9]); const float* B2 = (dir ? p.in[12] : p.in[10]);
        const int i = tid & 63;
        float w2c[16];
#pragma unroll
        for (int m = 0; m < 16; ++m) w2c[m] = W2[m * 256 + h * 64 + i];
        const float b2c = B2[h * 64 + i];
        float S[8];
#pragma unroll
        for (int r = 0; r < 8; ++r) S[r] = 0.f;
        for (int c0 = 0; c0 < PB; c0 += TC) {
            __syncthreads();
#pragma unroll
            for (int j = 0; j < 4; ++j) {
                const int t = (tid >> 6) + 8 * j; const size_t R = (size_t)b * PB + seq_pp(c0 + t, dir);
                const bf16_t* row = PROJ + R * NIN0;
                qs[t * 64 + i] = bf2f(row[h * 64 + i]) * 0.125f;
                ks_[t * 64 + i] = bf2f(row[256 + h * 64 + i]);
                vs[t * 64 + i] = bf2f(row[512 + h * 128 + half * 64 + i]);
            }
            { const int t = tid >> 4, m = tid & 15; const size_t R = (size_t)b * PB + seq_pp(c0 + t, dir); rs[t * 16 + m] = bf2f(PROJ[R * NIN0 + 1024 + dir * 16 + m]); }
            __syncthreads();
#pragma unroll
            for (int j = 0; j < 4; ++j) {
                const int t = (tid >> 6) + 8 * j;
                float z = b2c;
#pragma unroll
                for (int m = 0; m < 16; ++m) z += rs[t * 16 + m] * w2c[m];
                const float ls = fminf(z, 0.f) - __logf(1.f + __expf(-fabsf(z)));
                as_[t * 64 + i] = __expf(ls * (1.f / 16.f));
            }
            __syncthreads();
            scan_chunk<64, 0>(qs, ks_, as_, vs, nullptr, nullptr, os, S, w, cl, ksl);
            __syncthreads();
            { const int t = tid >> 4, c4 = (tid & 15) * 4; const size_t R = (size_t)b * PB + seq_pp(c0 + t, dir);
              uint2 o; o.x = pk2(os[t * 64 + c4], os[t * 64 + c4 + 1]); o.y = pk2(os[t * 64 + c4 + 2], os[t * 64 + c4 + 3]);
              *(uint2*)(OD + R * D + h * 128 + half * 64 + c4) = o; }
        }
    } else {
        float* qs = ldsf; float* fs = qs + TC * 128; float* vs = fs + TC * 128; float* os = vs + TC * 64;
        const int i = tid & 127;
        const float* lbl = p.in[15];
        const float lb = 1.f / (1.f + __expf(lbl[512 + h * 128 + i] - lbl[h * 128 + i]));
        float S[16];
#pragma unroll
        for (int r = 0; r < 16; ++r) S[r] = 0.f;
        for (int c0 = 0; c0 < PB; c0 += TC) {
            __syncthreads();
#pragma unroll
            for (int j = 0; j < 8; ++j) {
                const int t = (tid >> 7) + 4 * j; const size_t R = (size_t)b * PB + seq_pp(c0 + t, dir);
                const bf16_t* row = PROJ + R * NIN0;
                qs[t * 128 + i] = bf2f(row[1568 + h * 128 + i]);
                const float z = bf2f(row[2080 + dir * 512 + h * 128 + i]);
                fs[t * 128 + i] = lb + (1.f - lb) * sigmoidf_(z);
            }
#pragma unroll
            for (int j = 0; j < 4; ++j) {
                const int t = (tid >> 6) + 8 * j; const size_t R = (size_t)b * PB + seq_pp(c0 + t, dir);
                vs[t * 64 + (tid & 63)] = bf2f(PROJ[R * NIN0 + 3104 + h * 128 + half * 64 + (tid & 63)]);
            }
            __syncthreads();
            scan_chunk<128, 1>(qs, nullptr, fs, vs, nullptr, nullptr, os, S, w, cl, ksl);
            __syncthreads();
            { const int t = tid >> 4, c4 = (tid & 15) * 4; const size_t R = (size_t)b * PB + seq_pp(c0 + t, dir);
              uint2 o; o.x = pk2(os[t * 64 + c4], os[t * 64 + c4 + 1]); o.y = pk2(os[t * 64 + c4 + 2], os[t * 64 + c4 + 3]);
              *(uint2*)(OD + R * D + 512 + h * 128 + half * 64 + c4) = o; }
        }
    }
}

template <int NK>
__device__ __forceinline__ f32x4 mma_tile(const LAS unsigned char* A, int strideA, int rowA0, const LAS unsigned char* B, int strideB, int rowB0, f32x4 acc, int lane) {
    const int r = lane & 15, q = lane >> 4;
    const LAS unsigned char* ap = A + (rowA0 + r) * strideA + q * 16;
    const LAS unsigned char* bp = B + (rowB0 + r) * strideB + q * 16;
#pragma unroll
    for (int kb = 0; kb < NK; ++kb) {
        const bf16x8 a = *(const LAS bf16x8*)(ap + kb * 64), b = *(const LAS bf16x8*)(bp + kb * 64);
        acc = __builtin_amdgcn_mfma_f32_16x16x32_bf16(a, b, acc, 0, 0, 0);
    }
    return acc;
}
template <int NK>
__device__ __forceinline__ f32x4 mma_tile_rows(const LAS unsigned char* A, int strideA, int rowA, const LAS unsigned char* B, int strideB, int rowB0, f32x4 acc, int lane) {
    const int r = lane & 15, q = lane >> 4;
    const LAS unsigned char* ap = A + rowA * strideA + q * 16;
    const LAS unsigned char* bp = B + (rowB0 + r) * strideB + q * 16;
#pragma unroll
    for (int kb = 0; kb < NK; ++kb) {
        const bf16x8 a = *(const LAS bf16x8*)(ap + kb * 64), b = *(const LAS bf16x8*)(bp + kb * 64);
        acc = __builtin_amdgcn_mfma_f32_16x16x32_bf16(a, b, acc, 0, 0, 0);
    }
    return acc;
}
__device__ __forceinline__ float fexp(float x) { return __builtin_amdgcn_exp2f(x * 1.4426950408889634f); }
__device__ __forceinline__ float flog(float x) { return __builtin_amdgcn_logf(x) * 0.6931471805599453f; }
__device__ __forceinline__ float clamp80(float x) { return fminf(fmaxf(x, -80.f), 80.f); }

template <int TYPE  >
__device__ __forceinline__ void scan_l0_chunked(const P& p, int idx, LAS unsigned char* lds) {
    constexpr int DK = TYPE ? 128 : 64, C = 64, CPT = DK / 64, TL = 8, NSEG = 8;
    constexpr int SQ = DK * 2 + 16, S64 = 144;
    constexpr int OFF_QM = 0, OFF_KM = OFF_QM + C * SQ, OFF_QS = OFF_KM + C * SQ, OFF_KL = OFF_QS + C * SQ, OFF_VT = OFF_KL + DK * S64, OFF_P = OFF_VT + 64 * S64,
                  OFF_S0 = OFF_P + 64 * S64, OFF_S1 = OFF_S0 + 64 * SQ, OFF_TOT = OFF_S1 + 64 * SQ, OFF_D = OFF_TOT + NSEG * DK * 4, OFF_END = OFF_D + DK * 4;
    static_assert(OFF_END <= LDS_CTL, "scan LDS");
    const int b = idx >> 4, h = (idx >> 2) & 3, dir = (idx >> 1) & 1, half = idx & 1;
    const int tid = otid(), lane = tid & 63, w = __builtin_amdgcn_readfirstlane(tid >> 6), r16 = lane & 15, q4 = lane >> 4;
    const int i0 = lane * CPT, seg = w;
    const bf16_t* PROJ = (const bf16_t*)(p.ws + WS_BIG);
    bf16_t* OD = (bf16_t*)(p.ws + WS_SCR) + (size_t)dir * MT * D + (TYPE ? 512 : 0) + h * 128 + half * 64;
    LAS float* TOT = (LAS float*)(lds + OFF_TOT); LAS float* DV = (LAS float*)(lds + OFF_D);
    float lb[CPT], b2c = 0.f; float w2c[16];
    if (TYPE) { const float* lbl = p.in[15];
#pragma unroll
        for (int c = 0; c < CPT; ++c) lb[c] = 1.f / (1.f + fexp(lbl[512 + h * 128 + i0 + c] - lbl[h * 128 + i0 + c])); }
    else { const float* W2 = dir ? p.in[11] : p.in[9]; const float* B2 = dir ? p.in[12] : p.in[10]; lb[0] = 0.f;
#pragma unroll
        for (int m = 0; m < 16; ++m) w2c[m] = W2[m * 256 + h * 64 + i0];
        b2c = B2[h * 64 + i0]; }
    const int qcol = TYPE ? (1568 + h * 128 + i0) : (h * 64 + i0);
    const int zcol = TYPE ? (2080 + dir * 512 + h * 128 + i0) : (256 + h * 64 + i0);
    const int vcol = (TYPE ? (3104 + h * 128) : (512 + h * 128)) + half * 64 + (tid & 7) * 8;
    constexpr int NST = TYPE ? 4 : 2;
    const int it = TYPE ? w : (w >> 1), ct0 = TYPE ? 0 : ((w & 1) * 2);
    f32x4 sacc[NST];
#pragma unroll
    for (int k = 0; k < NST; ++k) sacc[k] = (f32x4){0.f, 0.f, 0.f, 0.f};
    __syncthreads();
    for (int k = tid; k < 64 * SQ / 4; k += NTHR) ((LAS unsigned*)(lds + OFF_S0))[k] = 0u;
    int cur = 0;
    unsigned rq[TL], rz[TL]; uint4 rv; uint4 rr[TYPE ? 1 : 2 * TL];
#define L0_LOAD(n) do { \
        _Pragma("unroll") for (int j = 0; j < TL; ++j) { const size_t R = (size_t)b * PB + seq_pp((n) * C + seg * TL + j, dir); const bf16_t* row = PROJ + R * NIN0; \
            if (CPT == 2) { rq[j] = *(const unsigned*)(row + qcol); rz[j] = *(const unsigned*)(row + zcol); } else { rq[j] = row[qcol]; rz[j] = row[zcol]; } \
            if (!TYPE) { rr[2 * j] = *(const uint4*)(row + 1024 + dir * 16); rr[2 * j + 1] = *(const uint4*)(row + 1024 + dir * 16 + 8); } } \
        { const size_t R = (size_t)b * PB + seq_pp((n) * C + (tid >> 3), dir); rv = *(const uint4*)(PROJ + R * NIN0 + vcol); } } while (0)
    L0_LOAD(0);
    for (int n = 0; n < PB / C; ++n) {
        float qv[CPT][TL], kv[CPT][TL], Bl[CPT][TL];
        float run[CPT];
#pragma unroll
        for (int c = 0; c < CPT; ++c) run[c] = 0.f;
#pragma unroll
        for (int j = 0; j < TL; ++j) {
#pragma unroll
            for (int c = 0; c < CPT; ++c) {
                const float qr = c ? bfhi(rq[j]) : bflo(rq[j]), zr = c ? bfhi(rz[j]) : bflo(rz[j]);
                float G;
                if (TYPE) { const float f = lb[c] + (1.f - lb[c]) * __builtin_amdgcn_rcpf(1.f + fexp(-zr)); G = flog(f); kv[c][j] = 1.f - f; qv[c][j] = qr; }
                else {
                    const uint4 r0 = rr[2 * j], r1 = rr[2 * j + 1];
                    float z = b2c;
                    z += bflo(r0.x) * w2c[0] + bfhi(r0.x) * w2c[1] + bflo(r0.y) * w2c[2] + bfhi(r0.y) * w2c[3] + bflo(r0.z) * w2c[4] + bfhi(r0.z) * w2c[5] + bflo(r0.w) * w2c[6] + bfhi(r0.w) * w2c[7];
                    z += bflo(r1.x) * w2c[8] + bfhi(r1.x) * w2c[9] + bflo(r1.y) * w2c[10] + bfhi(r1.y) * w2c[11] + bflo(r1.z) * w2c[12] + bfhi(r1.z) * w2c[13] + bflo(r1.w) * w2c[14] + bfhi(r1.w) * w2c[15];
                    G = (fminf(z, 0.f) - flog(1.f + fexp(-fabsf(z)))) * (1.f / 16.f);
                    kv[c][j] = zr; qv[c][j] = qr * 0.125f;
                }
                run[c] += G; Bl[c][j] = run[c];
            }
        }
#pragma unroll
        for (int c = 0; c < CPT; ++c) TOT[seg * DK + i0 + c] = run[c];
        const uint4 vraw = rv;
        LDS_SYNC();
        float offs[CPT], mref[CPT], blast[CPT];
#pragma unroll
        for (int c = 0; c < CPT; ++c) { offs[c] = 0.f; mref[c] = 0.f; blast[c] = 0.f; }
#pragma unroll
        for (int s2 = 0; s2 < NSEG; ++s2)
#pragma unroll
            for (int c = 0; c < CPT; ++c) { const float tv = TOT[s2 * DK + i0 + c]; offs[c] += (s2 < seg) ? tv : 0.f; mref[c] += (s2 < NSEG / 2) ? tv : 0.f; blast[c] += tv; }
        {
            unsigned kl[CPT][TL / 2];
#pragma unroll
            for (int j = 0; j < TL; ++j) {
                const int t = seg * TL + j;
                float qm[CPT], km[CPT], qs[CPT], kq[CPT];
#pragma unroll
                for (int c = 0; c < CPT; ++c) { const float Bt = offs[c] + Bl[c][j]; const float e1 = fexp(clamp80(Bt - mref[c])), e2 = __builtin_amdgcn_rcpf(e1), eb = fexp(Bt), el = fexp(blast[c] - Bt);
                    qm[c] = qv[c][j] * e1; km[c] = kv[c][j] * e2; qs[c] = qv[c][j] * eb; kq[c] = kv[c][j] * el; }
                if (CPT == 2) {
                    *(LAS unsigned*)(lds + OFF_QM + t * SQ + i0 * 2) = pk2(qm[0], qm[CPT - 1]);
                    *(LAS unsigned*)(lds + OFF_KM + t * SQ + i0 * 2) = pk2(km[0], km[CPT - 1]);
                    *(LAS unsigned*)(lds + OFF_QS + t * SQ + i0 * 2) = pk2(qs[0], qs[CPT - 1]);
                } else {
                    *(LAS bf16_t*)(lds + OFF_QM + t * SQ + i0 * 2) = f2bf(qm[0]);
                    *(LAS bf16_t*)(lds + OFF_KM + t * SQ + i0 * 2) = f2bf(km[0]);
                    *(LAS bf16_t*)(lds + OFF_QS + t * SQ + i0 * 2) = f2bf(qs[0]);
                }
#pragma unroll
                for (int c = 0; c < CPT; ++c) {
                    if (j & 1) kl[c][j >> 1] = (kl[c][j >> 1] & 0xffffu) | ((unsigned)f2bf(kq[c]) << 16); else kl[c][j >> 1] = (unsigned)f2bf(kq[c]);
                }
            }
#pragma unroll
            for (int c = 0; c < CPT; ++c) {
                *(LAS u32x4*)(lds + OFF_KL + (i0 + c) * S64 + (seg * TL) * 2) = (u32x4){kl[c][0], kl[c][1], kl[c][2], kl[c][3]};
                if (seg == 0) DV[i0 + c] = fexp(blast[c]);
            }
            const int tv = tid >> 3, c8 = (tid & 7) * 8;
            const unsigned vw[4] = {vraw.x, vraw.y, vraw.z, vraw.w};
#pragma unroll
            for (int e = 0; e < 4; ++e) { *(LAS bf16_t*)(lds + OFF_VT + (c8 + 2 * e) * S64 + tv * 2) = (bf16_t)(vw[e] & 0xffffu); *(LAS bf16_t*)(lds + OFF_VT + (c8 + 2 * e + 1) * S64 + tv * 2) = (bf16_t)(vw[e] >> 16); }
        }
        LDS_SYNC();
        if (n + 1 < PB / C) L0_LOAD(n + 1);
#pragma unroll
        for (int k = 0; k < 2; ++k) {
            const int tile = w + 8 * k, st = tile >> 2, tt = tile & 3;
            f32x4 d = (f32x4){0.f, 0.f, 0.f, 0.f};
            if (st <= tt) d = mma_tile<DK / 32>(lds + OFF_KM, SQ, st * 16, lds + OFF_QM, SQ, tt * 16, d, lane);
            const int s0 = st * 16 + 4 * q4, t = tt * 16 + r16;
            u32x2 o; o.x = pk2(s0 <= t ? d[0] : 0.f, s0 + 1 <= t ? d[1] : 0.f); o.y = pk2(s0 + 2 <= t ? d[2] : 0.f, s0 + 3 <= t ? d[3] : 0.f);
            *(LAS u32x2*)(lds + OFF_P + t * S64 + s0 * 2) = o;
        }
        {
            const f32x4 dv = *(const LAS f32x4*)(DV + it * 16 + 4 * q4);
            const int snx = cur ? OFF_S0 : OFF_S1;
#pragma unroll
            for (int k = 0; k < NST; ++k) {
                const int ct = ct0 + k;
                f32x4 a = sacc[k]; a[0] *= dv[0]; a[1] *= dv[1]; a[2] *= dv[2]; a[3] *= dv[3];
                a = mma_tile<2>(lds + OFF_KL, S64, it * 16, lds + OFF_VT, S64, ct * 16, a, lane);
                sacc[k] = a;
                u32x2 o; o.x = pk2(a[0], a[1]); o.y = pk2(a[2], a[3]);
                *(LAS u32x2*)(lds + snx + (ct * 16 + r16) * SQ + (it * 16 + 4 * q4) * 2) = o;
            }
        }
        LDS_SYNC();
        {
            const int scu = cur ? OFF_S1 : OFF_S0;
            const int tt = w >> 1, cA = 32 * (w & 1) + 8 * (r16 >> 2) + (r16 & 3);
            uint4 ov;
#pragma unroll
            for (int k = 0; k < 2; ++k) {
                f32x4 d = (f32x4){0.f, 0.f, 0.f, 0.f};
                d = mma_tile_rows<2>(lds + OFF_VT, S64, cA + 4 * k, lds + OFF_P, S64, tt * 16, d, lane);
                d = mma_tile_rows<DK / 32>(lds + scu, SQ, cA + 4 * k, lds + OFF_QS, SQ, tt * 16, d, lane);
                if (k == 0) { ov.x = pk2(d[0], d[1]); ov.y = pk2(d[2], d[3]); } else { ov.z = pk2(d[0], d[1]); ov.w = pk2(d[2], d[3]); }
            }
            { const size_t R = (size_t)b * PB + seq_pp(n * C + tt * 16 + r16, dir); *(uint4*)(OD + R * D + 32 * (w & 1) + 8 * q4) = ov; }
        }
        cur ^= 1;
    }
#undef L0_LOAD
}

__device__ __forceinline__ void scan_unit_delta(const P& p, int idx, float* ldsf) {
    const int b = idx >> 4, h = (idx >> 2) & 3, dir = (idx >> 1) & 1, half = idx & 1;
    const int tid = otid(), lane = tid & 63, w = tid >> 6, cl = lane >> 3, ksl = lane & 7;
    const bf16_t* PROJ = (const bf16_t*)(p.ws + WS_BIG);
    const bf16_t* QKV = (const bf16_t*)(p.ws + WS_SCR);
    bf16_t* OD = (bf16_t*)(p.ws + WS_OFB1) + (size_t)dir * MT * 512;
    float* qs = ldsf; float* ks_ = qs + TC * 128; float* vs = ks_ + TC * 128; float* os = vs + TC * 64; float* egs = os + TC * 64; float* bts = egs + TC;
    const float Aexp = __expf((dir ? p.in[31] : p.in[29])[h]); const float dtb = (dir ? p.in[32] : p.in[30])[h];
    const int i = tid & 127;
    float S[16];
#pragma unroll
    for (int r = 0; r < 16; ++r) S[r] = 0.f;
    for (int c0 = 0; c0 < PB; c0 += TC) {
        __syncthreads();
#pragma unroll
        for (int j = 0; j < 8; ++j) {
            const int t = (tid >> 7) + 4 * j; const size_t R = (size_t)b * PB + seq_pp(c0 + t, dir);
            const bf16_t* row = QKV + R * 1536;
            qs[t * 128 + i] = bf2f(row[h * 128 + i]);
            ks_[t * 128 + i] = bf2f(row[512 + h * 128 + i]);
        }
#pragma unroll
        for (int j = 0; j < 4; ++j) {
            const int t = (tid >> 6) + 8 * j; const size_t R = (size_t)b * PB + seq_pp(c0 + t, dir);
            vs[t * 64 + (tid & 63)] = bf2f(QKV[R * 1536 + 1024 + h * 128 + half * 64 + (tid & 63)]);
        }
        if (tid < TC) {
            const size_t R = (size_t)b * PB + seq_pp(c0 + tid, dir);
            const float a = bf2f(PROJ[R * NIN1 + 1544 + dir * 4 + h]) + dtb;
            const float sp = a > 20.f ? a : __logf(1.f + __expf(a));
            egs[tid] = __expf(-Aexp * sp);
            bts[tid] = sigmoidf_(bf2f(PROJ[R * NIN1 + 1536 + dir * 4 + h]));
        }
        __syncthreads();
        scan_chunk<128, 2>(qs, ks_, nullptr, vs, egs, bts, os, S, w, cl, ksl);
        __syncthreads();
        if (seq_pp(c0, dir) >= CTX) {
            const int t = tid >> 4, c4 = (tid & 15) * 4; const size_t R = (size_t)b * PB + seq_pp(c0 + t, dir);
            uint2 o; o.x = pk2(os[t * 64 + c4], os[t * 64 + c4 + 1]); o.y = pk2(os[t * 64 + c4 + 2], os[t * 64 + c4 + 3]);
            *(uint2*)(OD + R * 512 + h * 128 + half * 64 + c4) = o;
        }
    }
}

__device__ __forceinline__ void ph_delta_T(const P& p, LAS unsigned char* lds, int bid, int nb) {
    const int tid = otid(), lane = tid & 63, w = __builtin_amdgcn_readfirstlane(tid >> 6), r16 = lane & 15, q4 = lane >> 4;
    LAS unsigned char* wl = lds + w * 17920;
    LAS float* GA = (LAS float*)(wl + 17408); LAS float* BE = GA + 64;
    LAS float* Af = (LAS float*)wl;
    const bf16_t* PROJ = (const bf16_t*)(p.ws + WS_BIG);
    const bf16_t* QKV = (const bf16_t*)(p.ws + WS_SCR);
    bf16_t* TM = (bf16_t*)(p.ws + WS_TM);
    __syncthreads();
    for (int u = bid * 8 + w; u < 8448; u += nb * 8) {
        const int n = u % 132, hh = (u / 132) & 3, b = (u / 528) & 7, dir = u / 4224;
        const size_t R = (size_t)b * PB + seq_pp(n * 64 + lane, dir);
        const float Aexp = __expf((dir ? p.in[31] : p.in[29])[hh]), dtb = (dir ? p.in[32] : p.in[30])[hh];
        const float a = bf2f(PROJ[R * NIN1 + 1544 + dir * 4 + hh]) + dtb;
        const float sp = a > 20.f ? a : __logf(1.f + __expf(a));
        float gam = -Aexp * sp;
        const float beta = sigmoidf_(bf2f(PROJ[R * NIN1 + 1536 + dir * 4 + hh]));
#pragma unroll
        for (int o = 1; o < 64; o <<= 1) { const float t = __shfl_up(gam, o); if (lane >= o) gam += t; }
        GA[lane] = gam; BE[lane] = beta;
        { float* GB = (float*)(p.ws + WS_WIN0) + (size_t)u * 128; GB[lane] = gam; GB[64 + lane] = beta; }
        {
#pragma unroll
          for (int j = 0; j < 16; ++j) { const int row = 4 * j + (lane >> 4); const size_t Rr = (size_t)b * PB + seq_pp(n * 64 + row, dir);
              const uint4 v = *(const uint4*)(QKV + Rr * 1536 + 512 + hh * 128 + (lane & 15) * 8); *(LAS u32x4*)(wl + row * 272 + (lane & 15) * 16) = (u32x4){v.x, v.y, v.z, v.w}; } }
        WAVE_FENCE();
        f32x4 at[10];
        { int ix = 0;
#pragma unroll
          for (int tt = 0; tt < 4; ++tt)
#pragma unroll
            for (int st = 0; st <= tt; ++st) { at[ix] = mma_tile<4>(wl, 272, tt * 16, wl, 272, st * 16, (f32x4){0.f, 0.f, 0.f, 0.f}, lane); ++ix; } }
        float gsig[4], gtau[4][4], btau[4][4];
#pragma unroll
        for (int st = 0; st < 4; ++st) gsig[st] = GA[st * 16 + r16];
#pragma unroll
        for (int tt = 0; tt < 4; ++tt) { const f32x4 g4 = *(const LAS f32x4*)(GA + tt * 16 + 4 * q4), b4 = *(const LAS f32x4*)(BE + tt * 16 + 4 * q4);
#pragma unroll
            for (int e = 0; e < 4; ++e) { gtau[tt][e] = g4[e]; btau[tt][e] = b4[e]; } }
        WAVE_FENCE();
        LAS float* AD = (LAS float*)wl;
        LAS unsigned char* AO = wl + 4096;
        LAS unsigned char* TT = wl + 8704;
        LAS float* YS = (LAS float*)(wl + 13312);
        { int ix = 0;
#pragma unroll
          for (int tt = 0; tt < 4; ++tt)
#pragma unroll
            for (int st = 0; st <= tt; ++st) {
#pragma unroll
                for (int e = 0; e < 4; ++e) { const int tau = tt * 16 + 4 * q4 + e, sg = st * 16 + r16;
                    const float val = (sg < tau) ? btau[tt][e] * __expf(gtau[tt][e] - gsig[st]) * at[ix][e] : 0.f;
                    if (st == tt) AD[tau * 16 + r16] = val; else *(LAS bf16_t*)(AO + (tau - 16) * 96 + sg * 2) = f2bf(val); }
                ++ix; } }
        WAVE_FENCE();
        float T[64];
#pragma unroll
        for (int i = 0; i < 4; ++i) {
            float y[16];
#pragma unroll
            for (int r = 0; r < 16; ++r) y[r] = 0.f;
            if (i > 0) {
#pragma unroll
                for (int ct = 0; ct < i; ++ct) {
                    f32x4 d = (f32x4){0.f, 0.f, 0.f, 0.f};
                    const LAS unsigned char* ap = AO + ((i - 1) * 16 + r16) * 96; const LAS unsigned char* bp = TT + (ct * 16 + r16) * 96;
                    const bf16x8 z8 = {0, 0, 0, 0, 0, 0, 0, 0};
                    if (i >= 2) d = __builtin_amdgcn_mfma_f32_16x16x32_bf16(*(const LAS bf16x8*)(ap + q4 * 16), *(const LAS bf16x8*)(bp + q4 * 16), d, 0, 0, 0);
                    if (i == 1 || i == 3) {
                        const int ko = (i == 3) ? 64 : 0;
                        bf16x8 av = *(const LAS bf16x8*)(ap + ko + q4 * 16), bv = *(const LAS bf16x8*)(bp + ko + q4 * 16);
                        if (q4 >= 2) { av = z8; bv = z8; }
                        d = __builtin_amdgcn_mfma_f32_16x16x32_bf16(av, bv, d, 0, 0, 0);
                    }
#pragma unroll
                    for (int e = 0; e < 4; ++e) YS[(4 * q4 + e) * 52 + ct * 16 + r16] = d[e];
                }
                WAVE_FENCE();
                if (lane < 16 * i) {
#pragma unroll
                    for (int r = 0; r < 16; ++r) y[r] = YS[r * 52 + lane];
                }
            }
#pragma unroll
            for (int r = 0; r < 16; ++r) {
                float acc = ((i * 16 + r == lane) ? 1.f : 0.f) - y[r];
#pragma unroll
                for (int k4 = 0; k4 * 4 < r; ++k4) {
                    const f32x4 a4 = *(const LAS f32x4*)(AD + (i * 16 + r) * 16 + k4 * 4);
#pragma unroll
                    for (int e = 0; e < 4; ++e) if (k4 * 4 + e < r) acc -= a4[e] * T[i * 16 + k4 * 4 + e];
                }
                T[i * 16 + r] = acc;
            }
            if (i < 3) {
                if (lane < 48) {
                    const u32x4 v0 = {pk2(T[i * 16 + 0], T[i * 16 + 1]), pk2(T[i * 16 + 2], T[i * 16 + 3]), pk2(T[i * 16 + 4], T[i * 16 + 5]), pk2(T[i * 16 + 6], T[i * 16 + 7])};
                    const u32x4 v1 = {pk2(T[i * 16 + 8], T[i * 16 + 9]), pk2(T[i * 16 + 10], T[i * 16 + 11]), pk2(T[i * 16 + 12], T[i * 16 + 13]), pk2(T[i * 16 + 14], T[i * 16 + 15])};
                    *(LAS u32x4*)(TT + lane * 96 + i * 32) = v0; *(LAS u32x4*)(TT + lane * 96 + i * 32 + 16) = v1;
                }
                WAVE_FENCE();
            }
        }
        WAVE_FENCE();
#pragma unroll
        for (int r = 0; r < 64; ++r) *(LAS bf16_t*)(wl + r * 144 + lane * 2) = f2bf(T[r]);
        WAVE_FENCE();
#pragma unroll
        for (int j = 0; j < 8; ++j) { const u32x4 v = *(const LAS u32x4*)(wl + lane * 144 + j * 16); *(uint4*)(TM + (size_t)u * 4096 + lane * 64 + j * 8) = make_uint4(v[0], v[1], v[2], v[3]); }
        WAVE_FENCE();
    }
}

__device__ __forceinline__ void scan_delta_chunked(const P& p, int idx, LAS unsigned char* lds) {
    constexpr int C = 64, SQ = 272, S64 = 144;
    constexpr int OFF_KR = 0, OFF_QR = OFF_KR + 64 * SQ, OFF_QG = OFF_QR + 64 * SQ, OFF_NKG = OFF_QG + 64 * SQ, OFF_KLT = OFF_NKG + 64 * SQ,
                  OFF_VBT = OFF_KLT + 128 * S64, OFF_P2 = OFF_VBT + 64 * S64, OFF_VNT = OFF_P2 + 64 * S64, OFF_ST0 = OFF_VNT + 64 * S64, OFF_ST1 = OFF_ST0 + 64 * SQ,
                  OFF_GA = OFF_ST1 + 64 * SQ, OFF_VB = OFF_GA + 256, OFF_END = OFF_VB + 64 * S64;
    static_assert(OFF_END <= LDS_CTL, "delta LDS");
    const int b = idx >> 4, h = (idx >> 2) & 3, dir = (idx >> 1) & 1, half = idx & 1;
    const int tid = otid(), lane = tid & 63, w = __builtin_amdgcn_readfirstlane(tid >> 6), r16 = lane & 15, q4 = lane >> 4;
    const bf16_t* PROJ = (const bf16_t*)(p.ws + WS_BIG);
    const bf16_t* QKV = (const bf16_t*)(p.ws + WS_SCR);
    const bf16_t* TM = (const bf16_t*)(p.ws + WS_TM) + (size_t)(((dir * 8 + b) * 4 + h) * 132) * 4096;
    bf16_t* OD = (bf16_t*)(p.ws + WS_OFB1) + (size_t)dir * MT * 512 + h * 128 + half * 64;
    LAS float* GA = (LAS float*)(lds + OFF_GA);
    const float* GB = (const float*)(p.ws + WS_WIN0) + (size_t)(((dir * 8 + b) * 4 + h) * 132) * 128;
    const int pk = lane & 15, rk_ = 8 * w + (lane >> 4), pv = lane & 7, rv_ = 8 * w + (lane >> 3);
    f32x4 sacc[4];
#pragma unroll
    for (int k = 0; k < 4; ++k) sacc[k] = (f32x4){0.f, 0.f, 0.f, 0.f};
    __syncthreads();
    for (int k = tid; k < 64 * SQ / 4; k += NTHR) ((LAS unsigned*)(lds + OFF_ST0))[k] = 0u;
    int cur = 0;
    uint4 rk0, rk1, rq0, rq1, rvv; float gtok, btok; bf16x8 tn0, tn1;
    uint4 pk0, pk1, pq0, pq1, pvv; float ptok, pbtk; bf16x8 pt0, pt1;
#define DL_LOAD(XK0, XK1, XQ0, XQ1, XVV, XTOK, XBTK, XT0, XT1, n) do { \
        const size_t R0 = (size_t)b * PB + seq_pp((n) * C + rk_, dir), R1 = (size_t)b * PB + seq_pp((n) * C + rk_ + 4, dir), RV = (size_t)b * PB + seq_pp((n) * C + rv_, dir); \
        XQ0 = *(const uint4*)(QKV + R0 * 1536 + h * 128 + pk * 8); XQ1 = *(const uint4*)(QKV + R1 * 1536 + h * 128 + pk * 8); \
        XK0 = *(const uint4*)(QKV + R0 * 1536 + 512 + h * 128 + pk * 8); XK1 = *(const uint4*)(QKV + R1 * 1536 + 512 + h * 128 + pk * 8); \
        XVV = *(const uint4*)(QKV + RV * 1536 + 1024 + h * 128 + half * 64 + pv * 8); \
        { const float* gb = GB + (size_t)(n) * 128; XTOK = gb[lane]; XBTK = gb[64 + lane]; } \
        { const bf16_t* tp = TM + (size_t)(n) * 4096 + ((w >> 1) * 16 + r16) * 64 + q4 * 8; XT0 = *(const bf16x8*)tp; XT1 = *(const bf16x8*)(tp + 32); } } while (0)
    DL_LOAD(rk0, rk1, rq0, rq1, rvv, gtok, btok, tn0, tn1, 0);
    DL_LOAD(pk0, pk1, pq0, pq1, pvv, ptok, pbtk, pt0, pt1, 1);
    for (int n = 0; n < PB / C; ++n) {
        float egl, eltok; unsigned qg[8];
        const bf16x8 tf0 = tn0, tf1 = tn1;
        {
            const float glast = __shfl(gtok, 63);
            const float gk0 = __shfl(gtok, rk_), gk1 = __shfl(gtok, rk_ + 4), bk0 = __shfl(btok, rk_), bk1 = __shfl(btok, rk_ + 4), bvv = __shfl(btok, rv_);
            egl = fexp(glast); eltok = fexp(glast - gtok);
            if (w == 0) GA[lane] = gtok;
            const float eg0 = fexp(gk0), eg1 = fexp(gk1), nb0 = -bk0 * eg0, nb1 = -bk1 * eg1;
            const int o0 = rk_ * SQ + pk * 16, o1 = (rk_ + 4) * SQ + pk * 16;
            *(LAS u32x4*)(lds + OFF_KR + o0) = (u32x4){rk0.x, rk0.y, rk0.z, rk0.w}; *(LAS u32x4*)(lds + OFF_KR + o1) = (u32x4){rk1.x, rk1.y, rk1.z, rk1.w};
            *(LAS u32x4*)(lds + OFF_QR + o0) = (u32x4){rq0.x, rq0.y, rq0.z, rq0.w}; *(LAS u32x4*)(lds + OFF_QR + o1) = (u32x4){rq1.x, rq1.y, rq1.z, rq1.w};
            const unsigned qw[8] = {rq0.x, rq0.y, rq0.z, rq0.w, rq1.x, rq1.y, rq1.z, rq1.w};
            const unsigned kw[8] = {rk0.x, rk0.y, rk0.z, rk0.w, rk1.x, rk1.y, rk1.z, rk1.w};
            unsigned nkg[8];
#pragma unroll
            for (int e = 0; e < 8; ++e) {
                const float eg = e < 4 ? eg0 : eg1, nbg = e < 4 ? nb0 : nb1;
                qg[e] = pk2(bflo(qw[e]) * eg, bfhi(qw[e]) * eg);
                nkg[e] = pk2(bflo(kw[e]) * nbg, bfhi(kw[e]) * nbg);
            }
            *(LAS u32x4*)(lds + OFF_NKG + o0) = (u32x4){nkg[0], nkg[1], nkg[2], nkg[3]}; *(LAS u32x4*)(lds + OFF_NKG + o1) = (u32x4){nkg[4], nkg[5], nkg[6], nkg[7]};
            *(LAS u32x4*)(lds + OFF_VB + rv_ * S64 + pv * 16) = (u32x4){pk2(bflo(rvv.x) * bvv, bfhi(rvv.x) * bvv), pk2(bflo(rvv.y) * bvv, bfhi(rvv.y) * bvv), pk2(bflo(rvv.z) * bvv, bfhi(rvv.z) * bvv), pk2(bflo(rvv.w) * bvv, bfhi(rvv.w) * bvv)};
        }
        LDS_SYNC();
        *(LAS u32x4*)(lds + OFF_QG + rk_ * SQ + pk * 16) = (u32x4){qg[0], qg[1], qg[2], qg[3]}; *(LAS u32x4*)(lds + OFF_QG + (rk_ + 4) * SQ + pk * 16) = (u32x4){qg[4], qg[5], qg[6], qg[7]};
        {
            const u32x4 ka = *(const LAS u32x4*)(lds + OFF_KR + lane * SQ + w * 32), kb = *(const LAS u32x4*)(lds + OFF_KR + lane * SQ + w * 32 + 16);
            const unsigned kw2[8] = {ka[0], ka[1], ka[2], ka[3], kb[0], kb[1], kb[2], kb[3]};
#pragma unroll
            for (int e = 0; e < 8; ++e) { *(LAS bf16_t*)(lds + OFF_KLT + (16 * w + 2 * e) * S64 + lane * 2) = f2bf(bflo(kw2[e]) * eltok); *(LAS bf16_t*)(lds + OFF_KLT + (16 * w + 2 * e + 1) * S64 + lane * 2) = f2bf(bfhi(kw2[e]) * eltok); }
        }
        rk0 = pk0; rk1 = pk1; rq0 = pq0; rq1 = pq1; rvv = pvv; gtok = ptok; btok = pbtk; tn0 = pt0; tn1 = pt1;
        if (n + 2 < PB / C) DL_LOAD(pk0, pk1, pq0, pq1, pvv, ptok, pbtk, pt0, pt1, n + 2);
        const int stc = cur ? OFF_ST1 : OFF_ST0, stn = cur ? OFF_ST0 : OFF_ST1;
#pragma unroll
        for (int k = 0; k < 2; ++k) {
            const int tile = w + 8 * k, st = tile >> 2, tt = tile & 3;
            f32x4 d = (f32x4){0.f, 0.f, 0.f, 0.f};
            if (st <= tt) d = mma_tile<4>(lds + OFF_KR, SQ, st * 16, lds + OFF_QR, SQ, tt * 16, d, lane);
            const int s0 = st * 16 + 4 * q4, t = tt * 16 + r16;
            const float gt = GA[t]; const f32x4 gs = *(const LAS f32x4*)(GA + s0);
            u32x2 o; o.x = pk2(s0 <= t ? d[0] * fexp(gt - gs[0]) : 0.f, s0 + 1 <= t ? d[1] * fexp(gt - gs[1]) : 0.f);
            o.y = pk2(s0 + 2 <= t ? d[2] * fexp(gt - gs[2]) : 0.f, s0 + 3 <= t ? d[3] * fexp(gt - gs[3]) : 0.f);
            *(LAS u32x2*)(lds + OFF_P2 + t * S64 + s0 * 2) = o;
        }
#pragma unroll
        for (int k = 0; k < 2; ++k) {
            const int st = w >> 1, ct = (w & 1) * 2 + k;
            LAS u32x2* zp = (LAS u32x2*)(lds + OFF_VBT + (ct * 16 + r16) * S64 + (st * 16 + 4 * q4) * 2);
            const LAS unsigned char* vbp = lds + OFF_VB + (st * 16 + 4 * q4) * S64 + (ct * 16 + r16) * 2;
            f32x4 d = (f32x4){bf2f(*(const LAS bf16_t*)vbp), bf2f(*(const LAS bf16_t*)(vbp + S64)), bf2f(*(const LAS bf16_t*)(vbp + 2 * S64)), bf2f(*(const LAS bf16_t*)(vbp + 3 * S64))};
            d = mma_tile<4>(lds + OFF_NKG, SQ, st * 16, lds + stc, SQ, ct * 16, d, lane);
            u32x2 o; o.x = pk2(d[0], d[1]); o.y = pk2(d[2], d[3]);
            *zp = o;
        }
        LDS_SYNC();
#pragma unroll
        for (int k = 0; k < 2; ++k) {
            const int tt = w >> 1, ct = (w & 1) * 2 + k;
            const LAS unsigned char* zb = lds + OFF_VBT + (ct * 16 + r16) * S64 + q4 * 16;
            const bf16x8 b0 = *(const LAS bf16x8*)zb, b1 = *(const LAS bf16x8*)(zb + 64);
            f32x4 d = __builtin_amdgcn_mfma_f32_16x16x32_bf16(tf0, b0, (f32x4){0.f, 0.f, 0.f, 0.f}, 0, 0, 0);
            d = __builtin_amdgcn_mfma_f32_16x16x32_bf16(tf1, b1, d, 0, 0, 0);
            u32x2 o; o.x = pk2(d[0], d[1]); o.y = pk2(d[2], d[3]);
            *(LAS u32x2*)(lds + OFF_VNT + (ct * 16 + r16) * S64 + (tt * 16 + 4 * q4) * 2) = o;
        }
        LDS_SYNC();
        {
            const bool lat = seq_pp(n * C, dir) >= CTX;
            uint4 ov;
            {
                const int tt = w >> 1, cA = 32 * (w & 1) + 8 * (r16 >> 2) + (r16 & 3);
#pragma unroll
                for (int k = 0; k < 2; ++k) {
                    f32x4 d = mma_tile_rows<2>(lds + OFF_VNT, S64, cA + 4 * k, lds + OFF_P2, S64, tt * 16, (f32x4){0.f, 0.f, 0.f, 0.f}, lane);
                    d = mma_tile_rows<4>(lds + stc, SQ, cA + 4 * k, lds + OFF_QG, SQ, tt * 16, d, lane);
                    if (k == 0) { ov.x = pk2(d[0], d[1]); ov.y = pk2(d[2], d[3]); } else { ov.z = pk2(d[0], d[1]); ov.w = pk2(d[2], d[3]); }
                }
                if (lat) { const size_t R = (size_t)b * PB + seq_pp(n * C + tt * 16 + r16, dir); *(uint4*)(OD + R * 512 + 32 * (w & 1) + 8 * q4) = ov; }
            }
#pragma unroll
            for (int ct = 0; ct < 4; ++ct) {
                f32x4 a = sacc[ct]; a[0] *= egl; a[1] *= egl; a[2] *= egl; a[3] *= egl;
                a = mma_tile<2>(lds + OFF_KLT, S64, w * 16, lds + OFF_VNT, S64, ct * 16, a, lane);
                sacc[ct] = a;
                u32x2 o; o.x = pk2(a[0], a[1]); o.y = pk2(a[2], a[3]);
                *(LAS u32x2*)(lds + stn + (ct * 16 + r16) * SQ + (w * 16 + 4 * q4) * 2) = o;
            }
        }
        cur ^= 1;
    }
#undef DL_LOAD
}

__device__ __forceinline__ void ph_prep1(const P& p, int bid, int nb) {
    const int lane = otid() & 63, wv = __builtin_amdgcn_readfirstlane(otid() >> 6);
    bf16_t* PROJ = (bf16_t*)(p.ws + WS_BIG);
    bf16_t* QKV = (bf16_t*)(p.ws + WS_SCR);
    const float* cw = p.in[28];
    const int stride = nb * 8;
    const unsigned lane16 = (unsigned)lane * 16u;
#define P1_LOAD(X, R_) do { int b_, pp_; row_decode((R_), b_, pp_); const int lo_ = pp_ < CTX ? 0 : CTX, hi_ = pp_ < CTX ? CTX : PB; \
        _Pragma("unroll") for (int j = 0; j < 5; ++j) { const int q_ = pp_ + j - 2; const bool ok_ = q_ >= lo_ && q_ < hi_; \
            const unsigned char* rowp_ = (const unsigned char*)(PROJ + (size_t)((R_) + j - 2) * NIN1);        \
            _Pragma("unroll") for (int g = 0; g < 3; ++g) { X[g][j] = make_uint4(0u, 0u, 0u, 0u); if (ok_) X[g][j] = *(const uint4*)(rowp_ + g * 1024 + lane16); } } } while (0)
#define P1_ROW(X, R_) do { const int R = (R_); int b, pp; row_decode(R, b, pp); \
        unsigned rq[6];        \
        if (pp >= CTX) { _Pragma("unroll") for (int k = 0; k < 3; ++k) { const int m = lane + 64 * k; if (m < 160) { const bf16_t* q = PROJ + (size_t)R * NIN1 + 2064 + (m >> 4) * 64 + (m & 15) * 2; \
            rq[2 * k] = *(const unsigned*)q; rq[2 * k + 1] = *(const unsigned*)(q + 32); } } } \
        _Pragma("unroll") for (int g = 0; g < 3; ++g) { \
            const int ch = g * 512 + lane * 8; \
            float a[8]; \
            _Pragma("unroll") for (int e = 0; e < 8; ++e) a[e] = 0.f; \
            _Pragma("unroll") for (int j = 0; j < 5; ++j) { \
                const uint4 xv = X[g][j]; \
                const float4 w0 = *(const float4*)(cw + j * 1536 + ch), w1 = *(const float4*)(cw + j * 1536 + ch + 4); \
                a[0] += w0.x * bflo(xv.x); a[1] += w0.y * bfhi(xv.x); a[2] += w0.z * bflo(xv.y); a[3] += w0.w * bfhi(xv.y); \
                a[4] += w1.x * bflo(xv.z); a[5] += w1.y * bfhi(xv.z); a[6] += w1.z * bflo(xv.w); a[7] += w1.w * bfhi(xv.w); } \
            float ss = 0.f; \
            _Pragma("unroll") for (int e = 0; e < 8; ++e) { a[e] = siluf_(a[e]); ss += a[e] * a[e]; } \
            if (g < 2) { \
                ss += __shfl_xor(ss, 1); ss += __shfl_xor(ss, 2); ss += __shfl_xor(ss, 4); ss += __shfl_xor(ss, 8); \
                const float sc = rsqrtf(ss + EPS) * (g == 0 ? 0.08838834764831845f : 1.f); \
                _Pragma("unroll") for (int e = 0; e < 8; ++e) a[e] *= sc; } \
            uint4 o; o.x = pk2(a[0], a[1]); o.y = pk2(a[2], a[3]); o.z = pk2(a[4], a[5]); o.w = pk2(a[6], a[7]); \
            *(uint4*)(QKV + (size_t)R * 1536 + ch) = o; } \
        if (pp >= CTX) { \
            const int t = pp - CTX; const float rowp = (float)(t >> 6), colp = (float)(t & 63); \
            _Pragma("unroll") for (int k = 0; k < 3; ++k) { \
                const int m = lane + 64 * k; \
                if (m < 160) { \
                    const int hd = m >> 4, f2 = (m & 15) * 2; \
                    const float pos = (f2 < 16 ? rowp : colp) * 0.15915494309189535f; \
                    const float rev0 = pos * __builtin_amdgcn_exp2f(-(float)(f2 & 15) * (13.287712379549449f / 16.f)), rev1 = pos * __builtin_amdgcn_exp2f(-(float)((f2 + 1) & 15) * (13.287712379549449f / 16.f)); \
                    const float sn0 = __builtin_amdgcn_sinf(rev0), cs0 = __builtin_amdgcn_cosf(rev0), sn1 = __builtin_amdgcn_sinf(rev1), cs1 = __builtin_amdgcn_cosf(rev1); \
                    bf16_t* q = PROJ + (size_t)R * NIN1 + 2064 + hd * 64 + f2; \
                    const float x1a = bflo(rq[2 * k]), x1b = bfhi(rq[2 * k]), x2a = bflo(rq[2 * k + 1]), x2b = bfhi(rq[2 * k + 1]); \
                    *(unsigned*)q = pk2(x1a * cs0 - x2a * sn0, x1b * cs1 - x2b * sn1); *(unsigned*)(q + 32) = pk2(x2a * cs0 + x1a * sn0, x2b * cs1 + x1b * sn1); } } } } while (0)
    uint4 xa[3][5], xb[3][5];
    int R0 = bid * 8 + wv;
    if (R0 < MT) P1_LOAD(xa, R0);
#pragma nounroll
    for (; R0 < MT; R0 += 2 * stride) {
        const int R1 = R0 + stride, R2 = R0 + 2 * stride;
        if (R1 < MT) P1_LOAD(xb, R1);
        P1_ROW(xa, R0);
        if (R2 < MT) P1_LOAD(xa, R2);
        if (R1 < MT) P1_ROW(xb, R1);
    }
#undef P1_LOAD
#undef P1_ROW
}

__device__ __forceinline__ void attn_unit(const P& p, int u, float* ldsf) {
    const int b = u >> 7, qb = (u >> 1) & 63, kvh = u & 1;
    const int tid = otid(), g = tid >> 7, qi = tid & 127, hq = kvh * 4 + g;
    const int t0 = qb * 128, t = t0 + qi;
    const bf16_t* PROJ = (const bf16_t*)(p.ws + WS_BIG);
    bf16_t* Y = (bf16_t*)(p.ws + WS_H);
    float* Ks = ldsf; float* Vs = ldsf + 128 * 64;
    const size_t Rq = (size_t)b * PB + CTX + t;
    float q[64], acc[64];
    {
        const uint4* qp = (const uint4*)(PROJ + Rq * NIN1 + 2064 + hq * 64);
#pragma unroll
        for (int i = 0; i < 8; ++i) { const uint4 v = qp[i]; q[i * 8 + 0] = bflo(v.x) * 0.125f; q[i * 8 + 1] = bfhi(v.x) * 0.125f; q[i * 8 + 2] = bflo(v.y) * 0.125f; q[i * 8 + 3] = bfhi(v.y) * 0.125f;
            q[i * 8 + 4] = bflo(v.z) * 0.125f; q[i * 8 + 5] = bfhi(v.z) * 0.125f; q[i * 8 + 6] = bflo(v.w) * 0.125f; q[i * 8 + 7] = bfhi(v.w) * 0.125f; }
    }
#pragma unroll
    for (int d = 0; d < 64; ++d) acc[d] = 0.f;
    float mx = p.in[34][hq], l = 1.f;
    for (int kt = 0; kt < 5; ++kt) {
        const int kbase = t0 - 128 + kt * 128;
        if (kt < 3 && (kbase < 0 || kbase >= SEQ)) continue;
        __syncthreads();
        {
            const int key = tid >> 2, d0 = (tid & 3) * 16;
            const size_t Rk = kt < 3 ? ((size_t)b * PB + CTX + kbase + key) : ((size_t)b * PB + (kt - 3) * 128 + key);
            const uint4* kp = (const uint4*)(PROJ + Rk * NIN1 + 2576 + kvh * 64 + d0);
            const uint4* vp = (const uint4*)(PROJ + Rk * NIN1 + 2704 + kvh * 64 + d0);
#pragma unroll
            for (int i = 0; i < 2; ++i) {
                const uint4 kv = kp[i], vv = vp[i];
                float* kd = Ks + key * 64 + d0 + i * 8; float* vd = Vs + key * 64 + d0 + i * 8;
                kd[0] = bflo(kv.x); kd[1] = bfhi(kv.x); kd[2] = bflo(kv.y); kd[3] = bfhi(kv.y); kd[4] = bflo(kv.z); kd[5] = bfhi(kv.z); kd[6] = bflo(kv.w); kd[7] = bfhi(kv.w);
                vd[0] = bflo(vv.x); vd[1] = bfhi(vv.x); vd[2] = bflo(vv.y); vd[3] = bfhi(vv.y); vd[4] = bflo(vv.z); vd[5] = bfhi(vv.z); vd[6] = bflo(vv.w); vd[7] = bfhi(vv.w);
            }
        }
        __syncthreads();
        for (int j = 0; j < 128; ++j) {
            float s = 0.f;
#pragma unroll
            for (int d4 = 0; d4 < 16; ++d4) { const float4 k4 = *(const float4*)(Ks + j * 64 + d4 * 4); s += q[d4 * 4] * k4.x + q[d4 * 4 + 1] * k4.y + q[d4 * 4 + 2] * k4.z + q[d4 * 4 + 3] * k4.w; }
            bool valid = true;
            if (kt < 3) { const int dk_ = kbase + j - t; valid = (dk_ <= 128) && (dk_ >= -128); }
            if (valid && s > mx) {
                const float corr = __expf(mx - s); l *= corr;
#pragma unroll
                for (int d = 0; d < 64; ++d) acc[d] *= corr;
                mx = s;
            }
            const float pr = valid ? __expf(s - mx) : 0.f;
            l += pr;
#pragma unroll
            for (int d4 = 0; d4 < 16; ++d4) { const float4 v4 = *(const float4*)(Vs + j * 64 + d4 * 4); acc[d4 * 4] += pr * v4.x; acc[d4 * 4 + 1] += pr * v4.y; acc[d4 * 4 + 2] += pr * v4.z; acc[d4 * 4 + 3] += pr * v4.w; }
        }
    }
    const float il = 1.f / l;
    uint4* yp = (uint4*)(Y + Rq * D + 512 + hq * 64);
#pragma unroll
    for (int i = 0; i < 8; ++i) { uint4 o; o.x = pk2(acc[i * 8] * il, acc[i * 8 + 1] * il); o.y = pk2(acc[i * 8 + 2] * il, acc[i * 8 + 3] * il); o.z = pk2(acc[i * 8 + 4] * il, acc[i * 8 + 5] * il); o.w = pk2(acc[i * 8 + 6] * il, acc[i * 8 + 7] * il); yp[i] = o; }
}

__device__ __forceinline__ void attn_unit_mfma(const P& p, int u, LAS unsigned char* lds) {
    constexpr int S64 = 144, OFF_K = 0, OFF_VT = 64 * S64, OFF_P = 2 * 64 * S64;
    const int b = u >> 7, qb = (u >> 1) & 63, kvh = u & 1;
    const int tid = otid(), lane = tid & 63, w = __builtin_amdgcn_readfirstlane(tid >> 6), r16 = lane & 15, q4 = lane >> 4;
    const int hq = kvh * 4 + (w >> 1), t0 = qb * 128, tq0 = t0 + (w & 1) * 64;
    const bf16_t* PROJ = (const bf16_t*)(p.ws + WS_BIG);
    bf16_t* Y = (bf16_t*)(p.ws + WS_H);
    LAS unsigned char* Pw = lds + OFF_P + w * (64 * S64);
    bf16x8 qf[4][2];
#pragma unroll
    for (int qt = 0; qt < 4; ++qt)
#pragma unroll
        for (int kb = 0; kb < 2; ++kb) qf[qt][kb] = *(const bf16x8*)(PROJ + ((size_t)b * PB + CTX + tq0 + qt * 16 + r16) * NIN1 + 2064 + hq * 64 + kb * 32 + q4 * 8);
    f32x4 oacc[4][4];
#pragma unroll
    for (int qt = 0; qt < 4; ++qt)
#pragma unroll
        for (int dt = 0; dt < 4; ++dt) oacc[qt][dt] = (f32x4){0.f, 0.f, 0.f, 0.f};
    constexpr float CS = 0.125f * 1.4426950408889634f;
    float m2[4], lp[4];
#pragma unroll
    for (int qt = 0; qt < 4; ++qt) { m2[qt] = p.in[34][hq] * 1.4426950408889634f; lp[qt] = (q4 == 0) ? 1.f : 0.f; }
    for (int kt = 0; kt < 10; ++kt) {
        const bool local = kt < 6; const int kbase = t0 - 128 + kt * 64;
        if (local && (kbase < 0 || kbase >= SEQ)) continue;
        LDS_SYNC();
        {
            const int key = tid >> 3, d8 = (tid & 7) * 8;
            const size_t Rk = local ? ((size_t)b * PB + CTX + kbase + key) : ((size_t)b * PB + (kt - 6) * 64 + key);
            const uint4 kv = *(const uint4*)(PROJ + Rk * NIN1 + 2576 + kvh * 64 + d8), vv = *(const uint4*)(PROJ + Rk * NIN1 + 2704 + kvh * 64 + d8);
            *(LAS u32x4*)(lds + OFF_K + key * S64 + d8 * 2) = (u32x4){kv.x, kv.y, kv.z, kv.w};
            const unsigned vw[4] = {vv.x, vv.y, vv.z, vv.w};
#pragma unroll
            for (int e = 0; e < 4; ++e) { *(LAS bf16_t*)(lds + OFF_VT + (d8 + 2 * e) * S64 + key * 2) = (bf16_t)(vw[e] & 0xffffu); *(LAS bf16_t*)(lds + OFF_VT + (d8 + 2 * e + 1) * S64 + key * 2) = (bf16_t)(vw[e] >> 16); }
        }
        LDS_SYNC();
        if (local && (kbase + 63 < tq0 - 128 || kbase > tq0 + 63 + 128)) continue;
        f32x4 st[4][4];
#pragma unroll
        for (int k16 = 0; k16 < 4; ++k16) {
            const bf16x8 a0 = *(const LAS bf16x8*)(lds + OFF_K + (k16 * 16 + r16) * S64 + q4 * 16), a1 = *(const LAS bf16x8*)(lds + OFF_K + (k16 * 16 + r16) * S64 + 64 + q4 * 16);
#pragma unroll
            for (int qt = 0; qt < 4; ++qt) {
                f32x4 d = __builtin_amdgcn_mfma_f32_16x16x32_bf16(a0, qf[qt][0], (f32x4){0.f, 0.f, 0.f, 0.f}, 0, 0, 0);
                st[k16][qt] = __builtin_amdgcn_mfma_f32_16x16x32_bf16(a1, qf[qt][1], d, 0, 0, 0);
            }
        }
#pragma unroll
        for (int qt = 0; qt < 4; ++qt) {
            float mx = -3.0e38f;
            if (local) {
                const int tq = tq0 + qt * 16 + r16;
#pragma unroll
                for (int k16 = 0; k16 < 4; ++k16)
#pragma unroll
                    for (int e = 0; e < 4; ++e) { const int dk_ = kbase + k16 * 16 + 4 * q4 + e - tq; if (dk_ > 128 || dk_ < -128) st[k16][qt][e] = -3.0e38f; }
            }
#pragma unroll
            for (int k16 = 0; k16 < 4; ++k16) mx = fmaxf(fmaxf(mx, fmaxf(st[k16][qt][0], st[k16][qt][1])), fmaxf(st[k16][qt][2], st[k16][qt][3]));
            mx = fmaxf(mx, __shfl_xor(mx, 16)); mx = fmaxf(mx, __shfl_xor(mx, 32));
            const float mn = fmaxf(m2[qt], mx * CS), corr = __builtin_amdgcn_exp2f(m2[qt] - mn);
            m2[qt] = mn; lp[qt] *= corr;
#pragma unroll
            for (int dt = 0; dt < 4; ++dt) { oacc[qt][dt][0] *= corr; oacc[qt][dt][1] *= corr; oacc[qt][dt][2] *= corr; oacc[qt][dt][3] *= corr; }
            float ls = 0.f;
#pragma unroll
            for (int k16 = 0; k16 < 4; ++k16) {
                const float p0 = __builtin_amdgcn_exp2f(fmaf(st[k16][qt][0], CS, -mn)), p1 = __builtin_amdgcn_exp2f(fmaf(st[k16][qt][1], CS, -mn)), p2 = __builtin_amdgcn_exp2f(fmaf(st[k16][qt][2], CS, -mn)), p3 = __builtin_amdgcn_exp2f(fmaf(st[k16][qt][3], CS, -mn));
                ls += (p0 + p1) + (p2 + p3);
                u32x2 o; o.x = pk2(p0, p1); o.y = pk2(p2, p3);
                *(LAS u32x2*)(Pw + (qt * 16 + r16) * S64 + (k16 * 16 + 4 * q4) * 2) = o;
            }
            lp[qt] += ls;
        }
        WAVE_FENCE();
#pragma unroll
        for (int kb = 0; kb < 2; ++kb) {
            bf16x8 vf[4];
#pragma unroll
            for (int dt = 0; dt < 4; ++dt) vf[dt] = *(const LAS bf16x8*)(lds + OFF_VT + (dt * 16 + r16) * S64 + kb * 64 + q4 * 16);
#pragma unroll
            for (int qt = 0; qt < 4; ++qt) {
                const bf16x8 pf = *(const LAS bf16x8*)(Pw + (qt * 16 + r16) * S64 + kb * 64 + q4 * 16);
#pragma unroll
                for (int dt = 0; dt < 4; ++dt) oacc[qt][dt] = __builtin_amdgcn_mfma_f32_16x16x32_bf16(vf[dt], pf, oacc[qt][dt], 0, 0, 0);
            }
        }
        WAVE_FENCE();
    }
#pragma unroll
    for (int qt = 0; qt < 4; ++qt) {
        float l = lp[qt]; l += __shfl_xor(l, 16); l += __shfl_xor(l, 32);
        const float il = 1.f / l;
        bf16_t* yp = Y + ((size_t)b * PB + CTX + tq0 + qt * 16 + r16) * D + 512 + hq * 64 + 4 * q4;
#pragma unroll
        for (int dt = 0; dt < 4; ++dt) { uint2 o; o.x = pk2(oacc[qt][dt][0] * il, oacc[qt][dt][1] * il); o.y = pk2(oacc[qt][dt][2] * il, oacc[qt][dt][3] * il); *(uint2*)(yp + dt * 16) = o; }
    }
}

__device__ __forceinline__ void ph_combine0(const P& p, int bid, int nb) {
    const int lane = otid() & 63, wv = otid() >> 6;
    const bf16_t* OF = (const bf16_t*)(p.ws + WS_SCR); const bf16_t* OB = OF + (size_t)MT * D;
    const bf16_t* PROJ = (const bf16_t*)(p.ws + WS_BIG);
    bf16_t* Y = (bf16_t*)(p.ws + WS_H);
    const int c0 = lane * 16, type = c0 >> 9, cc = c0 & 511;
    const float* nw = (type ? p.in[14] : p.in[13]) + (cc & 127);
    const int ogc = (type ? 3616 : 1056) + cc;
    for (int R = bid * 8 + wv; R < MT; R += nb * 8) {
        float o[16];
        const uint4* a = (const uint4*)(OF + (size_t)R * D + c0); const uint4* bq = (const uint4*)(OB + (size_t)R * D + c0);
        float ss = 0.f;
#pragma unroll
        for (int i = 0; i < 2; ++i) { const uint4 x = ntldu4(a + i), y = ntldu4(bq + i);
            o[i * 8 + 0] = bflo(x.x) + bflo(y.x); o[i * 8 + 1] = bfhi(x.x) + bfhi(y.x); o[i * 8 + 2] = bflo(x.y) + bflo(y.y); o[i * 8 + 3] = bfhi(x.y) + bfhi(y.y);
            o[i * 8 + 4] = bflo(x.z) + bflo(y.z); o[i * 8 + 5] = bfhi(x.z) + bfhi(y.z); o[i * 8 + 6] = bflo(x.w) + bflo(y.w); o[i * 8 + 7] = bfhi(x.w) + bfhi(y.w); }
#pragma unroll
        for (int e = 0; e < 16; ++e) ss += o[e] * o[e];
        ss += __shfl_xor(ss, 1); ss += __shfl_xor(ss, 2); ss += __shfl_xor(ss, 4);
        const float rs = rsqrtf(ss * (1.f / 128.f) + EPS);
        const uint4* gp = (const uint4*)(PROJ + (size_t)R * NIN0 + ogc);
        unsigned ow[8];
#pragma unroll
        for (int i = 0; i < 2; ++i) { const uint4 gv = ntldu4(gp + i);
            const float g0 = siluf_(bflo(gv.x)), g1 = siluf_(bfhi(gv.x)), g2 = siluf_(bflo(gv.y)), g3 = siluf_(bfhi(gv.y)), g4 = siluf_(bflo(gv.z)), g5 = siluf_(bfhi(gv.z)), g6 = siluf_(bflo(gv.w)), g7 = siluf_(bfhi(gv.w));
            const float4 w0 = *(const float4*)(nw + i * 8), w1 = *(const float4*)(nw + i * 8 + 4);
            ow[i * 4 + 0] = pk2(o[i * 8 + 0] * rs * w0.x * g0, o[i * 8 + 1] * rs * w0.y * g1); ow[i * 4 + 1] = pk2(o[i * 8 + 2] * rs * w0.z * g2, o[i * 8 + 3] * rs * w0.w * g3);
            ow[i * 4 + 2] = pk2(o[i * 8 + 4] * rs * w1.x * g4, o[i * 8 + 5] * rs * w1.y * g5); ow[i * 4 + 3] = pk2(o[i * 8 + 6] * rs * w1.z * g6, o[i * 8 + 7] * rs * w1.w * g7); }
        uint4* yp = (uint4*)(Y + (size_t)R * D + c0);
        yp[0] = make_uint4(ow[0], ow[1], ow[2], ow[3]); yp[1] = make_uint4(ow[4], ow[5], ow[6], ow[7]);
    }
}
__device__ __forceinline__ void ph_combine1(const P& p, int bid, int nb) {
    const int lane = otid() & 63, wv = otid() >> 6;
    const bf16_t* OF = (const bf16_t*)(p.ws + WS_OFB1); const bf16_t* OB = OF + (size_t)MT * 512;
    const bf16_t* PROJ = (const bf16_t*)(p.ws + WS_BIG);
    bf16_t* Y = (bf16_t*)(p.ws + WS_H);
    const int c0 = lane * 8;
    const float* nw = p.in[33] + (c0 & 127);
    for (int rr = bid * 8 + wv; rr < NB * SEQ; rr += nb * 8) {
        const int b = rr >> 13, t = rr & 8191; const size_t R = (size_t)b * PB + CTX + t;
        const uint4 x = ntldu4(OF + R * 512 + c0), y = ntldu4(OB + R * 512 + c0);
        float o[8];
        o[0] = bflo(x.x) + bflo(y.x); o[1] = bfhi(x.x) + bfhi(y.x); o[2] = bflo(x.y) + bflo(y.y); o[3] = bfhi(x.y) + bfhi(y.y);
        o[4] = bflo(x.z) + bflo(y.z); o[5] = bfhi(x.z) + bfhi(y.z); o[6] = bflo(x.w) + bflo(y.w); o[7] = bfhi(x.w) + bfhi(y.w);
        float ss = 0.f;
#pragma unroll
        for (int e = 0; e < 8; ++e) ss += o[e] * o[e];
        ss += __shfl_xor(ss, 1); ss += __shfl_xor(ss, 2); ss += __shfl_xor(ss, 4); ss += __shfl_xor(ss, 8);
        const float rs = rsqrtf(ss * (1.f / 128.f) + EPS);
        const uint4 gv = ntldu4(PROJ + R * NIN1 + 1552 + c0);
        const float4 w0 = *(const float4*)(nw), w1 = *(const float4*)(nw + 4);
        uint4 ov;
        ov.x = pk2(o[0] * rs * w0.x * siluf_(bflo(gv.x)), o[1] * rs * w0.y * siluf_(bfhi(gv.x))); ov.y = pk2(o[2] * rs * w0.z * siluf_(bflo(gv.y)), o[3] * rs * w0.w * siluf_(bfhi(gv.y)));
        ov.z = pk2(o[4] * rs * w1.x * siluf_(bflo(gv.z)), o[5] * rs * w1.y * siluf_(bfhi(gv.z))); ov.w = pk2(o[6] * rs * w1.z * siluf_(bflo(gv.w)), o[7] * rs * w1.w * siluf_(bfhi(gv.w)));
        *(uint4*)(Y + R * D + c0) = ov;
    }
}

__device__ __forceinline__ void ph_route(const P& p, int layer, LAS unsigned char* lds, int bid, int nb) {
    const int tid = otid(), lane = tid & 63, wv = __builtin_amdgcn_readfirstlane(tid >> 6);
    const int c = lane & 15, q = lane >> 4, e = lane & 31, half = lane >> 5;
    const float* MOD = (const float*)(p.ws + WS_MOD);
    const float* nw = (layer ? p.in[35] : p.in[16]);
    const float* rw = (layer ? p.in[36] : p.in[17]); const float* rb = (layer ? p.in[37] : p.in[18]);
    bf16_t* H = (bf16_t*)(p.ws + WS_H);
    int* cnt = (int*)(p.ws + WS_CNT) + layer * 128;
    int* TOK = (int*)(p.ws + WS_TOK); float* GATE = (float*)(p.ws + WS_GATE);
    constexpr int RS = 2064, OFF_LO = 16 * RS, OFF_PART = 32 * RS;
    bf16x8 bh[4][2], bl[4][2];
#pragma unroll
    for (int s = 0; s < 4; ++s)
#pragma unroll
        for (int nt = 0; nt < 2; ++nt) {
            const float* wp = rw + (size_t)(wv * 128 + s * 32 + 8 * q) * 32 + nt * 16 + c;
            unsigned hh[4], ll[4];
#pragma unroll
            for (int j = 0; j < 4; ++j) { const float w0 = wp[(2 * j) * 32], w1 = wp[(2 * j + 1) * 32]; hh[j] = pk2(w0, w1); ll[j] = pk2(w0 - bflo(hh[j]), w1 - bfhi(hh[j])); }
            const u32x4 hv = {hh[0], hh[1], hh[2], hh[3]}, lv = {ll[0], ll[1], ll[2], ll[3]};
            bh[s][nt] = __builtin_bit_cast(bf16x8, hv); bl[s][nt] = __builtin_bit_cast(bf16x8, lv);
        }
    const float rbe = rb[e];
    const int ngroups = layer ? (NB * SEQ / 16) : (MT / 16);
#define RT_ROW(gi_, t_) (layer ? ((((gi_) * 16 + wv * 2 + (t_)) >> 13) * PB + CTX + (((gi_) * 16 + wv * 2 + (t_)) & 8191)) : ((gi_) * 16 + wv * 2 + (t_)))
#define RT_LOAD(gi_) do { _Pragma("unroll") for (int t = 0; t < 2; ++t) { int b_, pp_; row_decode(RT_ROW(gi_, t), b_, pp_); const float* src_ = stream_row(p, 1, b_, pp_); \
        _Pragma("unroll") for (int i = 0; i < 4; ++i) xr[t][i] = ntld4(src_ + i * 256 + lane * 4); } } while (0)
    float4 xr[2][4];
    int gi = bid;
    if (gi < ngroups) RT_LOAD(gi);
    int pgrp = 0, pR = 0, pslot = 0, have = 0; float pwk = 0.f;
    LAS float* part = (LAS float*)(lds + OFF_PART);
#pragma nounroll
    for (; gi < ngroups; gi += nb) {
#pragma unroll
        for (int t = 0; t < 2; ++t) {
            const int R = RT_ROW(gi, t); int b, pp; row_decode(R, b, pp);
            const float* m = MOD + (size_t)(layer * 9 + (pp < CTX ? 8 : b)) * 6144 + 3072;
            float ss = 0.f;
#pragma unroll
            for (int i = 0; i < 4; ++i) ss += xr[t][i].x * xr[t][i].x + xr[t][i].y * xr[t][i].y + xr[t][i].z * xr[t][i].z + xr[t][i].w * xr[t][i].w;
            ss = wave_sum(ss);
            const float rs = rsqrtf(ss * (1.f / 1024.f) + EPS);
#pragma unroll
            for (int i = 0; i < 4; ++i) {
                const float4 w = *(const float4*)(nw + i * 256 + lane * 4), sh = *(const float4*)(m + i * 256 + lane * 4), sc = *(const float4*)(m + 1024 + i * 256 + lane * 4);
                const float v0 = xr[t][i].x * rs * w.x * (1.f + sc.x) + sh.x, v1 = xr[t][i].y * rs * w.y * (1.f + sc.y) + sh.y;
                const float v2 = xr[t][i].z * rs * w.z * (1.f + sc.z) + sh.z, v3 = xr[t][i].w * rs * w.w * (1.f + sc.w) + sh.w;
                const unsigned h0 = pk2(v0, v1), h1 = pk2(v2, v3);
                const unsigned l0 = pk2(v0 - bflo(h0), v1 - bfhi(h0)), l1 = pk2(v2 - bflo(h1), v3 - bfhi(h1));
                uint2 o; o.x = h0; o.y = h1; *(uint2*)(H + (size_t)R * D + i * 256 + lane * 4) = o;
                const u32x2 hv = {h0, h1}, lv = {l0, l1};
                *(LAS u32x2*)(lds + (wv * 2 + t) * RS + (i * 256 + lane * 4) * 2) = hv;
                *(LAS u32x2*)(lds + OFF_LO + (wv * 2 + t) * RS + (i * 256 + lane * 4) * 2) = lv;
            }
        }
        { const int gn = gi + nb; if (gn < ngroups) RT_LOAD(gn); }
        if (have && e < 4) { TOK[(size_t)pgrp * MT + pslot] = pR; GATE[(size_t)pgrp * MT + pslot] = pwk; }
        LDS_SYNC();
        {
            f32x4 a0 = {0.f, 0.f, 0.f, 0.f}, a1 = {0.f, 0.f, 0.f, 0.f};
#pragma unroll
            for (int s = 0; s < 4; ++s) {
                const int off = c * RS + (wv * 128 + s * 32 + 8 * q) * 2;
                const bf16x8 ah = *(const LAS bf16x8*)(lds + off), al = *(const LAS bf16x8*)(lds + OFF_LO + off);
                a0 = __builtin_amdgcn_mfma_f32_16x16x32_bf16(al, bh[s][0], a0, 0, 0, 0); a0 = __builtin_amdgcn_mfma_f32_16x16x32_bf16(ah, bl[s][0], a0, 0, 0, 0); a0 = __builtin_amdgcn_mfma_f32_16x16x32_bf16(ah, bh[s][0], a0, 0, 0, 0);
                a1 = __builtin_amdgcn_mfma_f32_16x16x32_bf16(al, bh[s][1], a1, 0, 0, 0); a1 = __builtin_amdgcn_mfma_f32_16x16x32_bf16(ah, bl[s][1], a1, 0, 0, 0); a1 = __builtin_amdgcn_mfma_f32_16x16x32_bf16(ah, bh[s][1], a1, 0, 0, 0);
            }
#pragma unroll
            for (int r = 0; r < 4; ++r) { part[(wv * 16 + 4 * q + r) * 32 + c] = a0[r]; part[(wv * 16 + 4 * q + r) * 32 + 16 + c] = a1[r]; }
        }
        LDS_SYNC();
        {
            const int tok = wv * 2 + half;
            float lg = rbe;
#pragma unroll
            for (int s = 0; s < 8; ++s) lg += part[(s * 16 + tok) * 32 + e];
            float tv[4]; int ti[4];
#pragma unroll
            for (int k = 0; k < 4; ++k) {
                float bv = lg; int bi = e;
#pragma unroll
                for (int o = 16; o > 0; o >>= 1) { const float ov = __shfl_xor(bv, o); const int oi = __shfl_xor(bi, o); if (ov > bv || (ov == bv && oi < bi)) { bv = ov; bi = oi; } }
                tv[k] = bv; ti[k] = bi;
                if (e == bi) lg = -3.0e38f;
            }
            if (e < 4) {
                const float m0 = tv[0];
                const float e0 = 1.f, e1 = __expf(tv[1] - m0), e2 = __expf(tv[2] - m0), e3 = __expf(tv[3] - m0);
                const float inv = 1.f / (e0 + e1 + e2 + e3);
                pwk = (e == 0 ? e0 : e == 1 ? e1 : e == 2 ? e2 : e3) * inv;
                const int ek = e == 0 ? ti[0] : e == 1 ? ti[1] : e == 2 ? ti[2] : ti[3];
                pgrp = e * NE + ek;
                pslot = atomicAdd(&cnt[pgrp], 1);
                pR = RT_ROW(gi, half);
            }
            have = 1;
        }
    }
    if (have && e < 4) { TOK[(size_t)pgrp * MT + pslot] = pR; GATE[(size_t)pgrp * MT + pslot] = pwk; }
#undef RT_ROW
#undef RT_LOAD
}

constexpr int NG = 4 * NE;
__device__ __forceinline__ void moe_table(const P& p, int layer, LAS int* tab) {
    __syncthreads();
    if (otid() < 64) {
        const int* cnt = (const int*)(p.ws + WS_CNT) + layer * 128;
        const int lane = otid();
        const int c0 = __hip_atomic_load(&cnt[2 * lane], __ATOMIC_RELAXED, __HIP_MEMORY_SCOPE_AGENT), c1 = __hip_atomic_load(&cnt[2 * lane + 1], __ATOMIC_RELAXED, __HIP_MEMORY_SCOPE_AGENT);
        const int t0 = (c0 + 255) >> 8, t1 = (c1 + 255) >> 8;
        int incl = t0 + t1;
#pragma unroll
        for (int o = 1; o < 64; o <<= 1) { const int t = __shfl_up(incl, o); if (lane >= o) incl += t; }
        const int excl = incl - (t0 + t1);
        tab[2 * lane] = excl; tab[2 * lane + 1] = excl + t0; tab[NG + 1 + 2 * lane] = c0; tab[NG + 1 + 2 * lane + 1] = c1;
        if (lane == 63) tab[NG] = incl;
    }
    __syncthreads();
}
__device__ __forceinline__ int moe_find(LAS const int* tab, int rt) { int g = 0;
#pragma unroll 8
    for (int k = 1; k < NG; ++k) if (tab[k] <= rt) g = k;
    return g; }

struct EpiUp {
    static constexpr bool ACT = true;
    __device__ __forceinline__ bool is_full() const { return true; }
    typedef EpiNoPre Pre;
    __device__ __forceinline__ void prefetch(int, int, int, Pre&) const {}
    bf16_t* abuf; const float* bup; int arow0  , pn;
    __device__ __forceinline__ f32x4 act(const f32x4 gl, const f32x4 li, int c) const {
        const int gc = pn * 128 + c;
        const f32x4 bg = *(const f32x4*)(bup + gc), bl = *(const f32x4*)(bup + 1024 + gc);
        f32x4 r;
#pragma unroll
        for (int h2 = 0; h2 < 2; ++h2) {
            f32x2 g = (f32x2){gl[2 * h2], gl[2 * h2 + 1]} + (f32x2){bg[2 * h2], bg[2 * h2 + 1]};
            f32x2 l = (f32x2){li[2 * h2], li[2 * h2 + 1]} + (f32x2){bl[2 * h2], bl[2 * h2 + 1]};
            g[0] = fminf(g[0], 7.f); g[1] = fminf(g[1], 7.f);
            l[0] = __builtin_amdgcn_fmed3f(l[0], -7.f, 7.f); l[1] = __builtin_amdgcn_fmed3f(l[1], -7.f, 7.f);
            const f32x2 t = g * (f32x2){-1.702f * 1.4426950408889634f, -1.702f * 1.4426950408889634f};
            f32x2 e = (f32x2){__builtin_amdgcn_exp2f(t[0]), __builtin_amdgcn_exp2f(t[1])};
            e = e + (f32x2){1.f, 1.f};
            const f32x2 s = g * (f32x2){__builtin_amdgcn_rcpf(e[0]), __builtin_amdgcn_rcpf(e[1])};
            const f32x2 o = __builtin_elementwise_fma(l, s, s);
            r[2 * h2] = o[0]; r[2 * h2 + 1] = o[1];
        }
        return r;
    }
    __device__ __forceinline__ void row(int r, int c8, const u32x4 v) const {
        __builtin_nontemporal_store(v, (u32x4*)(abuf + (size_t)(arow0 + r) * DFF + pn * 128 + c8));
    }
};

__device__ __forceinline__ void ph_moe_up(const P& p, int layer, LAS unsigned char* lds, int bid, int nb) {
    LAS int* tab = (LAS int*)(lds + LDS_CTL + 64);
    moe_table(p, layer, tab);
    const int ntiles = tab[NG];
    const int* TOK = (const int*)(p.ws + WS_TOK);
    const unsigned char* A = p.ws + WS_H;
    for (int it = 0;; ++it) {
        int rtg, pn; if (!unit_map(it, bid, nb, ntiles, 8, rtg, pn)) break;
        const int g = moe_find(tab, rtg), e = g & (NE - 1), rt = rtg - tab[g], c = tab[NG + 1 + g];
        int R0, C0, R1, C1; g8::stage_rc(otid() * 16, R0, C0); g8::stage_rc(otid() * 16 + 8192, R1, C1);
        const int* tk = TOK + (size_t)g * MT + rt * 256;
        const int s00 = R0, s01 = R1, s10 = 128 + R0, s11 = 128 + R1;
        const unsigned t00 = (rt * 256 + s00 < c) ? (unsigned)tk[s00] : 0u, t01 = (rt * 256 + s01 < c) ? (unsigned)tk[s01] : 0u;
        const unsigned t10 = (rt * 256 + s10 < c) ? (unsigned)tk[s10] : 0u, t11 = (rt * 256 + s11 < c) ? (unsigned)tk[s11] : 0u;
        EpiUp E{(bf16_t*)(p.ws + WS_BIG), (layer ? p.in[39] : p.in[20]) + (size_t)e * 2048, rtg * 256, pn};
        gemm_unit(lds, A, t00 * 2048u + C0 * 2u, t01 * 2048u + C1 * 2u, t10 * 2048u + C0 * 2u, t11 * 2048u + C1 * 2u,
                  p.ws + WS_WUP + ((size_t)e * 2048 + pn * 256) * 2048, E);
    }
}

struct PreDown { uint2 x[8]; float4 g[8]; int R[8]; float gate[8]; };
struct EpiDown {
    static constexpr bool ACT = false;
    __device__ __forceinline__ bool is_full() const { return !(ks & 8); }
    typedef PreDown Pre;
    const P* p; int layer, ks; const float* bdn; int col0;
    int tkv; float gatev;
    __device__ __forceinline__ void load8(int ai, int w2, int lane, int i0, Pre& pre) const {
        const bf16_t* Z = (const bf16_t*)(p->ws + WS_H);
#pragma unroll
        for (int i = 0; i < 8; ++i) {
            pre.R[i] = __builtin_amdgcn_readlane(tkv, ai * 16 + i0 + i); pre.gate[i] = __int_as_float(__builtin_amdgcn_readlane(__float_as_int(gatev), ai * 16 + i0 + i));
            const int Rc = pre.R[i] < 0 ? 0 : pre.R[i];
            int b, pp; row_decode(Rc, b, pp);
            pre.g[i] = *(const float4*)((const float*)(p->ws + WS_MOD) + (size_t)(layer * 9 + (pp < CTX ? 8 : b)) * 6144 + 5120 + col0 + lane * 4);
            if ((ks & 7) > 0) pre.x[i] = *(const uint2*)(Z + (size_t)Rc * D + col0 + lane * 4);
        }
    }
    __device__ __forceinline__ void store8(int ai, int w2, int lane, int i0, const LAS float* stg, const Pre& pre, const float4 bb) const {
        bf16_t* Z = (bf16_t*)(p->ws + WS_H);
#pragma unroll
        for (int i = 0; i < 8; ++i) {
            if (pre.R[i] >= 0) {
                const f32x4 a = *(const LAS f32x4*)(stg + (w2 * 16 + i0 + i) * 260 + lane * 4);
                const float4 gg = pre.g[i]; const float gate = pre.gate[i];
                float4 x = make_float4(0.f, 0.f, 0.f, 0.f);
                if ((ks & 7) > 0) { x.x = bflo(pre.x[i].x); x.y = bfhi(pre.x[i].x); x.z = bflo(pre.x[i].y); x.w = bfhi(pre.x[i].y); }
                x.x += gate * gg.x * (a[0] + bb.x); x.y += gate * gg.y * (a[1] + bb.y); x.z += gate * gg.z * (a[2] + bb.z); x.w += gate * gg.w * (a[3] + bb.w);
                uint2 o; o.x = pk2(x.x, x.y); o.y = pk2(x.z, x.w);
                *(uint2*)(Z + (size_t)pre.R[i] * D + col0 + lane * 4) = o;
            }
        }
    }
    __device__ __forceinline__ void prefetch(int ai, int w2, int lane, Pre& pre) const { load8(ai, w2, lane, 0, pre); }
    __device__ __forceinline__ void rows(int ai, int w2, int lane, const LAS float* stg, Pre& pre) const {
        const float4 bb = *(const float4*)(bdn + col0 + lane * 4);
        store8(ai, w2, lane, 0, stg, pre, bb);
        load8(ai, w2, lane, 8, pre);
        store8(ai, w2, lane, 8, stg, pre, bb);
    }
};

__device__ __forceinline__ void ph_moe_down(const P& p, int layer, int ks, LAS unsigned char* lds, int bid, int nb) {
    LAS int* tab = (LAS int*)(lds + LDS_CTL + 64);
    moe_table(p, layer, tab);
    const int tile0 = tab[ks * NE], ntiles = tab[(ks + 1) * NE] - tile0;
    const unsigned char* A = p.ws + WS_BIG;
    const int U = ntiles * 4, rfull = U / nb, urem = U - rfull * nb;
    const bool split = ((nb & 7) == 0) && urem > 0 && urem * 2 <= nb;
#pragma nounroll
    for (int it = 0;; ++it) {
        int rtl, pn, hoff = 0; bool full = true;
        if (split && it == rfull) {
            const int hidx = (bid & 7) * (nb >> 3) + (bid >> 3);
            if (hidx >= 2 * urem) break;
            hoff = hidx & 1; full = false;
            unit_decode(rfull * nb + (hidx >> 1), ntiles, 4, rtl, pn);
        } else if (!unit_map(it, bid, nb, ntiles, 4, rtl, pn)) break;
        const int rtg = tile0 + rtl;
        const int g = moe_find(tab, rtg), e = g & (NE - 1), rt = rtg - tab[g], c = tab[NG + 1 + g];
        unsigned a00, a01, a10, a11; a_offsets_plain((unsigned)rtg * 256u + (unsigned)hoff * 128u, a00, a01, a10, a11);
        int tkv = -1; float gatev = 0.f;
        { const int l2 = otid() & 63, w2 = __builtin_amdgcn_readfirstlane(otid() >> 6);
          const int slot = rt * 256 + (((l2 >> 4) & 1) + hoff) * 128 + w2 * 16 + (l2 & 15);
          if (l2 < 32 && slot < c) { tkv = ((const int*)(p.ws + WS_TOK) + (size_t)g * MT)[slot]; gatev = ((const float*)(p.ws + WS_GATE) + (size_t)g * MT)[slot]; } }
        EpiDown E{&p, layer, ks | (full ? 0 : 8), (layer ? p.in[41] : p.in[22]) + (size_t)e * 1024, pn * 256, tkv, gatev};
        gemm_unit(lds, A, a00, a01, a10, a11, p.ws + WS_WDN + ((size_t)e * 1024 + pn * 256) * 2048, E);
    }
}

__device__ __forceinline__ void ph_final(const P& p, int bid, int nb) {
    const int lane = otid() & 63, wv = otid() >> 6;
    const float* nw = p.in[42];
    for (int r = bid * 8 + wv; r < NB * SEQ; r += nb * 8) {
        float* row = p.out + (size_t)r * D;
        float4 x[4]; float ss = 0.f;
#pragma unroll
        for (int i = 0; i < 4; ++i) { x[i] = ntld4(row + i * 256 + lane * 4);
            const uint2 z = ntldu2((const bf16_t*)(p.ws + WS_H) + ((size_t)(r >> 13) * PB + CTX + (r & 8191)) * D + i * 256 + lane * 4);
            x[i].x += bflo(z.x); x[i].y += bfhi(z.x); x[i].z += bflo(z.y); x[i].w += bfhi(z.y);
            ss += x[i].x * x[i].x + x[i].y * x[i].y + x[i].z * x[i].z + x[i].w * x[i].w; }
        ss = wave_sum(ss);
        const float rs = rsqrtf(ss * (1.f / 1024.f) + EPS);
#pragma unroll
        for (int i = 0; i < 4; ++i) { const float4 w = *(const float4*)(nw + i * 256 + lane * 4); float4 o; o.x = x[i].x * rs * w.x; o.y = x[i].y * rs * w.y; o.z = x[i].z * rs * w.z; o.w = x[i].w * rs * w.w; *(float4*)(row + i * 256 + lane * 4) = o; }
    }
}

constexpr int N_PHASES = 20;

__global__ void __launch_bounds__(NTHR, 2) mk_fwd(P p) {
    extern __shared__ __attribute__((aligned(16))) unsigned char lds_raw[];
    LAS unsigned char* lds = (LAS unsigned char*)lds_raw;
    float* ldsf = (float*)lds_raw;
    const int bid = blockIdx.x, nb = gridDim.x;
    volatile LAS unsigned* xbw = (volatile LAS unsigned*)(lds + LDS_CTL);
    if (threadIdx.x < 16) xbw[threadIdx.x] = 0u;
    __syncthreads();
#if MK_PER_PHASE
    XcdBarrier bar; bar.bar = nullptr; bar.x = 0; bar.st = nullptr;
#define GRID_BAR() do { } while (0)
#else
    XcdBarrier bar = xcd_barrier_post((unsigned*)(p.ws + WS_CTL), xbw);
#define GRID_BAR() xcd_barrier(bar)
#endif
    const int lo = p.ph_lo, hi = p.ph_hi;
#define IN(k) (lo <= (k) && (k) < hi)
#define SEAM(k) do { if (IN((k) + 1)) GRID_BAR(); } while (0)

    if (IN(0)) { { ph0_mod(p, ldsf, bid, nb); ph0_convert(p, ldsf, bid, nb); } SEAM(0); }
    if (IN(1)) { ph_norm1(p, 0, bid, nb); SEAM(1); }
    if (IN(2)) { ph_inproj(p, 0, lds, bid, nb); SEAM(2); }
    if (IN(3)) {
        for (int u = bid; u < 256; u += nb) { if (u < 128) scan_l0_chunked<0>(p, u & 127, lds); else scan_l0_chunked<1>(p, u & 127, lds); } SEAM(3); }
    if (IN(4)) { ph_combine0(p, bid, nb); SEAM(4); }
    if (IN(5)) { ph_outproj(p, 0, lds, bid, nb); ph_convert_moe(p, 0, ldsf, bid, nb, 32); SEAM(5); }
    if (IN(6)) { ph_route(p, 0, lds, bid, nb); SEAM(6); }
    if (IN(7)) { ph_moe_up(p, 0, lds, bid, nb); SEAM(7); }
    if (IN(8)) {
#pragma nounroll
        for (int ks = 0; ks < 4; ++ks) { ph_moe_down(p, 0, ks, lds, bid, nb); if (ks < 3 || IN(9)) GRID_BAR(); }
    }
    if (IN(9)) { ph_norm1(p, 1, bid, nb); SEAM(9); }
    if (IN(10)) { ph_inproj(p, 1, lds, bid, nb); SEAM(10); }
    if (IN(11)) { ph_prep1(p, bid, nb); SEAM(11); }
    if (IN(12)) {
        ph_delta_T(p, lds, bid, nb);
        SEAM(12); }
    if (IN(13)) {
        if (nb >= 256) { if (bid < 128) scan_delta_chunked(p, bid, lds); else for (int u = bid - 128; u < 1024; u += nb - 128) attn_unit_mfma(p, u, lds); }
        else for (int u = bid; u < 128 + 1024; u += nb) { if (u < 128) scan_delta_chunked(p, u, lds); else attn_unit_mfma(p, u - 128, lds); }
        SEAM(13);
    }
    if (IN(14)) { ph_combine1(p, bid, nb); SEAM(14); }
    if (IN(15)) { ph_outproj(p, 1, lds, bid, nb); ph_convert_moe(p, 1, ldsf, bid, nb, 0); SEAM(15); }
    if (IN(16)) { ph_route(p, 1, lds, bid, nb); SEAM(16); }
    if (IN(17)) { ph_moe_up(p, 1, lds, bid, nb); SEAM(17); }
    if (IN(18)) {
#pragma nounroll
        for (int ks = 0; ks < 4; ++ks) { ph_moe_down(p, 1, ks, lds, bid, nb); if (ks < 3 || IN(19)) GRID_BAR(); }
    }
    if (IN(19)) { ph_final(p, bid, nb); }
#undef IN
#undef SEAM
}

extern "C" void kernel_launch(void* const* d_in, const int* in_sizes, int n_in, void* d_out, int out_size, void* d_ws, size_t ws_size, hipStream_t stream) {
    static int grid = 0;
    if (grid == 0) {
        if (n_in != 43 || out_size != NB * SEQ * D || ws_size < WS_END) { fprintf(stderr, "kernel_launch: unexpected problem (n_in %d out %d ws %zu need %zu)\n", n_in, out_size, ws_size, (size_t)WS_END); grid = -1; return; }
        int dev = 0, cus = 0, per_cu = 0;
        if (hipGetDevice(&dev) != hipSuccess || hipDeviceGetAttribute(&cus, hipDeviceAttributeMultiprocessorCount, dev) != hipSuccess) { grid = -1; return; }
        if (hipFuncSetAttribute((const void*)mk_fwd, hipFuncAttributeMaxDynamicSharedMemorySize, LDS_BYTES) != hipSuccess) { fprintf(stderr, "kernel_launch: hipFuncSetAttribute failed\n"); grid = -1; return; }
        if (hipOccupancyMaxActiveBlocksPerMultiprocessor(&per_cu, (const void*)mk_fwd, NTHR, LDS_BYTES) != hipSuccess || per_cu < 1) { fprintf(stderr, "kernel_launch: occupancy query says %d\n", per_cu); }
        (void)hipGetLastError();
        grid = cus;
    }
    if (grid < 0) return;
    (void)hipMemsetAsync(d_ws, 0, WS_ZERO_BYTES, stream);
    P prm;
    memset(&prm, 0, sizeof(prm));
    for (int i = 0; i < 43; ++i) prm.in[i] = (const float*)d_in[i];
    prm.out = (float*)d_out; prm.ws = (unsigned char*)d_ws;
#if MK_PER_PHASE
    for (int ph = 0; ph < N_PHASES; ++ph) { prm.ph_lo = ph; prm.ph_hi = ph + 1; hipLaunchKernelGGL(mk_fwd, dim3(grid), dim3(NTHR), LDS_BYTES, stream, prm); }
#else
    prm.ph_lo = 0; prm.ph_hi = N_PHASES; prm.dupa = PROBE_DUPA; prm.dupb = PROBE_DUPB;
    hipLaunchKernelGGL(mk_fwd, dim3(grid), dim3(NTHR), LDS_BYTES, stream, prm);
#endif
}
```

```cpp
#include <hip/hip_runtime.h>
#include <stdint.h>
#include <stdio.h>
#include <string.h>

#ifndef PROBE_DUPA
#define PROBE_DUPA 0
#endif
#ifndef PROBE_DUPB
#define PROBE_DUPB 0
#endif
#ifndef PROBE_DUP3
#define PROBE_DUP3 0
#endif
#ifndef PROBE_DUP12
#define PROBE_DUP12 0
#endif
#ifndef PROBE_DUP2
#define PROBE_DUP2 0
#endif
#ifndef PROBE_DUP7
#define PROBE_DUP7 0
#endif
#ifndef MK_PER_PHASE
#define MK_PER_PHASE 0
#endif

typedef unsigned short bf16_t;
typedef short bf16x8 __attribute__((ext_vector_type(8)));
typedef short bf16x4 __attribute__((ext_vector_type(4)));
typedef float f32x4 __attribute__((ext_vector_type(4)));
typedef unsigned u32x2 __attribute__((ext_vector_type(2)));
typedef unsigned u32x4 __attribute__((ext_vector_type(4)));
#define LAS __attribute__((address_space(3)))

constexpr int D = 1024, NB = 8, SEQ = 8192, CTX = 256, PB = SEQ + CTX  , MT = NB * PB  ;
constexpr int NIN0 = 4128, NIN0P = 4352, NIN1 = 2832, NIN1P = 3072;
constexpr int NE = 32, DFF = 1024;
constexpr int NTHR = 512;
constexpr float EPS = 1e-6f;
constexpr int LDS_CTL = 161792;
constexpr int LDS_BYTES = LDS_CTL + 2048;

constexpr size_t WS_CTL = 0;
constexpr size_t WS_CNT = 16384;
constexpr size_t WS_MOD = 65536;
constexpr size_t WS_ZERO_BYTES = 524288;
constexpr size_t WS_CTXS = 524288;
constexpr size_t WS_WIN0 = WS_CTXS + 8388608;
constexpr size_t WS_WIN1 = WS_WIN0 + 8912896;
constexpr size_t WS_WOUT = WS_WIN1 + 6291456;
constexpr size_t WS_TOK = WS_WOUT + 4194304;
constexpr size_t WS_GATE = WS_TOK + 34603008;
constexpr size_t WS_H = WS_GATE + 34603008;
constexpr size_t WS_BIG = WS_H + 138412032;
constexpr size_t WS_SCR = WS_BIG + 557973504;
constexpr size_t WS_OFB1 = WS_BIG + 382795776;
constexpr size_t WS_TM = WS_SCR + 207618048;
constexpr size_t WS_WUP = WS_SCR + 75497472;
constexpr size_t WS_WDN = WS_WUP + 134217728;
constexpr size_t WS_END = WS_SCR + 276824064;

#define XB_TMO      128
#define XB_XCNT(j)  (256  + 64 * (j))
#define XB_XSUB(j)  (1280 + 64 * (j))
#define XB_XGEN(j)  (2304 + 64 * (j))
#define XB_TOP      3328
#define XB_TOPGEN   3392
#define XCD_BAR_WORDS 3456
#define XB_SPIN_CAP (1u << 22)

__device__ __forceinline__ unsigned xb_ld(unsigned* p)              { return __hip_atomic_load(p, __ATOMIC_RELAXED, __HIP_MEMORY_SCOPE_AGENT); }
__device__ __forceinline__ unsigned xb_add(unsigned* p, unsigned v) { return __hip_atomic_fetch_add(p, v, __ATOMIC_RELAXED, __HIP_MEMORY_SCOPE_AGENT); }
__device__ __forceinline__ unsigned xb_xcc_id() { return (unsigned)__builtin_amdgcn_s_getreg((3 << 11) | 20) & 0xFu; }
#define XB_SPIN(cond, bar) do { unsigned _sp = 0; while (cond) { __builtin_amdgcn_s_sleep(1); \
    if ((++_sp & 255u) == 0u) { if (xb_ld(&(bar)[XB_TMO])) break; if (_sp > XB_SPIN_CAP) { atomicAdd(&(bar)[XB_TMO], 1u); break; } } } } while (0)

struct XcdBarrier { unsigned* bar; unsigned x; volatile LAS unsigned* st; };

__device__ __forceinline__ XcdBarrier xcd_barrier_post(unsigned* bar, volatile LAS unsigned* st) {
    XcdBarrier b; b.bar = bar; b.x = xb_xcc_id(); b.st = st;
    if (threadIdx.x == 0) (void)xb_add(&bar[XB_XCNT(b.x)], 1u);
    return b;
}
__device__ __forceinline__ void xcd_barrier_complete(unsigned* bar, unsigned x, unsigned& nloc, unsigned& nx) {
    const unsigned G = gridDim.x * gridDim.y * gridDim.z;
    unsigned sum, cnt, mine, sp = 0u;
    for (;;) {
        sum = 0u; cnt = 0u; mine = 0u;
#pragma unroll
        for (unsigned j = 0; j < 16; ++j) { const unsigned c = xb_ld(&bar[XB_XCNT(j)]); sum += c; cnt += (c > 0u) ? 1u : 0u; mine = (j == x) ? c : mine; }
        if (sum == G) break;
        __builtin_amdgcn_s_sleep(1);
        if ((++sp & 255u) == 0u) { if (xb_ld(&bar[XB_TMO])) break; if (sp > XB_SPIN_CAP) { atomicAdd(&bar[XB_TMO], 1u); break; } }
    }
    nloc = mine > 0u ? mine : 1u; nx = cnt > 0u ? cnt : 1u;
}
__device__ __forceinline__ void xcd_barrier(const XcdBarrier& b) {
    asm volatile("s_waitcnt vmcnt(0)" ::: "memory");
    __syncthreads();
    if (threadIdx.x == 0) {
        unsigned* bar = b.bar;
        __builtin_amdgcn_s_waitcnt(0);
        unsigned nloc = b.st[0], nx = b.st[1];
        if (nloc == 0u) { xcd_barrier_complete(bar, b.x, nloc, nx); b.st[0] = nloc; b.st[1] = nx; }
        const unsigned old = xb_add(&bar[XB_XSUB(b.x)], 1u);
        const unsigned gen = old / nloc;
        if (old + 1u == (gen + 1u) * nloc) {
            __builtin_amdgcn_fence(__ATOMIC_RELEASE, "agent");
            asm volatile("s_waitcnt vmcnt(0)" ::: "memory");
            const unsigned og = xb_add(&bar[XB_TOP], 1u);
            const unsigned tg = og / nx;
            if (og + 1u == (tg + 1u) * nx) xb_add(&bar[XB_TOPGEN], 1u);
            else XB_SPIN(xb_ld(&bar[XB_TOPGEN]) == tg, bar);
            __builtin_amdgcn_fence(__ATOMIC_ACQUIRE, "agent");
            xb_add(&bar[XB_XGEN(b.x)], 1u);
            asm volatile("s_waitcnt vmcnt(0)" ::: "memory");
        } else {
            XB_SPIN(xb_ld(&bar[XB_XGEN(b.x)]) == gen, bar);
            __builtin_amdgcn_fence(__ATOMIC_ACQUIRE, "agent");
            asm volatile("s_waitcnt vmcnt(0)" ::: "memory");
        }
    }
    __syncthreads();
}

__device__ __forceinline__ int otid() { int t = threadIdx.x; asm volatile("" : "+v"(t)); return t; }
__device__ __forceinline__ float bf2f(bf16_t v) { return __uint_as_float(((unsigned)v) << 16); }
__device__ __forceinline__ float bflo(unsigned w) { return __uint_as_float(w << 16); }
__device__ __forceinline__ float bfhi(unsigned w) { return __uint_as_float(w & 0xffff0000u); }
typedef __bf16 bf16v2 __attribute__((ext_vector_type(2)));
typedef float f32x2 __attribute__((ext_vector_type(2)));
__device__ __forceinline__ unsigned pk2(float lo, float hi) { const f32x2 v = {lo, hi}; const bf16v2 b = __builtin_convertvector(v, bf16v2); return __builtin_bit_cast(unsigned, b); }
__device__ __forceinline__ bf16_t f2bf(float f) { return (bf16_t)(pk2(f, f) & 0xffffu); }
__device__ __forceinline__ float sigmoidf_(float x) { return __builtin_amdgcn_rcpf(1.f + __expf(-x)); }
__device__ __forceinline__ float siluf_(float x) { return x * __builtin_amdgcn_rcpf(1.f + __expf(-x)); }
__device__ __forceinline__ float dppf(float v, const int ctrl_sel) {
    int r;
    if (ctrl_sel == 0) r = __builtin_amdgcn_update_dpp(0, __float_as_int(v), 0xB1, 0xf, 0xf, false);
    else if (ctrl_sel == 1) r = __builtin_amdgcn_update_dpp(0, __float_as_int(v), 0x4E, 0xf, 0xf, false);
    else r = __builtin_amdgcn_update_dpp(0, __float_as_int(v), 0x141, 0xf, 0xf, false);
    return __int_as_float(r);
}
__device__ __forceinline__ float red8(float v) { v += dppf(v, 0); v += dppf(v, 1); v += dppf(v, 2); return v; }
__device__ __forceinline__ float4 ntld4(const float* p) { const f32x4 v = __builtin_nontemporal_load((const f32x4*)p); return make_float4(v[0], v[1], v[2], v[3]); }
__device__ __forceinline__ uint4 ntldu4(const void* p) { const u32x4 v = __builtin_nontemporal_load((const u32x4*)p); return make_uint4(v[0], v[1], v[2], v[3]); }
__device__ __forceinline__ uint2 ntldu2(const void* p) { const u32x2 v = __builtin_nontemporal_load((const u32x2*)p); return make_uint2(v[0], v[1]); }
__device__ __forceinline__ float wave_sum(float v) {
#pragma unroll
    for (int o = 32; o > 0; o >>= 1) v += __shfl_xor(v, o);
    return v;
}

constexpr float FX_SCALE = 1048576.f, FX_INV = 1.f / 1048576.f;
#define LDS_SYNC() do { asm volatile("s_waitcnt lgkmcnt(0)" ::: "memory"); __builtin_amdgcn_s_barrier(); asm volatile("" ::: "memory"); } while (0)
#define WAVE_FENCE() do { asm volatile("s_waitcnt lgkmcnt(0)" ::: "memory"); __builtin_amdgcn_wave_barrier(); } while (0)
struct P { const float* in[43]; float* out; unsigned char* ws; int ph_lo, ph_hi, dupa, dupb; };

__device__ __forceinline__ void row_decode(int R, int& b, int& pp) { b = R / PB; pp = R - b * PB; }

__device__ __forceinline__ void ph0_mod(const P& p, float* ldsf, int bid, int nb) {
    float* MOD = (float*)(p.ws + WS_MOD);
    const int tid = otid();
    float* sc = ldsf;
    float* red = ldsf + 9 * 1024;
    for (int u = bid; u < 192; u += nb) {
        const int l = u / 96, cb = u % 96;
        const float* W = l ? p.in[23] : p.in[4]; const float* bias = l ? p.in[24] : p.in[5];
        __syncthreads();
        for (int i = tid; i < 9 * 1024; i += NTHR) { const int rr = i >> 10, k = i & 1023; const float v = rr < 8 ? p.in[1][rr * 1024 + k] : p.in[3][k]; sc[i] = siluf_(v); }
        __syncthreads();
        const int cq = tid & 15, ks = tid >> 4;
        const float* wp = W + (size_t)(ks * 32) * 6144 + cb * 64 + cq * 4;
        float4 acc[9];
#pragma unroll
        for (int rr = 0; rr < 9; ++rr) acc[rr] = make_float4(0.f, 0.f, 0.f, 0.f);
#pragma unroll 4
        for (int k4 = 0; k4 < 32; k4 += 4) {
            float4 w[4];
#pragma unroll
            for (int j = 0; j < 4; ++j) w[j] = ntld4(wp + (size_t)(k4 + j) * 6144);
#pragma unroll
            for (int rr = 0; rr < 9; ++rr) {
                const float4 s = *(const float4*)(sc + rr * 1024 + ks * 32 + k4);
                acc[rr].x += s.x * w[0].x + s.y * w[1].x + s.z * w[2].x + s.w * w[3].x; acc[rr].y += s.x * w[0].y + s.y * w[1].y + s.z * w[2].y + s.w * w[3].y;
                acc[rr].z += s.x * w[0].z + s.y * w[1].z + s.z * w[2].z + s.w * w[3].z; acc[rr].w += s.x * w[0].w + s.y * w[1].w + s.z * w[2].w + s.w * w[3].w;
            }
        }
#pragma unroll
        for (int rr = 0; rr < 9; ++rr) *(float4*)(red + (ks * 9 + rr) * 64 + cq * 4) = acc[rr];
        __syncthreads();
        for (int i = tid; i < 9 * 64; i += NTHR) { const int rr = i >> 6, c = i & 63;
            float s = 0.f;
#pragma unroll 8
            for (int k2 = 0; k2 < 32; ++k2) s += red[(k2 * 9 + rr) * 64 + c];
            MOD[(l * 9 + rr) * 6144 + cb * 64 + c] = s + bias[cb * 64 + c]; }
    }
}

template <int MAP>
__device__ __forceinline__ void cvt_tile(const float* __restrict__ src, int ldn, int nmax, int k0, int n0, bf16_t* __restrict__ dst, float* tile) {
    const int tid = otid();
    __syncthreads();
#pragma unroll
    for (int j = 0; j < 2; ++j) {
        const int r = (tid >> 4) + 32 * j, c4 = (tid & 15) * 4;
        float4 v = make_float4(0.f, 0.f, 0.f, 0.f);
        if (n0 + c4 < nmax) v = ntld4(src + (size_t)(k0 + r) * ldn + n0 + c4);
        tile[r * 65 + c4 + 0] = v.x; tile[r * 65 + c4 + 1] = v.y; tile[r * 65 + c4 + 2] = v.z; tile[r * 65 + c4 + 3] = v.w;
    }
    __syncthreads();
    const int n = tid >> 3, k8 = (tid & 7) * 8;
    if (n0 + n < nmax) {
        int nn = n0 + n;
        if (MAP == 1) { const int j = nn & 1023; nn = (j >> 7) * 256 + (nn >= 1024 ? 128 : 0) + (j & 127); }
        uint4 o;
        o.x = pk2(tile[(k8 + 0) * 65 + n], tile[(k8 + 1) * 65 + n]); o.y = pk2(tile[(k8 + 2) * 65 + n], tile[(k8 + 3) * 65 + n]);
        o.z = pk2(tile[(k8 + 4) * 65 + n], tile[(k8 + 5) * 65 + n]); o.w = pk2(tile[(k8 + 6) * 65 + n], tile[(k8 + 7) * 65 + n]);
        *(uint4*)(dst + (size_t)nn * 1024 + k0 + k8) = o;
    }
}

template <int MAP>
__device__ __forceinline__ void cvt_tile_wide(const float* __restrict__ src, int ldn, int k0, int n0, bf16_t* __restrict__ dst, float* tile) {
    const int tid = otid();
    __syncthreads();
    float4 v[8];
#pragma unroll
    for (int j = 0; j < 8; ++j) { const int r = (tid >> 6) + 8 * j, c4 = (tid & 63) * 4; v[j] = ntld4(src + (size_t)(k0 + r) * ldn + n0 + c4); }
#pragma unroll
    for (int j = 0; j < 8; ++j) { const int r = (tid >> 6) + 8 * j, c4 = (tid & 63) * 4; float* t = tile + r * 257 + c4; t[0] = v[j].x; t[1] = v[j].y; t[2] = v[j].z; t[3] = v[j].w; }
    __syncthreads();
#pragma unroll
    for (int j = 0; j < 4; ++j) {
        const int n = (tid >> 3) + 64 * j, k8 = (tid & 7) * 8;
        int nn = n0 + n;
        if (MAP == 1) { const int jj = nn & 1023; nn = (jj >> 7) * 256 + (nn >= 1024 ? 128 : 0) + (jj & 127); }
        uint4 o;
        o.x = pk2(tile[(k8 + 0) * 257 + n], tile[(k8 + 1) * 257 + n]); o.y = pk2(tile[(k8 + 2) * 257 + n], tile[(k8 + 3) * 257 + n]);
        o.z = pk2(tile[(k8 + 4) * 257 + n], tile[(k8 + 5) * 257 + n]); o.w = pk2(tile[(k8 + 6) * 257 + n], tile[(k8 + 7) * 257 + n]);
        *(uint4*)(dst + (size_t)nn * 1024 + k0 + k8) = o;
    }
}

__device__ __forceinline__ void ph0_convert(const P& p, float* ldsf, int bid, int nb) {
    for (int u = bid; u < 2272; u += nb) {
        if (u < 1040) { const int kt = u / 65, nt = u % 65; cvt_tile<0>(p.in[7], NIN0, NIN0, kt * 64, nt * 64, (bf16_t*)(p.ws + WS_WIN0), ldsf); }
        else if (u < 1760) { const int v = u - 1040, kt = v / 45, nt = v % 45; cvt_tile<0>(p.in[26], NIN1, NIN1, kt * 64, nt * 64, (bf16_t*)(p.ws + WS_WIN1), ldsf); }
        else if (u < 2016) { const int v = u - 1760, kt = v / 16, nt = v % 16; cvt_tile<0>(p.in[8], 1024, 1024, kt * 64, nt * 64, (bf16_t*)(p.ws + WS_WOUT), ldsf); }
        else { const int v = u - 2016, kt = v / 16, nt = v % 16; cvt_tile<0>(p.in[27], 1024, 1024, kt * 64, nt * 64, (bf16_t*)(p.ws + WS_WOUT) + 1024 * 1024, ldsf); }
    }
    const uint4 z = make_uint4(0u, 0u, 0u, 0u);
    uint4* z0 = (uint4*)(p.ws + WS_WIN0 + (size_t)NIN0 * 2048); const int n0 = (NIN0P - NIN0) * 2048 / 16;
    uint4* z1 = (uint4*)(p.ws + WS_WIN1 + (size_t)NIN1 * 2048); const int n1 = (NIN1P - NIN1) * 2048 / 16;
    for (int i = bid * NTHR + otid(); i < n0; i += nb * NTHR) z0[i] = z;
    for (int i = bid * NTHR + otid(); i < n1; i += nb * NTHR) z1[i] = z;
}

__device__ __forceinline__ void ph_convert_moe(const P& p, int layer, float* ldsf, int bid, int nb, int shift) {
    const float* wup = (layer ? p.in[38] : p.in[19]); const float* wdn = (layer ? p.in[40] : p.in[21]);
    bf16_t* up_t = (bf16_t*)(p.ws + WS_WUP); bf16_t* dn_t = (bf16_t*)(p.ws + WS_WDN);
    for (int u = (bid + shift) % nb; u < 6144; u += nb) {
        if (u < 4096) { const int e = u >> 7, v = u & 127, kt = v >> 3, nt = v & 7;
            cvt_tile_wide<1>(wup + (size_t)e * 1024 * 2048, 2048, kt * 64, nt * 256, up_t + (size_t)e * 2048 * 1024, ldsf); }
        else { const int w = u - 4096, e = w >> 6, v = w & 63, kt = v >> 2, nt = v & 3;
            cvt_tile_wide<0>(wdn + (size_t)e * 1024 * 1024, 1024, kt * 64, nt * 256, dn_t + (size_t)e * 1024 * 1024, ldsf); }
    }
}

template <int CONV>
__device__ __forceinline__ void norm_mod_row(float* __restrict__ src, const float* __restrict__ nw, const float* __restrict__ shift, const float* __restrict__ scale, int lane, float (&v)[16]) {
    float ss = 0.f;
#pragma unroll
    for (int i = 0; i < 4; ++i) {
        float4 x;
        if (CONV == 1) { const int4 xi = *(const int4*)(src + i * 256 + lane * 4); x.x = (float)xi.x * FX_INV; x.y = (float)xi.y * FX_INV; x.z = (float)xi.z * FX_INV; x.w = (float)xi.w * FX_INV; *(float4*)(src + i * 256 + lane * 4) = x; }
        else x = ntld4(src + i * 256 + lane * 4);
        if (CONV == 2) { int4 xi; xi.x = __float2int_rn(x.x * FX_SCALE); xi.y = __float2int_rn(x.y * FX_SCALE); xi.z = __float2int_rn(x.z * FX_SCALE); xi.w = __float2int_rn(x.w * FX_SCALE); *(int4*)(src + i * 256 + lane * 4) = xi; }
        v[i * 4 + 0] = x.x; v[i * 4 + 1] = x.y; v[i * 4 + 2] = x.z; v[i * 4 + 3] = x.w; ss += x.x * x.x + x.y * x.y + x.z * x.z + x.w * x.w; }
    ss = wave_sum(ss);
    const float rs = rsqrtf(ss * (1.f / 1024.f) + EPS);
#pragma unroll
    for (int i = 0; i < 4; ++i) {
        const float4 w = *(const float4*)(nw + i * 256 + lane * 4), sh = *(const float4*)(shift + i * 256 + lane * 4), sc = *(const float4*)(scale + i * 256 + lane * 4);
        v[i * 4 + 0] = v[i * 4 + 0] * rs * w.x * (1.f + sc.x) + sh.x; v[i * 4 + 1] = v[i * 4 + 1] * rs * w.y * (1.f + sc.y) + sh.y;
        v[i * 4 + 2] = v[i * 4 + 2] * rs * w.z * (1.f + sc.z) + sh.z; v[i * 4 + 3] = v[i * 4 + 3] * rs * w.w * (1.f + sc.w) + sh.w;
    }
}
__device__ __forceinline__ float* stream_row(const P& p, int layer_src  , int b, int pp) {
    if (pp < CTX) return (layer_src ? (float*)(p.ws + WS_CTXS) : (float*)p.in[2]) + (size_t)(b * CTX + pp) * D;
    return (layer_src ? p.out : (float*)p.in[0]) + (size_t)(b * SEQ + pp - CTX) * D;
}

__device__ __forceinline__ void ph_norm1(const P& p, int layer, int bid, int nb) {
    const int lane = otid() & 63, wv = otid() >> 6;
    const float* MOD = (const float*)(p.ws + WS_MOD);
    const float* nw = layer ? p.in[25] : p.in[6];
    bf16_t* H = (bf16_t*)(p.ws + WS_H);
    for (int R = bid * 8 + wv; R < MT; R += nb * 8) {
        int b, pp; row_decode(R, b, pp);
        float* src = stream_row(p, layer, b, pp);
        const float* m = MOD + (size_t)(layer * 9 + (pp < CTX ? 8 : b)) * 6144;
        float v[16];
        if (layer) {
            float ss = 0.f;
#pragma unroll
            for (int i = 0; i < 4; ++i) {
                float4 x = ntld4(src + i * 256 + lane * 4); const uint2 z = ntldu2(H + (size_t)R * D + i * 256 + lane * 4);
                x.x += bflo(z.x); x.y += bfhi(z.x); x.z += bflo(z.y); x.w += bfhi(z.y);
                if (pp >= CTX) *(float4*)(src + i * 256 + lane * 4) = x;
                v[i * 4 + 0] = x.x; v[i * 4 + 1] = x.y; v[i * 4 + 2] = x.z; v[i * 4 + 3] = x.w; ss += x.x * x.x + x.y * x.y + x.z * x.z + x.w * x.w;
            }
            ss = wave_sum(ss);
            const float rs = rsqrtf(ss * (1.f / 1024.f) + EPS);
#pragma unroll
            for (int i = 0; i < 4; ++i) {
                const float4 w = *(const float4*)(nw + i * 256 + lane * 4), sh = *(const float4*)(m + i * 256 + lane * 4), sc = *(const float4*)(m + 1024 + i * 256 + lane * 4);
                v[i * 4 + 0] = v[i * 4 + 0] * rs * w.x * (1.f + sc.x) + sh.x; v[i * 4 + 1] = v[i * 4 + 1] * rs * w.y * (1.f + sc.y) + sh.y;
                v[i * 4 + 2] = v[i * 4 + 2] * rs * w.z * (1.f + sc.z) + sh.z; v[i * 4 + 3] = v[i * 4 + 3] * rs * w.w * (1.f + sc.w) + sh.w;
            }
        } else norm_mod_row<0>(src, nw, m, m + 1024, lane, v);
#pragma unroll
        for (int i = 0; i < 4; ++i) { uint2 o; o.x = pk2(v[i * 4], v[i * 4 + 1]); o.y = pk2(v[i * 4 + 2], v[i * 4 + 3]); *(uint2*)(H + (size_t)R * D + i * 256 + lane * 4) = o; }
    }
}

namespace g8 {
constexpr int BK = 64, HALF = 128, HTB = HALF * BK * 2;
constexpr int STAGE_BYTES = 8 * HTB;
__device__ __forceinline__ int lds_byte(int r, int c) { const int st = (r >> 4) * 2 + (c >> 5), rr = r & 15, cc = c & 31, ob = rr * 64 + cc * 2; return st * 1024 + (ob ^ (((ob >> 9) & 1) << 5)); }
__device__ __forceinline__ void stage_rc(int b, int& R, int& C) { const int st = b / 1024, sb = b % 1024, swz = sb ^ (((sb >> 9) & 1) << 5); R = (st >> 1) * 16 + swz / 64; C = (st & 1) * 32 + (swz % 64) / 2; }
}

template <class Epi>
__device__ __forceinline__ void gemm_unit(LAS unsigned char* lds, const unsigned char* __restrict__ Abase, unsigned a00, unsigned a01, unsigned a10, unsigned a11,
                                          const unsigned char* __restrict__ Btile, const Epi& epi) {
    using namespace g8;
    const int tid = otid(), wid = __builtin_amdgcn_readfirstlane(tid >> 6), lane = tid & 63;
    int wr = wid >> 2, wc = wid & 3, fr = lane & 15, fq = lane >> 4;
    unsigned vb0, vb1;
    { int R, C; stage_rc(tid * 16, R, C); vb0 = (unsigned)(R * 1024 + C) * 2u; stage_rc(tid * 16 + 8192, R, C); vb1 = (unsigned)(R * 1024 + C) * 2u; }
    const unsigned ldsw = (unsigned)wid * 1024u;
    const int aoff = lds_byte(wr * 64 + fr, fq * 8), boff = lds_byte(wc * 32 + fr, fq * 8);
    constexpr unsigned hstepB = HALF * 1024 * 2;
#define G_SA(b, h) (((b) * 2 + (h)) * HTB)
#define G_SB(b, h) ((4 + (b) * 2 + (h)) * HTB)
#define G_GL(gp, lo) __builtin_amdgcn_global_load_lds((const unsigned*)(gp), (LAS unsigned*)(lds + (lo)), 16, 0, 0)
#define G_STA(bufoff, h, kt) do { const unsigned char* _ub = Abase + (size_t)((kt) * 128); G_GL(_ub + ((h) ? a10 : a00), (bufoff) + ldsw); G_GL(_ub + ((h) ? a11 : a01), (bufoff) + ldsw + 8192); } while (0)
#define G_STB(bufoff, h, kt) do { const unsigned char* _ub = Btile + (size_t)((h) * hstepB + (kt) * 128); G_GL(_ub + vb0, (bufoff) + ldsw); G_GL(_ub + vb1, (bufoff) + ldsw + 8192); } while (0)
#define G_LDA(dst, b, h) do { _Pragma("unroll") for (int m = 0; m < 4; ++m) _Pragma("unroll") for (int k = 0; k < 2; ++k) dst[m][k] = *(const LAS bf16x8*)(lds + G_SA(b, h) + aoff + m * 2048 + k * 1024); } while (0)
#define G_LDB(dst, b, h) do { _Pragma("unroll") for (int n = 0; n < 2; ++n) _Pragma("unroll") for (int k = 0; k < 2; ++k) dst[n][k] = *(const LAS bf16x8*)(lds + G_SB(b, h) + boff + n * 2048 + k * 1024); } while (0)
#define G_MMA(ai, bj, At_, Bt_) do { __builtin_amdgcn_s_setprio(1); _Pragma("unroll") for (int m = 0; m < 4; ++m) _Pragma("unroll") for (int n = 0; n < 2; ++n) _Pragma("unroll") for (int k = 0; k < 2; ++k) \
        acc[ai][bj][m][n] = __builtin_amdgcn_mfma_f32_16x16x32_bf16(Bt_[n][k], At_[m][k], acc[ai][bj][m][n], 0, 0, 0); __builtin_amdgcn_s_setprio(0); } while (0)
#define G_WV(n) asm volatile("s_waitcnt vmcnt(" #n ")" ::: "memory")
#define G_WL(n) asm volatile("s_waitcnt lgkmcnt(" #n ")" ::: "memory")
#define G_BAR __builtin_amdgcn_s_barrier()
#define G_SCHED __builtin_amdgcn_sched_barrier(0)
    f32x4 acc[2][2][4][2];
#pragma unroll
    for (int a = 0; a < 2; ++a)
#pragma unroll
        for (int b = 0; b < 2; ++b)
#pragma unroll
            for (int m = 0; m < 4; ++m)
#pragma unroll
                for (int n = 0; n < 2; ++n) acc[a][b][m][n] = (f32x4){0.f, 0.f, 0.f, 0.f};
    bf16x8 At[4][2], B0[2][2], B1[2][2];
    constexpr int nt = 1024 / BK;
    G_STB(G_SB(0, 0), 0, 0); G_STA(G_SA(0, 0), 0, 0); G_STB(G_SB(0, 1), 1, 0); G_STA(G_SA(0, 1), 1, 0);
    if (wr == 1) G_BAR;
    G_WV(4); G_BAR;
    G_STB(G_SB(1, 0), 0, 1); G_STA(G_SA(1, 0), 0, 1); G_STB(G_SB(1, 1), 1, 1);
    G_WV(6); G_BAR;
    for (int t = 0; t < nt - 2; t += 2) {
        G_LDB(B0, 0, 0); G_SCHED; G_LDA(At, 0, 0); G_STA(G_SA(1, 1), 1, t + 1);
        G_WL(8); G_BAR; G_WL(0); G_MMA(0, 0, At, B0); G_BAR; G_SCHED;
        G_LDB(B1, 0, 1); G_STB(G_SB(0, 0), 0, t + 2);
        G_BAR; G_WL(0); G_MMA(0, 1, At, B1); G_BAR;
        G_LDA(At, 0, 1); G_STA(G_SA(0, 0), 0, t + 2);
        G_BAR; G_WL(0); if (epi.is_full()) G_MMA(1, 0, At, B0); G_BAR; G_SCHED;
        G_STB(G_SB(0, 1), 1, t + 2);
        G_WV(6); G_BAR; if (epi.is_full()) G_MMA(1, 1, At, B1); G_BAR;
        G_LDB(B0, 1, 0); G_SCHED; G_LDA(At, 1, 0); G_STA(G_SA(0, 1), 1, t + 2);
        G_WL(8); G_BAR; G_WL(0); G_MMA(0, 0, At, B0); G_BAR; G_SCHED;
        G_LDB(B1, 1, 1); G_STB(G_SB(1, 0), 0, t + 3);
        G_BAR; G_WL(0); G_MMA(0, 1, At, B1); G_BAR;
        G_LDA(At, 1, 1); G_STA(G_SA(1, 0), 0, t + 3);
        G_BAR; G_WL(0); if (epi.is_full()) G_MMA(1, 0, At, B0); G_BAR; G_SCHED;
        G_STB(G_SB(1, 1), 1, t + 3);
        G_WV(6); G_BAR; if (epi.is_full()) G_MMA(1, 1, At, B1); G_BAR;
    }
    { G_LDB(B0, 0, 0); G_WV(0); G_LDA(At, 0, 0); G_STA(G_SA(1, 1), 1, nt - 1);
      G_BAR; G_WL(0); G_MMA(0, 0, At, B0); G_BAR;
      G_LDB(B1, 0, 1); G_BAR; G_WL(0); G_MMA(0, 1, At, B1); G_BAR;
      G_LDA(At, 0, 1); G_WV(4); G_BAR; G_WL(0); if (epi.is_full()) G_MMA(1, 0, At, B0); if (epi.is_full()) G_MMA(1, 1, At, B1); G_BAR; }
    { G_LDB(B0, 1, 0); G_LDA(At, 1, 0); G_WV(2); G_BAR; G_WL(0); G_MMA(0, 0, At, B0); G_BAR;
      G_LDB(B1, 1, 1); G_WV(0); G_BAR; G_WL(0); G_MMA(0, 1, At, B1); G_BAR;
      G_LDA(At, 1, 1); G_BAR; G_WL(0); if (epi.is_full()) G_MMA(1, 0, At, B0); if (epi.is_full()) G_MMA(1, 1, At, B1); G_BAR; }
    if (wr == 0) G_BAR;
    int tz = otid(); asm volatile("" : "+v"(tz));
    const int w2 = __builtin_amdgcn_readfirstlane(tz >> 6), l2 = tz & 63; wr = w2 >> 2; wc = w2 & 3; fr = l2 & 15; fq = l2 >> 4;
    LAS float* stg = (LAS float*)lds;
    if constexpr (Epi::ACT) {
#pragma unroll
        for (int ai = 0; ai < 2; ++ai)
#pragma unroll
            for (int m = 0; m < 4; ++m)
#pragma unroll
                for (int n = 0; n < 2; ++n) {
                    const f32x4 r = epi.act(acc[ai][0][m][n], acc[ai][1][m][n], wc * 32 + n * 16 + fq * 4);
                    u32x2 o; o.x = pk2(r[0], r[1]); o.y = pk2(r[2], r[3]);
                    *(LAS u32x2*)(lds + (ai * 128 + wr * 64 + m * 16 + fr) * 272 + (wc * 32 + n * 16 + fq * 4) * 2) = o;
                }
        __syncthreads();
#pragma unroll 2
        for (int i = 0; i < 8; ++i) { const int r = w2 * 32 + i * 4 + (l2 >> 4), c8 = (l2 & 15) * 8; epi.row(r, c8, *(const LAS u32x4*)(lds + r * 272 + c8 * 2)); }
        __syncthreads();
    } else {
#pragma unroll
    for (int ai = 0; ai < 2; ++ai) {
        if (ai == 1 && !epi.is_full()) break;
        typename Epi::Pre pre; epi.prefetch(ai, w2, l2, pre);
#pragma unroll
        for (int bj = 0; bj < 2; ++bj)
#pragma unroll
            for (int m = 0; m < 4; ++m)
#pragma unroll
                for (int n = 0; n < 2; ++n)
                    *(LAS f32x4*)(stg + (wr * 64 + m * 16 + fr) * 260 + bj * 128 + wc * 32 + n * 16 + fq * 4) = acc[ai][bj][m][n];
        __syncthreads();
        epi.rows(ai, w2, l2, stg, pre);
        __syncthreads();
    }
    }
#undef G_SA
#undef G_SB
#undef G_GL
#undef G_STA
#undef G_STB
#undef G_LDA
#undef G_LDB
#undef G_MMA
#undef G_WV
#undef G_WL
#undef G_BAR
#undef G_SCHED
}

__device__ __forceinline__ int perm32(int rho) { const int n = rho >> 4, i = rho & 15; return 8 * (i >> 2) + 4 * n + (i & 3); }
template <class Sched, class Epi>
__device__ __forceinline__ void gemm_stream(LAS unsigned char* lds, const unsigned char* __restrict__ Abase, Sched& S, const Epi& E) {
    using namespace g8;
    typedef typename Sched::UnitT UnitT;
    const int tid = otid(), wid = __builtin_amdgcn_readfirstlane(tid >> 6), lane = tid & 63;
    int wr = wid >> 2, wc = wid & 3, fr = lane & 15, fq = lane >> 4;
    unsigned vb0, vb1;
    { int R, C; stage_rc(tid * 16, R, C); const int Rb0 = Epi::PERM ? ((R & ~31) + perm32(R & 31)) : R; vb0 = (unsigned)(Rb0 * 1024 + C) * 2u;
      stage_rc(tid * 16 + 8192, R, C); const int Rb1 = Epi::PERM ? ((R & ~31) + perm32(R & 31)) : R; vb1 = (unsigned)(Rb1 * 1024 + C) * 2u; }
    const unsigned ldsw = (unsigned)wid * 1024u;
    const int aoff = lds_byte(wr * 64 + fr, fq * 8), boff = lds_byte(wc * 32 + fr, fq * 8);
    constexpr unsigned hstepB = HALF * 1024 * 2;
#define S_SA(b, h) (((b) * 2 + (h)) * HTB)
#define S_SB(b, h) ((4 + (b) * 2 + (h)) * HTB)
#define S_GL(gp, lo) __builtin_amdgcn_global_load_lds((const unsigned*)(gp), (LAS unsigned*)(lds + (lo)), 16, 0, 0)
#define S_STA(bufoff, U, h, kt) do { const unsigned char* _ub = Abase + (size_t)((kt) * 128); S_GL(_ub + (U).a[h][0], (bufoff) + ldsw); S_GL(_ub + (U).a[h][1], (bufoff) + ldsw + 8192); } while (0)
#define S_STB(bufoff, U, h, kt) do { const unsigned char* _ub = (U).Bt + (size_t)((h) * hstepB + (kt) * 128); S_GL(_ub + vb0, (bufoff) + ldsw); S_GL(_ub + vb1, (bufoff) + ldsw + 8192); } while (0)
#define S_LDA(dst, b, h) do { _Pragma("unroll") for (int m = 0; m < 4; ++m) _Pragma("unroll") for (int k = 0; k < 2; ++k) dst[m][k] = *(const LAS bf16x8*)(lds + S_SA(b, h) + aoff + m * 2048 + k * 1024); } while (0)
#define S_LDB(dst, b, h) do { _Pragma("unroll") for (int n = 0; n < 2; ++n) _Pragma("unroll") for (int k = 0; k < 2; ++k) dst[n][k] = *(const LAS bf16x8*)(lds + S_SB(b, h) + boff + n * 2048 + k * 1024); } while (0)
#define S_MMA(ai, bj, At_, Bt_) do { __builtin_amdgcn_s_setprio(1); _Pragma("unroll") for (int m = 0; m < 4; ++m) _Pragma("unroll") for (int n = 0; n < 2; ++n) _Pragma("unroll") for (int k = 0; k < 2; ++k) \
        acc[ai][bj][m][n] = __builtin_amdgcn_mfma_f32_16x16x32_bf16(Bt_[n][k], At_[m][k], acc[ai][bj][m][n], 0, 0, 0); __builtin_amdgcn_s_setprio(0); } while (0)
#define S_WV(n) asm volatile("s_waitcnt vmcnt(" #n ")" ::: "memory")
#define S_WL(n) asm volatile("s_waitcnt lgkmcnt(" #n ")" ::: "memory")
#define S_BAR __builtin_amdgcn_s_barrier()
#define S_SCHED __builtin_amdgcn_sched_barrier(0)
    UnitT cur, nxt; int ui = 0;
    if (!S.next(0, cur)) return;
    f32x4 acc[2][2][4][2];
#pragma unroll
    for (int a = 0; a < 2; ++a)
#pragma unroll
        for (int b = 0; b < 2; ++b)
#pragma unroll
            for (int m = 0; m < 4; ++m)
#pragma unroll
                for (int n = 0; n < 2; ++n) acc[a][b][m][n] = (f32x4){0.f, 0.f, 0.f, 0.f};
    bf16x8 At[4][2], B0[2][2], B1[2][2];
    constexpr int nt = 1024 / BK;
    S_STB(S_SB(0, 0), cur, 0, 0); S_STA(S_SA(0, 0), cur, 0, 0); S_STB(S_SB(0, 1), cur, 1, 0); S_STA(S_SA(0, 1), cur, 1, 0);
    if (wr == 1) S_BAR;
    S_WV(4); S_BAR;
    S_STB(S_SB(1, 0), cur, 0, 1); S_STA(S_SA(1, 0), cur, 0, 1); S_STB(S_SB(1, 1), cur, 1, 1);
    S_WV(6); S_BAR;
    for (;;) {
        const bool has_next = S.next(ui + 1, nxt);
        if (!has_next) nxt = cur;
#pragma unroll 1
        for (int t = 0; t < nt; t += 2) {
            const bool last = (t == nt - 2);
            S_LDB(B0, 0, 0); S_SCHED; S_LDA(At, 0, 0); S_STA(S_SA(1, 1), cur, 1, t + 1);
            S_WL(8); S_BAR; S_WL(0); S_MMA(0, 0, At, B0); S_BAR; S_SCHED;
            S_LDB(B1, 0, 1); if (last) S_STB(S_SB(0, 0), nxt, 0, 0); else S_STB(S_SB(0, 0), cur, 0, t + 2);
            S_BAR; S_WL(0); S_MMA(0, 1, At, B1); S_BAR;
            S_LDA(At, 0, 1); if (last) S_STA(S_SA(0, 0), nxt, 0, 0); else S_STA(S_SA(0, 0), cur, 0, t + 2);
            S_BAR; S_WL(0); S_MMA(1, 0, At, B0); S_BAR; S_SCHED;
            if (last) S_STB(S_SB(0, 1), nxt, 1, 0); else S_STB(S_SB(0, 1), cur, 1, t + 2);
            S_WV(6); S_BAR; S_MMA(1, 1, At, B1); S_BAR;
            S_LDB(B0, 1, 0); S_SCHED; S_LDA(At, 1, 0); if (last) S_STA(S_SA(0, 1), nxt, 1, 0); else S_STA(S_SA(0, 1), cur, 1, t + 2);
            S_WL(8); S_BAR; S_WL(0); S_MMA(0, 0, At, B0); S_BAR; S_SCHED;
            S_LDB(B1, 1, 1); if (last) S_STB(S_SB(1, 0), nxt, 0, 1); else S_STB(S_SB(1, 0), cur, 0, t + 3);
            S_BAR; S_WL(0); S_MMA(0, 1, At, B1); S_BAR;
            S_LDA(At, 1, 1); if (last) S_STA(S_SA(1, 0), nxt, 0, 1); else S_STA(S_SA(1, 0), cur, 0, t + 3);
            S_BAR; S_WL(0); S_MMA(1, 0, At, B0); S_BAR; S_SCHED;
            if (last) S_STB(S_SB(1, 1), nxt, 1, 1); else S_STB(S_SB(1, 1), cur, 1, t + 3);
            S_WV(6); S_BAR; S_MMA(1, 1, At, B1); S_BAR;
        }
        E(acc, cur, wr, wc, fr, fq);
        if (!has_next) break;
#pragma unroll
        for (int a = 0; a < 2; ++a)
#pragma unroll
            for (int b = 0; b < 2; ++b)
#pragma unroll
                for (int m = 0; m < 4; ++m)
#pragma unroll
                    for (int n = 0; n < 2; ++n) acc[a][b][m][n] = (f32x4){0.f, 0.f, 0.f, 0.f};
        cur = nxt; ++ui;
    }
    S_WV(0);
    if (wr == 0) S_BAR;
    S_BAR;
#undef S_SA
#undef S_SB
#undef S_GL
#undef S_STA
#undef S_STB
#undef S_LDA
#undef S_LDB
#undef S_MMA
#undef S_WV
#undef S_WL
#undef S_BAR
#undef S_SCHED
}

__device__ __forceinline__ void a_offsets_plain(unsigned row0, unsigned& a00, unsigned& a01, unsigned& a10, unsigned& a11) {
    int R0, C0, R1, C1; g8::stage_rc(otid() * 16, R0, C0); g8::stage_rc(otid() * 16 + 8192, R1, C1);
    a00 = (row0 + R0) * 2048u + C0 * 2u; a01 = (row0 + R1) * 2048u + C1 * 2u;
    a10 = (row0 + 128 + R0) * 2048u + C0 * 2u; a11 = (row0 + 128 + R1) * 2048u + C1 * 2u;
}

__device__ __forceinline__ void unit_decode(int L, int nM, int nN, int& pm, int& pn) {
    const int nig = 8 * nN, gid = L / nig, fm = gid * 8, gsz = (nM - fm) < 8 ? (nM - fm) : 8, rem = L - gid * nig;
    pm = fm + rem % gsz; pn = rem / gsz;
}
__device__ __forceinline__ bool unit_map(int i, int bid, int nb, int nM, int nN, int& pm, int& pn) {
    int L;
    if ((nb & 7) == 0) L = (i * 8 + (bid & 7)) * (nb >> 3) + (bid >> 3); else L = i * nb + bid;
    if (L >= nM * nN) return false;
    unit_decode(L, nM, nN, pm, pn);
    return true;
}

struct EpiNoPre { };
struct EpiProj {
    static constexpr bool ACT = false;
    __device__ __forceinline__ bool is_full() const { return true; }
    typedef EpiNoPre Pre;
    bf16_t* out; int ld, nreal, row0, col0;
    __device__ __forceinline__ void prefetch(int, int, int, Pre&) const {}
    __device__ __forceinline__ void rows(int ai, int w2, int lane, const LAS float* stg, const Pre&) const {
        const int col = col0 + lane * 4;
        if (col < nreal) {
#pragma unroll 4
            for (int i = 0; i < 16; ++i) { const int r = w2 * 16 + i; const f32x4 a = *(const LAS f32x4*)(stg + r * 260 + lane * 4);
                u32x2 o; o.x = pk2(a[0], a[1]); o.y = pk2(a[2], a[3]); __builtin_nontemporal_store(o, (u32x2*)(out + (size_t)(row0 + ai * 128 + r) * ld + col)); }
        }
    }
};

struct UnitPlain { unsigned a[2][2]; const unsigned char* Bt; int row0, col0; };
struct SchedPlain {
    typedef UnitPlain UnitT;
    const unsigned char* Bt; int bid, nb, nM, nN;
    __device__ __forceinline__ bool next(int i, UnitT& u) const {
        int pm, pn; if (!unit_map(i, bid, nb, nM, nN, pm, pn)) return false;
        a_offsets_plain(pm * 256, u.a[0][0], u.a[0][1], u.a[1][0], u.a[1][1]);
        u.Bt = Bt + (size_t)pn * 256 * 2048; u.row0 = pm * 256; u.col0 = pn * 256; return true;
    }
};
struct DEpiProj {
    static constexpr bool PERM = true;
    bf16_t* out; int ld, nreal;
    __device__ __forceinline__ void operator()(const f32x4 (&acc)[2][2][4][2], const UnitPlain& u, int wr, int wc, int fr, int fq) const {
#pragma unroll
        for (int ai = 0; ai < 2; ++ai)
#pragma unroll
            for (int m = 0; m < 4; ++m) {
                bf16_t* rowp = out + (size_t)(u.row0 + ai * 128 + wr * 64 + m * 16 + fr) * ld;
#pragma unroll
                for (int bj = 0; bj < 2; ++bj) {
                    const int col = u.col0 + bj * 128 + wc * 32 + 8 * fq;
                    if (col < nreal) { const f32x4 v0 = acc[ai][bj][m][0], v1 = acc[ai][bj][m][1];
                        u32x4 o; o.x = pk2(v0[0], v0[1]); o.y = pk2(v0[2], v0[3]); o.z = pk2(v1[0], v1[1]); o.w = pk2(v1[2], v1[3]);
                        __builtin_nontemporal_store(o, (u32x4*)(rowp + col)); }
                }
            }
    }
};
__device__ __forceinline__ void ph_inproj(const P& p, int layer, LAS unsigned char* lds, int bid, int nb) {
    SchedPlain S{p.ws + (layer ? WS_WIN1 : WS_WIN0), bid, nb, MT / 256, layer ? (NIN1P / 256) : (NIN0P / 256)};
    DEpiProj E{(bf16_t*)(p.ws + WS_BIG), layer ? NIN1 : NIN0, layer ? NIN1 : NIN0};
    __syncthreads();
    gemm_stream(lds, p.ws + WS_H, S, E);
    __syncthreads();
}

struct Pre8 { float4 x[8]; };
struct EpiOut {
    static constexpr bool ACT = false;
    __device__ __forceinline__ bool is_full() const { return true; }
    typedef Pre8 Pre;
    const float* src; float* dst; const float* g; size_t ro0; int col0;
    __device__ __forceinline__ void prefetch(int ai, int w2, int lane, Pre& pre) const {
#pragma unroll
        for (int i = 0; i < 8; ++i) pre.x[i] = ntld4(src + ro0 + (size_t)(ai * 128 + w2 * 16 + i) * D + col0 + lane * 4);
    }
    __device__ __forceinline__ void rows(int ai, int w2, int lane, const LAS float* stg, const Pre& pre) const {
        const int col = col0 + lane * 4; const float4 gg = *(const float4*)(g + col);
        float4 x2[8];
#pragma unroll
        for (int i = 0; i < 8; ++i) x2[i] = ntld4(src + ro0 + (size_t)(ai * 128 + w2 * 16 + 8 + i) * D + col);
#pragma unroll
        for (int i = 0; i < 16; ++i) {
            const int r = w2 * 16 + i; const f32x4 a = *(const LAS f32x4*)(stg + r * 260 + lane * 4);
            const float4 x = i < 8 ? pre.x[i & 7] : x2[i & 7];
            float4 y; y.x = x.x + gg.x * a[0]; y.y = x.y + gg.y * a[1]; y.z = x.z + gg.z * a[2]; y.w = x.w + gg.w * a[3];
            *(float4*)(dst + ro0 + (size_t)(ai * 128 + r) * D + col) = y;
        }
    }
};

__device__ __forceinline__ void ph_outproj(const P& p, int layer, LAS unsigned char* lds, int bid, int nb) {
    const int nrt = layer ? 256 : 264;
    const int nunits = nrt * 4;
    const unsigned char* A = p.ws + WS_H;
    const unsigned char* Bt = p.ws + WS_WOUT + (size_t)layer * 1024 * 2048;
    (void)nunits;
    for (int it = 0;; ++it) {
        int j, pn; if (!unit_map(it, bid, nb, nrt, 4, j, pn)) break;
        const int pm = layer ? ((j >> 5) * 33 + 1 + (j & 31)) : j;
        unsigned a00, a01, a10, a11; a_offsets_plain(pm * 256, a00, a01, a10, a11);
        int b, pp0; row_decode(pm * 256, b, pp0);
        const bool isctx = pp0 < CTX;
        const float* MOD = (const float*)(p.ws + WS_MOD);
        EpiOut E{isctx ? (layer ? (const float*)(p.ws + WS_CTXS) : p.in[2]) : (layer ? (const float*)p.out : p.in[0]), isctx ? (float*)(p.ws + WS_CTXS) : p.out,
                 MOD + (size_t)(layer * 9 + (isctx ? 8 : b)) * 6144 + 2048, isctx ? (size_t)(b * CTX + pp0) * D : (size_t)(b * SEQ + pp0 - CTX) * D, pn * 256};
        gemm_unit(lds, A, a00, a01, a10, a11, Bt + (size_t)pn * 256 * 2048, E);
    }
}

constexpr int TC = 32;
__device__ __forceinline__ int seq_pp(int n, int dir) { return dir == 0 ? n : (n < CTX ? (CTX - 1 - n) : (PB + CTX - 1 - n)); }

template <int DK, int MODE  >
__device__ __forceinline__ void scan_chunk(const float* qs, const float* ks_, const float* as_, const float* vs, const float* egs, const float* bts, float* os, float (&S)[DK / 8], int w, int cl, int ksl) {
    constexpr int NR = DK / 8;
    for (int tt = 0; tt < TC; ++tt) {
        const float vv = vs[tt * 64 + w * 8 + cl];
        float qv[NR], kv[NR], av[NR];
#pragma unroll
        for (int r4 = 0; r4 < NR / 4; ++r4) {
            const float4 q4 = *(const float4*)(qs + tt * DK + ksl * NR + r4 * 4); qv[r4 * 4] = q4.x; qv[r4 * 4 + 1] = q4.y; qv[r4 * 4 + 2] = q4.z; qv[r4 * 4 + 3] = q4.w;
            if (MODE != 1) { const float4 k4 = *(const float4*)(ks_ + tt * DK + ksl * NR + r4 * 4); kv[r4 * 4] = k4.x; kv[r4 * 4 + 1] = k4.y; kv[r4 * 4 + 2] = k4.z; kv[r4 * 4 + 3] = k4.w; }
            if (MODE != 2) { const float4 a4 = *(const float4*)(as_ + tt * DK + ksl * NR + r4 * 4); av[r4 * 4] = a4.x; av[r4 * 4 + 1] = a4.y; av[r4 * 4 + 2] = a4.z; av[r4 * 4 + 3] = a4.w; }
        }
        float o = 0.f;
        if (MODE == 0) {
#pragma unroll
            for (int r = 0; r < NR; ++r) { S[r] = av[r] * S[r] + kv[r] * vv; o += qv[r] * S[r]; }
        } else if (MODE == 1) {
#pragma unroll
            for (int r = 0; r < NR; ++r) { S[r] = av[r] * S[r] + (1.f - av[r]) * vv; o += qv[r] * S[r]; }
        } else {
            const float eg = egs[tt], bt = bts[tt];
            float kS = 0.f;
#pragma unroll
            for (int r = 0; r < NR; ++r) kS += kv[r] * S[r];
            kS = red8(kS);
            const float c = bt * (vv - eg * kS);
#pragma unroll
            for (int r = 0; r < NR; ++r) { S[r] = eg * S[r] + kv[r] * c; o += qv[r] * S[r]; }
        }
        o = red8(o);
        if (ksl == 0) os[tt * 64 + w * 8 + cl] = o;
    }
}

__device__ __forceinline__ void scan_unit_l0(const P& p, int u, float* ldsf) {
    const int type = u >> 7, idx = u & 127, b = idx >> 4, h = (idx >> 2) & 3, dir = (idx >> 1) & 1, half = idx & 1;
    const int tid = otid(), lane = tid & 63, w = tid >> 6, cl = lane >> 3, ksl = lane & 7;
    const bf16_t* PROJ = (const bf16_t*)(p.ws + WS_BIG);
    bf16_t* OD = (bf16_t*)(p.ws + WS_SCR) + (size_t)dir * MT * D;
    if (type == 0) {
        float* qs = ldsf; float* ks_ = qs + TC * 64; float* as_ = ks_ + TC * 64; float* vs = as_ + TC * 64; float* os = vs + TC * 64; float* rs = os + TC * 64;
        const float* W2 = (dir ? p.in[11] : p.in[9]); const float* B2 = (dir ? p.in[12] : p.in[10]);
        const int i = tid & 63;
        float w2c[16];
#pragma unroll
        for (int m = 0; m < 16; ++m) w2c[m] = W2[m * 256 + h * 64 + i];
        const float b2c = B2[h * 64 + i];
        float S[8];
#pragma unroll
        for (int r = 0; r < 8; ++r) S[r] = 0.f;
        for (int c0 = 0; c0 < PB; c0 += TC) {
            __syncthreads();
#pragma unroll
            for (int j = 0; j < 4; ++j) {
                const int t = (tid >> 6) + 8 * j; const size_t R = (size_t)b * PB + seq_pp(c0 + t, dir);
                const bf16_t* row = PROJ + R * NIN0;
                qs[t * 64 + i] = bf2f(row[h * 64 + i]) * 0.125f;
                ks_[t * 64 + i] = bf2f(row[256 + h * 64 + i]);
                vs[t * 64 + i] = bf2f(row[512 + h * 128 + half * 64 + i]);
            }
            { const int t = tid >> 4, m = tid & 15; const size_t R = (size_t)b * PB + seq_pp(c0 + t, dir); rs[t * 16 + m] = bf2f(PROJ[R * NIN0 + 1024 + dir * 16 + m]); }
            __syncthreads();
#pragma unroll
            for (int j = 0; j < 4; ++j) {
                const int t = (tid >> 6) + 8 * j;
                float z = b2c;
#pragma unroll
                for (int m = 0; m < 16; ++m) z += rs[t * 16 + m] * w2c[m];
                const float ls = fminf(z, 0.f) - __logf(1.f + __expf(-fabsf(z)));
                as_[t * 64 + i] = __expf(ls * (1.f / 16.f));
            }
            __syncthreads();
            scan_chunk<64, 0>(qs, ks_, as_, vs, nullptr, nullptr, os, S, w, cl, ksl);
            __syncthreads();
            { const int t = tid >> 4, c4 = (tid & 15) * 4; const size_t R = (size_t)b * PB + seq_pp(c0 + t, dir);
              uint2 o; o.x = pk2(os[t * 64 + c4], os[t * 64 + c4 + 1]); o.y = pk2(os[t * 64 + c4 + 2], os[t * 64 + c4 + 3]);
              *(uint2*)(OD + R * D + h * 128 + half * 64 + c4) = o; }
        }
    } else {
        float* qs = ldsf; float* fs = qs + TC * 128; float* vs = fs + TC * 128; float* os = vs + TC * 64;
        const int i = tid & 127;
        const float* lbl = p.in[15];
        const float lb = 1.f / (1.f + __expf(lbl[512 + h * 128 + i] - lbl[h * 128 + i]));
        float S[16];
#pragma unroll
        for (int r = 0; r < 16; ++r) S[r] = 0.f;
        for (int c0 = 0; c0 < PB; c0 += TC) {
            __syncthreads();
#pragma unroll
            for (int j = 0; j < 8; ++j) {
                const int t = (tid >> 7) + 4 * j; const size_t R = (size_t)b * PB + seq_pp(c0 + t, dir);
                const bf16_t* row = PROJ + R * NIN0;
                qs[t * 128 + i] = bf2f(row[1568 + h * 128 + i]);
                const float z = bf2f(row[2080 + dir * 512 + h * 128 + i]);
                fs[t * 128 + i] = lb + (1.f - lb) * sigmoidf_(z);
            }
#pragma unroll
            for (int j = 0; j < 4; ++j) {
                const int t = (tid >> 6) + 8 * j; const size_t R = (size_t)b * PB + seq_pp(c0 + t, dir);
                vs[t * 64 + (tid & 63)] = bf2f(PROJ[R * NIN0 + 3104 + h * 128 + half * 64 + (tid & 63)]);
            }
            __syncthreads();
            scan_chunk<128, 1>(qs, nullptr, fs, vs, nullptr, nullptr, os, S, w, cl, ksl);
            __syncthreads();
            { const int t = tid >> 4, c4 = (tid & 15) * 4; const size_t R = (size_t)b * PB + seq_pp(c0 + t, dir);
              uint2 o; o.x = pk2(os[t * 64 + c4], os[t * 64 + c4 + 1]); o.y = pk2(os[t * 64 + c4 + 2], os[t * 64 + c4 + 3]);
              *(uint2*)(OD + R * D + 512 + h * 128 + half * 64 + c4) = o; }
        }
    }
}

template <int NK>
__device__ __forceinline__ f32x4 mma_tile(const LAS unsigned char* A, int strideA, int rowA0, const LAS unsigned char* B, int strideB, int rowB0, f32x4 acc, int lane) {
    const int r = lane & 15, q = lane >> 4;
    const LAS unsigned char* ap = A + (rowA0 + r) * strideA + q * 16;
    const LAS unsigned char* bp = B + (rowB0 + r) * strideB + q * 16;
#pragma unroll
    for (int kb = 0; kb < NK; ++kb) {
        const bf16x8 a = *(const LAS bf16x8*)(ap + kb * 64), b = *(const LAS bf16x8*)(bp + kb * 64);
        acc = __builtin_amdgcn_mfma_f32_16x16x32_bf16(a, b, acc, 0, 0, 0);
    }
    return acc;
}
template <int NK>
__device__ __forceinline__ f32x4 mma_tile_rows(const LAS unsigned char* A, int strideA, int rowA, const LAS unsigned char* B, int strideB, int rowB0, f32x4 acc, int lane) {
    const int r = lane & 15, q = lane >> 4;
    const LAS unsigned char* ap = A + rowA * strideA + q * 16;
    const LAS unsigned char* bp = B + (rowB0 + r) * strideB + q * 16;
#pragma unroll
    for (int kb = 0; kb < NK; ++kb) {
        const bf16x8 a = *(const LAS bf16x8*)(ap + kb * 64), b = *(const LAS bf16x8*)(bp + kb * 64);
        acc = __builtin_amdgcn_mfma_f32_16x16x32_bf16(a, b, acc, 0, 0, 0);
    }
    return acc;
}
__device__ __forceinline__ float fexp(float x) { return __builtin_amdgcn_exp2f(x * 1.4426950408889634f); }
__device__ __forceinline__ float flog(float x) { return __builtin_amdgcn_logf(x) * 0.6931471805599453f; }
__device__ __forceinline__ float clamp80(float x) { return fminf(fmaxf(x, -80.f), 80.f); }

template <int TYPE  >
__device__ __forceinline__ void scan_l0_chunked(const P& p, int idx, LAS unsigned char* lds) {
    constexpr int DK = TYPE ? 128 : 64, C = 64, CPT = DK / 64, TL = 8, NSEG = 8;
    constexpr int SQ = DK * 2 + 16, S64 = 144;
    constexpr int OFF_QM = 0, OFF_KM = OFF_QM + C * SQ, OFF_QS = OFF_KM + C * SQ, OFF_KL = OFF_QS + C * SQ, OFF_VT = OFF_KL + DK * S64, OFF_P = OFF_VT + 64 * S64,
                  OFF_S0 = OFF_P + 64 * S64, OFF_S1 = OFF_S0 + 64 * SQ, OFF_TOT = OFF_S1 + 64 * SQ, OFF_D = OFF_TOT + NSEG * DK * 4, OFF_END = OFF_D + DK * 4;
    static_assert(OFF_END <= LDS_CTL, "scan LDS");
    const int b = idx >> 4, h = (idx >> 2) & 3, dir = (idx >> 1) & 1, half = idx & 1;
    const int tid = otid(), lane = tid & 63, w = __builtin_amdgcn_readfirstlane(tid >> 6), r16 = lane & 15, q4 = lane >> 4;
    const int i0 = lane * CPT, seg = w;
    const bf16_t* PROJ = (const bf16_t*)(p.ws + WS_BIG);
    bf16_t* OD = (bf16_t*)(p.ws + WS_SCR) + (size_t)dir * MT * D + (TYPE ? 512 : 0) + h * 128 + half * 64;
    LAS float* TOT = (LAS float*)(lds + OFF_TOT); LAS float* DV = (LAS float*)(lds + OFF_D);
    float lb[CPT], b2c = 0.f; float w2c[16];
    if (TYPE) { const float* lbl = p.in[15];
#pragma unroll
        for (int c = 0; c < CPT; ++c) lb[c] = 1.f / (1.f + fexp(lbl[512 + h * 128 + i0 + c] - lbl[h * 128 + i0 + c])); }
    else { const float* W2 = dir ? p.in[11] : p.in[9]; const float* B2 = dir ? p.in[12] : p.in[10]; lb[0] = 0.f;
#pragma unroll
        for (int m = 0; m < 16; ++m) w2c[m] = W2[m * 256 + h * 64 + i0];
        b2c = B2[h * 64 + i0]; }
    const int qcol = TYPE ? (1568 + h * 128 + i0) : (h * 64 + i0);
    const int zcol = TYPE ? (2080 + dir * 512 + h * 128 + i0) : (256 + h * 64 + i0);
    const int vcol = (TYPE ? (3104 + h * 128) : (512 + h * 128)) + half * 64 + (tid & 7) * 8;
    constexpr int NST = TYPE ? 4 : 2;
    const int it = TYPE ? w : (w >> 1), ct0 = TYPE ? 0 : ((w & 1) * 2);
    f32x4 sacc[NST];
#pragma unroll
    for (int k = 0; k < NST; ++k) sacc[k] = (f32x4){0.f, 0.f, 0.f, 0.f};
    __syncthreads();
    for (int k = tid; k < 64 * SQ / 4; k += NTHR) ((LAS unsigned*)(lds + OFF_S0))[k] = 0u;
    int cur = 0;
    unsigned rq[TL], rz[TL]; uint4 rv; uint4 rr[TYPE ? 1 : 2 * TL];
#define L0_LOAD(n) do { \
        _Pragma("unroll") for (int j = 0; j < TL; ++j) { const size_t R = (size_t)b * PB + seq_pp((n) * C + seg * TL + j, dir); const bf16_t* row = PROJ + R * NIN0; \
            if (CPT == 2) { rq[j] = *(const unsigned*)(row + qcol); rz[j] = *(const unsigned*)(row + zcol); } else { rq[j] = row[qcol]; rz[j] = row[zcol]; } \
            if (!TYPE) { rr[2 * j] = *(const uint4*)(row + 1024 + dir * 16); rr[2 * j + 1] = *(const uint4*)(row + 1024 + dir * 16 + 8); } } \
        { const size_t R = (size_t)b * PB + seq_pp((n) * C + (tid >> 3), dir); rv = *(const uint4*)(PROJ + R * NIN0 + vcol); } } while (0)
    L0_LOAD(0);
    for (int n = 0; n < PB / C; ++n) {
        float qv[CPT][TL], kv[CPT][TL], Bl[CPT][TL];
        float run[CPT];
#pragma unroll
        for (int c = 0; c < CPT; ++c) run[c] = 0.f;
#pragma unroll
        for (int j = 0; j < TL; ++j) {
#pragma unroll
            for (int c = 0; c < CPT; ++c) {
                const float qr = c ? bfhi(rq[j]) : bflo(rq[j]), zr = c ? bfhi(rz[j]) : bflo(rz[j]);
                float G;
                if (TYPE) { const float f = lb[c] + (1.f - lb[c]) * __builtin_amdgcn_rcpf(1.f + fexp(-zr)); G = flog(f); kv[c][j] = 1.f - f; qv[c][j] = qr; }
                else {
                    const uint4 r0 = rr[2 * j], r1 = rr[2 * j + 1];
                    float z = b2c;
                    z += bflo(r0.x) * w2c[0] + bfhi(r0.x) * w2c[1] + bflo(r0.y) * w2c[2] + bfhi(r0.y) * w2c[3] + bflo(r0.z) * w2c[4] + bfhi(r0.z) * w2c[5] + bflo(r0.w) * w2c[6] + bfhi(r0.w) * w2c[7];
                    z += bflo(r1.x) * w2c[8] + bfhi(r1.x) * w2c[9] + bflo(r1.y) * w2c[10] + bfhi(r1.y) * w2c[11] + bflo(r1.z) * w2c[12] + bfhi(r1.z) * w2c[13] + bflo(r1.w) * w2c[14] + bfhi(r1.w) * w2c[15];
                    G = (fminf(z, 0.f) - flog(1.f + fexp(-fabsf(z)))) * (1.f / 16.f);
                    kv[c][j] = zr; qv[c][j] = qr * 0.125f;
                }
                run[c] += G; Bl[c][j] = run[c];
            }
        }
#pragma unroll
        for (int c = 0; c < CPT; ++c) TOT[seg * DK + i0 + c] = run[c];
        const uint4 vraw = rv;
        LDS_SYNC();
        float offs[CPT], mref[CPT], blast[CPT];
#pragma unroll
        for (int c = 0; c < CPT; ++c) { offs[c] = 0.f; mref[c] = 0.f; blast[c] = 0.f; }
#pragma unroll
        for (int s2 = 0; s2 < NSEG; ++s2)
#pragma unroll
            for (int c = 0; c < CPT; ++c) { const float tv = TOT[s2 * DK + i0 + c]; offs[c] += (s2 < seg) ? tv : 0.f; mref[c] += (s2 < NSEG / 2) ? tv : 0.f; blast[c] += tv; }
        {
            unsigned kl[CPT][TL / 2];
#pragma unroll
            for (int j = 0; j < TL; ++j) {
                const int t = seg * TL + j;
                float qm[CPT], km[CPT], qs[CPT], kq[CPT];
#pragma unroll
                for (int c = 0; c < CPT; ++c) { const float Bt = offs[c] + Bl[c][j]; const float e1 = fexp(clamp80(Bt - mref[c])), e2 = __builtin_amdgcn_rcpf(e1), eb = fexp(Bt), el = fexp(blast[c] - Bt);
                    qm[c] = qv[c][j] * e1; km[c] = kv[c][j] * e2; qs[c] = qv[c][j] * eb; kq[c] = kv[c][j] * el; }
                if (CPT == 2) {
                    *(LAS unsigned*)(lds + OFF_QM + t * SQ + i0 * 2) = pk2(qm[0], qm[CPT - 1]);
                    *(LAS unsigned*)(lds + OFF_KM + t * SQ + i0 * 2) = pk2(km[0], km[CPT - 1]);
                    *(LAS unsigned*)(lds + OFF_QS + t * SQ + i0 * 2) = pk2(qs[0], qs[CPT - 1]);
                } else {
                    *(LAS bf16_t*)(lds + OFF_QM + t * SQ + i0 * 2) = f2bf(qm[0]);
                    *(LAS bf16_t*)(lds + OFF_KM + t * SQ + i0 * 2) = f2bf(km[0]);
                    *(LAS bf16_t*)(lds + OFF_QS + t * SQ + i0 * 2) = f2bf(qs[0]);
                }
#pragma unroll
                for (int c = 0; c < CPT; ++c) {
                    if (j & 1) kl[c][j >> 1] = (kl[c][j >> 1] & 0xffffu) | ((unsigned)f2bf(kq[c]) << 16); else kl[c][j >> 1] = (unsigned)f2bf(kq[c]);
                }
            }
#pragma unroll
            for (int c = 0; c < CPT; ++c) {
                *(LAS u32x4*)(lds + OFF_KL + (i0 + c) * S64 + (seg * TL) * 2) = (u32x4){kl[c][0], kl[c][1], kl[c][2], kl[c][3]};
                if (seg == 0) DV[i0 + c] = fexp(blast[c]);
            }
            const int tv = tid >> 3, c8 = (tid & 7) * 8;
            const unsigned vw[4] = {vraw.x, vraw.y, vraw.z, vraw.w};
#pragma unroll
            for (int e = 0; e < 4; ++e) { *(LAS bf16_t*)(lds + OFF_VT + (c8 + 2 * e) * S64 + tv * 2) = (bf16_t)(vw[e] & 0xffffu); *(LAS bf16_t*)(lds + OFF_VT + (c8 + 2 * e + 1) * S64 + tv * 2) = (bf16_t)(vw[e] >> 16); }
        }
        LDS_SYNC();
        if (n + 1 < PB / C) L0_LOAD(n + 1);
#pragma unroll
        for (int k = 0; k < 2; ++k) {
            const int tile = w + 8 * k, st = tile >> 2, tt = tile & 3;
            f32x4 d = (f32x4){0.f, 0.f, 0.f, 0.f};
            if (st <= tt) d = mma_tile<DK / 32>(lds + OFF_KM, SQ, st * 16, lds + OFF_QM, SQ, tt * 16, d, lane);
            const int s0 = st * 16 + 4 * q4, t = tt * 16 + r16;
            u32x2 o; o.x = pk2(s0 <= t ? d[0] : 0.f, s0 + 1 <= t ? d[1] : 0.f); o.y = pk2(s0 + 2 <= t ? d[2] : 0.f, s0 + 3 <= t ? d[3] : 0.f);
            *(LAS u32x2*)(lds + OFF_P + t * S64 + s0 * 2) = o;
        }
        {
            const f32x4 dv = *(const LAS f32x4*)(DV + it * 16 + 4 * q4);
            const int snx = cur ? OFF_S0 : OFF_S1;
#pragma unroll
            for (int k = 0; k < NST; ++k) {
                const int ct = ct0 + k;
                f32x4 a = sacc[k]; a[0] *= dv[0]; a[1] *= dv[1]; a[2] *= dv[2]; a[3] *= dv[3];
                a = mma_tile<2>(lds + OFF_KL, S64, it * 16, lds + OFF_VT, S64, ct * 16, a, lane);
                sacc[k] = a;
                u32x2 o; o.x = pk2(a[0], a[1]); o.y = pk2(a[2], a[3]);
                *(LAS u32x2*)(lds + snx + (ct * 16 + r16) * SQ + (it * 16 + 4 * q4) * 2) = o;
            }
        }
        LDS_SYNC();
        {
            const int scu = cur ? OFF_S1 : OFF_S0;
#pragma unroll
            for (int k = 0; k < 2; ++k) {
                const int tile = 2 * w + k, ct = tile >> 2, tt = tile & 3;
                f32x4 d = (f32x4){0.f, 0.f, 0.f, 0.f};
                d = mma_tile<2>(lds + OFF_VT, S64, ct * 16, lds + OFF_P, S64, tt * 16, d, lane);
                d = mma_tile<DK / 32>(lds + scu, SQ, ct * 16, lds + OFF_QS, SQ, tt * 16, d, lane);
                const size_t R = (size_t)b * PB + seq_pp(n * C + tt * 16 + r16, dir);
                uint2 o; o.x = pk2(d[0], d[1]); o.y = pk2(d[2], d[3]);
                *(uint2*)(OD + R * D + ct * 16 + 4 * q4) = o;
            }
        }
        cur ^= 1;
    }
#undef L0_LOAD
}

__device__ __forceinline__ void scan_unit_delta(const P& p, int idx, float* ldsf) {
    const int b = idx >> 4, h = (idx >> 2) & 3, dir = (idx >> 1) & 1, half = idx & 1;
    const int tid = otid(), lane = tid & 63, w = tid >> 6, cl = lane >> 3, ksl = lane & 7;
    const bf16_t* PROJ = (const bf16_t*)(p.ws + WS_BIG);
    const bf16_t* QKV = (const bf16_t*)(p.ws + WS_SCR);
    bf16_t* OD = (bf16_t*)(p.ws + WS_OFB1) + (size_t)dir * MT * 512;
    float* qs = ldsf; float* ks_ = qs + TC * 128; float* vs = ks_ + TC * 128; float* os = vs + TC * 64; float* egs = os + TC * 64; float* bts = egs + TC;
    const float Aexp = __expf((dir ? p.in[31] : p.in[29])[h]); const float dtb = (dir ? p.in[32] : p.in[30])[h];
    const int i = tid & 127;
    float S[16];
#pragma unroll
    for (int r = 0; r < 16; ++r) S[r] = 0.f;
    for (int c0 = 0; c0 < PB; c0 += TC) {
        __syncthreads();
#pragma unroll
        for (int j = 0; j < 8; ++j) {
            const int t = (tid >> 7) + 4 * j; const size_t R = (size_t)b * PB + seq_pp(c0 + t, dir);
            const bf16_t* row = QKV + R * 1536;
            qs[t * 128 + i] = bf2f(row[h * 128 + i]);
            ks_[t * 128 + i] = bf2f(row[512 + h * 128 + i]);
        }
#pragma unroll
        for (int j = 0; j < 4; ++j) {
            const int t = (tid >> 6) + 8 * j; const size_t R = (size_t)b * PB + seq_pp(c0 + t, dir);
            vs[t * 64 + (tid & 63)] = bf2f(QKV[R * 1536 + 1024 + h * 128 + half * 64 + (tid & 63)]);
        }
        if (tid < TC) {
            const size_t R = (size_t)b * PB + seq_pp(c0 + tid, dir);
            const float a = bf2f(PROJ[R * NIN1 + 1544 + dir * 4 + h]) + dtb;
            const float sp = a > 20.f ? a : __logf(1.f + __expf(a));
            egs[tid] = __expf(-Aexp * sp);
            bts[tid] = sigmoidf_(bf2f(PROJ[R * NIN1 + 1536 + dir * 4 + h]));
        }
        __syncthreads();
        scan_chunk<128, 2>(qs, ks_, nullptr, vs, egs, bts, os, S, w, cl, ksl);
        __syncthreads();
        if (seq_pp(c0, dir) >= CTX) {
            const int t = tid >> 4, c4 = (tid & 15) * 4; const size_t R = (size_t)b * PB + seq_pp(c0 + t, dir);
            uint2 o; o.x = pk2(os[t * 64 + c4], os[t * 64 + c4 + 1]); o.y = pk2(os[t * 64 + c4 + 2], os[t * 64 + c4 + 3]);
            *(uint2*)(OD + R * 512 + h * 128 + half * 64 + c4) = o;
        }
    }
}

__device__ __forceinline__ void ph_delta_T(const P& p, LAS unsigned char* lds, int bid, int nb) {
    const int tid = otid(), lane = tid & 63, w = __builtin_amdgcn_readfirstlane(tid >> 6), r16 = lane & 15, q4 = lane >> 4;
    LAS unsigned char* wl = lds + w * 17920;
    LAS float* GA = (LAS float*)(wl + 17408); LAS float* BE = GA + 64;
    LAS float* Af = (LAS float*)wl;
    const bf16_t* PROJ = (const bf16_t*)(p.ws + WS_BIG);
    const bf16_t* QKV = (const bf16_t*)(p.ws + WS_SCR);
    bf16_t* TM = (bf16_t*)(p.ws + WS_TM);
    __syncthreads();
    for (int u = bid * 8 + w; u < 8448; u += nb * 8) {
        const int n = u % 132, hh = (u / 132) & 3, b = (u / 528) & 7, dir = u / 4224;
        const size_t R = (size_t)b * PB + seq_pp(n * 64 + lane, dir);
        const float Aexp = __expf((dir ? p.in[31] : p.in[29])[hh]), dtb = (dir ? p.in[32] : p.in[30])[hh];
        const float a = bf2f(PROJ[R * NIN1 + 1544 + dir * 4 + hh]) + dtb;
        const float sp = a > 20.f ? a : __logf(1.f + __expf(a));
        float gam = -Aexp * sp;
        const float beta = sigmoidf_(bf2f(PROJ[R * NIN1 + 1536 + dir * 4 + hh]));
#pragma unroll
        for (int o = 1; o < 64; o <<= 1) { const float t = __shfl_up(gam, o); if (lane >= o) gam += t; }
        GA[lane] = gam; BE[lane] = beta;
        { float* GB = (float*)(p.ws + WS_WIN0) + (size_t)u * 128; GB[lane] = gam; GB[64 + lane] = beta; }
        {
#pragma unroll
          for (int j = 0; j < 16; ++j) { const int row = 4 * j + (lane >> 4); const size_t Rr = (size_t)b * PB + seq_pp(n * 64 + row, dir);
              const uint4 v = *(const uint4*)(QKV + Rr * 1536 + 512 + hh * 128 + (lane & 15) * 8); *(LAS u32x4*)(wl + row * 272 + (lane & 15) * 16) = (u32x4){v.x, v.y, v.z, v.w}; } }
        WAVE_FENCE();
        f32x4 at[10];
        { int ix = 0;
#pragma unroll
          for (int tt = 0; tt < 4; ++tt)
#pragma unroll
            for (int st = 0; st <= tt; ++st) { at[ix] = mma_tile<4>(wl, 272, tt * 16, wl, 272, st * 16, (f32x4){0.f, 0.f, 0.f, 0.f}, lane); ++ix; } }
        float gsig[4], gtau[4][4], btau[4][4];
#pragma unroll
        for (int st = 0; st < 4; ++st) gsig[st] = GA[st * 16 + r16];
#pragma unroll
        for (int tt = 0; tt < 4; ++tt) { const f32x4 g4 = *(const LAS f32x4*)(GA + tt * 16 + 4 * q4), b4 = *(const LAS f32x4*)(BE + tt * 16 + 4 * q4);
#pragma unroll
            for (int e = 0; e < 4; ++e) { gtau[tt][e] = g4[e]; btau[tt][e] = b4[e]; } }
        WAVE_FENCE();
        LAS float* AD = (LAS float*)wl;
        LAS unsigned char* AO = wl + 4096;
        LAS unsigned char* TT = wl + 8704;
        LAS float* YS = (LAS float*)(wl + 13312);
        { int ix = 0;
#pragma unroll
          for (int tt = 0; tt < 4; ++tt)
#pragma unroll
            for (int st = 0; st <= tt; ++st) {
#pragma unroll
                for (int e = 0; e < 4; ++e) { const int tau = tt * 16 + 4 * q4 + e, sg = st * 16 + r16;
                    const float val = (sg < tau) ? btau[tt][e] * __expf(gtau[tt][e] - gsig[st]) * at[ix][e] : 0.f;
                    if (st == tt) AD[tau * 16 + r16] = val; else *(LAS bf16_t*)(AO + (tau - 16) * 96 + sg * 2) = f2bf(val); }
                ++ix; } }
        WAVE_FENCE();
        float T[64];
#pragma unroll
        for (int i = 0; i < 4; ++i) {
            float y[16];
#pragma unroll
            for (int r = 0; r < 16; ++r) y[r] = 0.f;
            if (i > 0) {
#pragma unroll
                for (int ct = 0; ct < i; ++ct) {
                    f32x4 d = (f32x4){0.f, 0.f, 0.f, 0.f};
                    const LAS unsigned char* ap = AO + ((i - 1) * 16 + r16) * 96; const LAS unsigned char* bp = TT + (ct * 16 + r16) * 96;
                    const bf16x8 z8 = {0, 0, 0, 0, 0, 0, 0, 0};
                    if (i >= 2) d = __builtin_amdgcn_mfma_f32_16x16x32_bf16(*(const LAS bf16x8*)(ap + q4 * 16), *(const LAS bf16x8*)(bp + q4 * 16), d, 0, 0, 0);
                    if (i == 1 || i == 3) {
                        const int ko = (i == 3) ? 64 : 0;
                        bf16x8 av = *(const LAS bf16x8*)(ap + ko + q4 * 16), bv = *(const LAS bf16x8*)(bp + ko + q4 * 16);
                        if (q4 >= 2) { av = z8; bv = z8; }
                        d = __builtin_amdgcn_mfma_f32_16x16x32_bf16(av, bv, d, 0, 0, 0);
                    }
#pragma unroll
                    for (int e = 0; e < 4; ++e) YS[(4 * q4 + e) * 52 + ct * 16 + r16] = d[e];
                }
                WAVE_FENCE();
                if (lane < 16 * i) {
#pragma unroll
                    for (int r = 0; r < 16; ++r) y[r] = YS[r * 52 + lane];
                }
            }
#pragma unroll
            for (int r = 0; r < 16; ++r) {
                float acc = ((i * 16 + r == lane) ? 1.f : 0.f) - y[r];
#pragma unroll
                for (int k4 = 0; k4 * 4 < r; ++k4) {
                    const f32x4 a4 = *(const LAS f32x4*)(AD + (i * 16 + r) * 16 + k4 * 4);
#pragma unroll
                    for (int e = 0; e < 4; ++e) if (k4 * 4 + e < r) acc -= a4[e] * T[i * 16 + k4 * 4 + e];
                }
                T[i * 16 + r] = acc;
            }
            if (i < 3) {
                if (lane < 48) {
                    const u32x4 v0 = {pk2(T[i * 16 + 0], T[i * 16 + 1]), pk2(T[i * 16 + 2], T[i * 16 + 3]), pk2(T[i * 16 + 4], T[i * 16 + 5]), pk2(T[i * 16 + 6], T[i * 16 + 7])};
                    const u32x4 v1 = {pk2(T[i * 16 + 8], T[i * 16 + 9]), pk2(T[i * 16 + 10], T[i * 16 + 11]), pk2(T[i * 16 + 12], T[i * 16 + 13]), pk2(T[i * 16 + 14], T[i * 16 + 15])};
                    *(LAS u32x4*)(TT + lane * 96 + i * 32) = v0; *(LAS u32x4*)(TT + lane * 96 + i * 32 + 16) = v1;
                }
                WAVE_FENCE();
            }
        }
        WAVE_FENCE();
#pragma unroll
        for (int r = 0; r < 64; ++r) *(LAS bf16_t*)(wl + r * 144 + lane * 2) = f2bf(T[r]);
        WAVE_FENCE();
#pragma unroll
        for (int j = 0; j < 8; ++j) { const int row = 8 * j + (lane >> 3), pc = lane & 7;
            const u32x4 v = *(const LAS u32x4*)(wl + row * 144 + pc * 16); *(uint4*)(TM + (size_t)u * 4096 + row * 64 + pc * 8) = make_uint4(v[0], v[1], v[2], v[3]); }
        WAVE_FENCE();
    }
}

__device__ __forceinline__ void scan_delta_chunked(const P& p, int idx, LAS unsigned char* lds) {
    constexpr int C = 64, SQ = 272, S64 = 144;
    constexpr int OFF_KR = 0, OFF_QR = OFF_KR + 64 * SQ, OFF_QG = OFF_QR + 64 * SQ, OFF_NKG = OFF_QG + 64 * SQ, OFF_KLT = OFF_NKG + 64 * SQ,
                  OFF_VBT = OFF_KLT + 128 * S64, OFF_P2 = OFF_VBT + 64 * S64, OFF_VNT = OFF_P2 + 64 * S64, OFF_ST0 = OFF_VNT + 64 * S64, OFF_ST1 = OFF_ST0 + 64 * SQ,
                  OFF_GA = OFF_ST1 + 64 * SQ, OFF_VB = OFF_GA + 256, OFF_END = OFF_VB + 64 * S64;
    static_assert(OFF_END <= LDS_CTL, "delta LDS");
    const int b = idx >> 4, h = (idx >> 2) & 3, dir = (idx >> 1) & 1, half = idx & 1;
    const int tid = otid(), lane = tid & 63, w = __builtin_amdgcn_readfirstlane(tid >> 6), r16 = lane & 15, q4 = lane >> 4;
    const bf16_t* PROJ = (const bf16_t*)(p.ws + WS_BIG);
    const bf16_t* QKV = (const bf16_t*)(p.ws + WS_SCR);
    const bf16_t* TM = (const bf16_t*)(p.ws + WS_TM) + (size_t)(((dir * 8 + b) * 4 + h) * 132) * 4096;
    bf16_t* OD = (bf16_t*)(p.ws + WS_OFB1) + (size_t)dir * MT * 512 + h * 128 + half * 64;
    LAS float* GA = (LAS float*)(lds + OFF_GA);
    const float* GB = (const float*)(p.ws + WS_WIN0) + (size_t)(((dir * 8 + b) * 4 + h) * 132) * 128;
    const int pk = lane & 15, rk_ = 8 * w + (lane >> 4), pv = lane & 7, rv_ = 8 * w + (lane >> 3);
    f32x4 sacc[4];
#pragma unroll
    for (int k = 0; k < 4; ++k) sacc[k] = (f32x4){0.f, 0.f, 0.f, 0.f};
    __syncthreads();
    for (int k = tid; k < 64 * SQ / 4; k += NTHR) ((LAS unsigned*)(lds + OFF_ST0))[k] = 0u;
    int cur = 0;
    uint4 rk0, rk1, rq0, rq1, rvv; float gtok, btok; bf16x8 tn0, tn1;
    uint4 pk0, pk1, pq0, pq1, pvv; float ptok, pbtk; bf16x8 pt0, pt1;
#define DL_LOAD(XK0, XK1, XQ0, XQ1, XVV, XTOK, XBTK, XT0, XT1, n) do { \
        const size_t R0 = (size_t)b * PB + seq_pp((n) * C + rk_, dir), R1 = (size_t)b * PB + seq_pp((n) * C + rk_ + 4, dir), RV = (size_t)b * PB + seq_pp((n) * C + rv_, dir); \
        XQ0 = *(const uint4*)(QKV + R0 * 1536 + h * 128 + pk * 8); XQ1 = *(const uint4*)(QKV + R1 * 1536 + h * 128 + pk * 8); \
        XK0 = *(const uint4*)(QKV + R0 * 1536 + 512 + h * 128 + pk * 8); XK1 = *(const uint4*)(QKV + R1 * 1536 + 512 + h * 128 + pk * 8); \
        XVV = *(const uint4*)(QKV + RV * 1536 + 1024 + h * 128 + half * 64 + pv * 8); \
        { const float* gb = GB + (size_t)(n) * 128; XTOK = gb[lane]; XBTK = gb[64 + lane]; } \
        { const bf16_t* tp = TM + (size_t)(n) * 4096 + ((w >> 1) * 16 + r16) * 64 + q4 * 8; XT0 = *(const bf16x8*)tp; XT1 = *(const bf16x8*)(tp + 32); } } while (0)
    DL_LOAD(rk0, rk1, rq0, rq1, rvv, gtok, btok, tn0, tn1, 0);
    DL_LOAD(pk0, pk1, pq0, pq1, pvv, ptok, pbtk, pt0, pt1, 1);
    for (int n = 0; n < PB / C; ++n) {
        float egl, eltok; unsigned qg[8];
        const bf16x8 tf0 = tn0, tf1 = tn1;
        {
            const float glast = __shfl(gtok, 63);
            const float gk0 = __shfl(gtok, rk_), gk1 = __shfl(gtok, rk_ + 4), bk0 = __shfl(btok, rk_), bk1 = __shfl(btok, rk_ + 4), bvv = __shfl(btok, rv_);
            egl = fexp(glast); eltok = fexp(glast - gtok);
            if (w == 0) GA[lane] = gtok;
            const float eg0 = fexp(gk0), eg1 = fexp(gk1), nb0 = -bk0 * eg0, nb1 = -bk1 * eg1;
            const int o0 = rk_ * SQ + pk * 16, o1 = (rk_ + 4) * SQ + pk * 16;
            *(LAS u32x4*)(lds + OFF_KR + o0) = (u32x4){rk0.x, rk0.y, rk0.z, rk0.w}; *(LAS u32x4*)(lds + OFF_KR + o1) = (u32x4){rk1.x, rk1.y, rk1.z, rk1.w};
            *(LAS u32x4*)(lds + OFF_QR + o0) = (u32x4){rq0.x, rq0.y, rq0.z, rq0.w}; *(LAS u32x4*)(lds + OFF_QR + o1) = (u32x4){rq1.x, rq1.y, rq1.z, rq1.w};
            const unsigned qw[8] = {rq0.x, rq0.y, rq0.z, rq0.w, rq1.x, rq1.y, rq1.z, rq1.w};
            const unsigned kw[8] = {rk0.x, rk0.y, rk0.z, rk0.w, rk1.x, rk1.y, rk1.z, rk1.w};
            unsigned nkg[8];
#pragma unroll
            for (int e = 0; e < 8; ++e) {
                const float eg = e < 4 ? eg0 : eg1, nbg = e < 4 ? nb0 : nb1;
                qg[e] = pk2(bflo(qw[e]) * eg, bfhi(qw[e]) * eg);
                nkg[e] = pk2(bflo(kw[e]) * nbg, bfhi(kw[e]) * nbg);
            }
            *(LAS u32x4*)(lds + OFF_NKG + o0) = (u32x4){nkg[0], nkg[1], nkg[2], nkg[3]}; *(LAS u32x4*)(lds + OFF_NKG + o1) = (u32x4){nkg[4], nkg[5], nkg[6], nkg[7]};
            *(LAS u32x4*)(lds + OFF_VB + rv_ * S64 + pv * 16) = (u32x4){pk2(bflo(rvv.x) * bvv, bfhi(rvv.x) * bvv), pk2(bflo(rvv.y) * bvv, bfhi(rvv.y) * bvv), pk2(bflo(rvv.z) * bvv, bfhi(rvv.z) * bvv), pk2(bflo(rvv.w) * bvv, bfhi(rvv.w) * bvv)};
        }
        LDS_SYNC();
        *(LAS u32x4*)(lds + OFF_QG + rk_ * SQ + pk * 16) = (u32x4){qg[0], qg[1], qg[2], qg[3]}; *(LAS u32x4*)(lds + OFF_QG + (rk_ + 4) * SQ + pk * 16) = (u32x4){qg[4], qg[5], qg[6], qg[7]};
        {
            const u32x4 ka = *(const LAS u32x4*)(lds + OFF_KR + lane * SQ + w * 32), kb = *(const LAS u32x4*)(lds + OFF_KR + lane * SQ + w * 32 + 16);
            const unsigned kw2[8] = {ka[0], ka[1], ka[2], ka[3], kb[0], kb[1], kb[2], kb[3]};
#pragma unroll
            for (int e = 0; e < 8; ++e) { *(LAS bf16_t*)(lds + OFF_KLT + (16 * w + 2 * e) * S64 + lane * 2) = f2bf(bflo(kw2[e]) * eltok); *(LAS bf16_t*)(lds + OFF_KLT + (16 * w + 2 * e + 1) * S64 + lane * 2) = f2bf(bfhi(kw2[e]) * eltok); }
        }
        rk0 = pk0; rk1 = pk1; rq0 = pq0; rq1 = pq1; rvv = pvv; gtok = ptok; btok = pbtk; tn0 = pt0; tn1 = pt1;
        if (n + 2 < PB / C) DL_LOAD(pk0, pk1, pq0, pq1, pvv, ptok, pbtk, pt0, pt1, n + 2);
        const int stc = cur ? OFF_ST1 : OFF_ST0, stn = cur ? OFF_ST0 : OFF_ST1;
#pragma unroll
        for (int k = 0; k < 2; ++k) {
            const int tile = w + 8 * k, st = tile >> 2, tt = tile & 3;
            f32x4 d = (f32x4){0.f, 0.f, 0.f, 0.f};
            if (st <= tt) d = mma_tile<4>(lds + OFF_KR, SQ, st * 16, lds + OFF_QR, SQ, tt * 16, d, lane);
            const int s0 = st * 16 + 4 * q4, t = tt * 16 + r16;
            const float gt = GA[t]; const f32x4 gs = *(const LAS f32x4*)(GA + s0);
            u32x2 o; o.x = pk2(s0 <= t ? d[0] * fexp(gt - gs[0]) : 0.f, s0 + 1 <= t ? d[1] * fexp(gt - gs[1]) : 0.f);
            o.y = pk2(s0 + 2 <= t ? d[2] * fexp(gt - gs[2]) : 0.f, s0 + 3 <= t ? d[3] * fexp(gt - gs[3]) : 0.f);
            *(LAS u32x2*)(lds + OFF_P2 + t * S64 + s0 * 2) = o;
        }
#pragma unroll
        for (int k = 0; k < 2; ++k) {
            const int st = w >> 1, ct = (w & 1) * 2 + k;
            LAS u32x2* zp = (LAS u32x2*)(lds + OFF_VBT + (ct * 16 + r16) * S64 + (st * 16 + 4 * q4) * 2);
            const LAS unsigned char* vbp = lds + OFF_VB + (st * 16 + 4 * q4) * S64 + (ct * 16 + r16) * 2;
            f32x4 d = (f32x4){bf2f(*(const LAS bf16_t*)vbp), bf2f(*(const LAS bf16_t*)(vbp + S64)), bf2f(*(const LAS bf16_t*)(vbp + 2 * S64)), bf2f(*(const LAS bf16_t*)(vbp + 3 * S64))};
            d = mma_tile<4>(lds + OFF_NKG, SQ, st * 16, lds + stc, SQ, ct * 16, d, lane);
            u32x2 o; o.x = pk2(d[0], d[1]); o.y = pk2(d[2], d[3]);
            *zp = o;
        }
        LDS_SYNC();
#pragma unroll
        for (int k = 0; k < 2; ++k) {
            const int tt = w >> 1, ct = (w & 1) * 2 + k;
            const LAS unsigned char* zb = lds + OFF_VBT + (ct * 16 + r16) * S64 + q4 * 16;
            const bf16x8 b0 = *(const LAS bf16x8*)zb, b1 = *(const LAS bf16x8*)(zb + 64);
            f32x4 d = __builtin_amdgcn_mfma_f32_16x16x32_bf16(tf0, b0, (f32x4){0.f, 0.f, 0.f, 0.f}, 0, 0, 0);
            d = __builtin_amdgcn_mfma_f32_16x16x32_bf16(tf1, b1, d, 0, 0, 0);
            u32x2 o; o.x = pk2(d[0], d[1]); o.y = pk2(d[2], d[3]);
            *(LAS u32x2*)(lds + OFF_VNT + (ct * 16 + r16) * S64 + (tt * 16 + 4 * q4) * 2) = o;
        }
        LDS_SYNC();
        {
            const bool lat = seq_pp(n * C, dir) >= CTX;
            uint4 ov;
            {
                const int tt = w >> 1, cA = 32 * (w & 1) + 8 * (r16 >> 2) + (r16 & 3);
#pragma unroll
                for (int k = 0; k < 2; ++k) {
                    f32x4 d = mma_tile_rows<2>(lds + OFF_VNT, S64, cA + 4 * k, lds + OFF_P2, S64, tt * 16, (f32x4){0.f, 0.f, 0.f, 0.f}, lane);
                    d = mma_tile_rows<4>(lds + stc, SQ, cA + 4 * k, lds + OFF_QG, SQ, tt * 16, d, lane);
                    if (k == 0) { ov.x = pk2(d[0], d[1]); ov.y = pk2(d[2], d[3]); } else { ov.z = pk2(d[0], d[1]); ov.w = pk2(d[2], d[3]); }
                }
                if (lat) { const size_t R = (size_t)b * PB + seq_pp(n * C + tt * 16 + r16, dir); *(uint4*)(OD + R * 512 + 32 * (w & 1) + 8 * q4) = ov; }
            }
#pragma unroll
            for (int ct = 0; ct < 4; ++ct) {
                f32x4 a = sacc[ct]; a[0] *= egl; a[1] *= egl; a[2] *= egl; a[3] *= egl;
                a = mma_tile<2>(lds + OFF_KLT, S64, w * 16, lds + OFF_VNT, S64, ct * 16, a, lane);
                sacc[ct] = a;
                u32x2 o; o.x = pk2(a[0], a[1]); o.y = pk2(a[2], a[3]);
                *(LAS u32x2*)(lds + stn + (ct * 16 + r16) * SQ + (w * 16 + 4 * q4) * 2) = o;
            }
        }
        cur ^= 1;
    }
#undef DL_LOAD
}

__device__ __forceinline__ void ph_prep1(const P& p, int bid, int nb) {
    const int lane = otid() & 63, wv = __builtin_amdgcn_readfirstlane(otid() >> 6);
    bf16_t* PROJ = (bf16_t*)(p.ws + WS_BIG);
    bf16_t* QKV = (bf16_t*)(p.ws + WS_SCR);
    const float* cw = p.in[28];
    const int stride = nb * 8;
    const unsigned lane16 = (unsigned)lane * 16u;
#define P1_LOAD(X, R_) do { int b_, pp_; row_decode((R_), b_, pp_); const int lo_ = pp_ < CTX ? 0 : CTX, hi_ = pp_ < CTX ? CTX : PB; \
        _Pragma("unroll") for (int j = 0; j < 5; ++j) { const int q_ = pp_ + j - 2; const bool ok_ = q_ >= lo_ && q_ < hi_; \
            const unsigned char* rowp_ = (const unsigned char*)(PROJ + (size_t)((R_) + j - 2) * NIN1);        \
            _Pragma("unroll") for (int g = 0; g < 3; ++g) { X[g][j] = make_uint4(0u, 0u, 0u, 0u); if (ok_) X[g][j] = *(const uint4*)(rowp_ + g * 1024 + lane16); } } } while (0)
#define P1_ROW(X, R_) do { const int R = (R_); int b, pp; row_decode(R, b, pp); \
        unsigned rq[6];        \
        if (pp >= CTX) { _Pragma("unroll") for (int k = 0; k < 3; ++k) { const int m = lane + 64 * k; if (m < 160) { const bf16_t* q = PROJ + (size_t)R * NIN1 + 2064 + (m >> 4) * 64 + (m & 15) * 2; \
            rq[2 * k] = *(const unsigned*)q; rq[2 * k + 1] = *(const unsigned*)(q + 32); } } } \
        _Pragma("unroll") for (int g = 0; g < 3; ++g) { \
            const int ch = g * 512 + lane * 8; \
            float a[8]; \
            _Pragma("unroll") for (int e = 0; e < 8; ++e) a[e] = 0.f; \
            _Pragma("unroll") for (int j = 0; j < 5; ++j) { \
                const uint4 xv = X[g][j]; \
                const float4 w0 = *(const float4*)(cw + j * 1536 + ch), w1 = *(const float4*)(cw + j * 1536 + ch + 4); \
                a[0] += w0.x * bflo(xv.x); a[1] += w0.y * bfhi(xv.x); a[2] += w0.z * bflo(xv.y); a[3] += w0.w * bfhi(xv.y); \
                a[4] += w1.x * bflo(xv.z); a[5] += w1.y * bfhi(xv.z); a[6] += w1.z * bflo(xv.w); a[7] += w1.w * bfhi(xv.w); } \
            float ss = 0.f; \
            _Pragma("unroll") for (int e = 0; e < 8; ++e) { a[e] = siluf_(a[e]); ss += a[e] * a[e]; } \
            if (g < 2) { \
                ss += __shfl_xor(ss, 1); ss += __shfl_xor(ss, 2); ss += __shfl_xor(ss, 4); ss += __shfl_xor(ss, 8); \
                const float sc = rsqrtf(ss + EPS) * (g == 0 ? 0.08838834764831845f : 1.f); \
                _Pragma("unroll") for (int e = 0; e < 8; ++e) a[e] *= sc; } \
            uint4 o; o.x = pk2(a[0], a[1]); o.y = pk2(a[2], a[3]); o.z = pk2(a[4], a[5]); o.w = pk2(a[6], a[7]); \
            *(uint4*)(QKV + (size_t)R * 1536 + ch) = o; } \
        if (pp >= CTX) { \
            const int t = pp - CTX; const float rowp = (float)(t >> 6), colp = (float)(t & 63); \
            _Pragma("unroll") for (int k = 0; k < 3; ++k) { \
                const int m = lane + 64 * k; \
                if (m < 160) { \
                    const int hd = m >> 4, f2 = (m & 15) * 2; \
                    const float pos = (f2 < 16 ? rowp : colp) * 0.15915494309189535f; \
                    const float rev0 = pos * __builtin_amdgcn_exp2f(-(float)(f2 & 15) * (13.287712379549449f / 16.f)), rev1 = pos * __builtin_amdgcn_exp2f(-(float)((f2 + 1) & 15) * (13.287712379549449f / 16.f)); \
                    const float sn0 = __builtin_amdgcn_sinf(rev0), cs0 = __builtin_amdgcn_cosf(rev0), sn1 = __builtin_amdgcn_sinf(rev1), cs1 = __builtin_amdgcn_cosf(rev1); \
                    bf16_t* q = PROJ + (size_t)R * NIN1 + 2064 + hd * 64 + f2; \
                    const float x1a = bflo(rq[2 * k]), x1b = bfhi(rq[2 * k]), x2a = bflo(rq[2 * k + 1]), x2b = bfhi(rq[2 * k + 1]); \
                    *(unsigned*)q = pk2(x1a * cs0 - x2a * sn0, x1b * cs1 - x2b * sn1); *(unsigned*)(q + 32) = pk2(x2a * cs0 + x1a * sn0, x2b * cs1 + x1b * sn1); } } } } while (0)
    uint4 xa[3][5], xb[3][5];
    int R0 = bid * 8 + wv;
    if (R0 < MT) P1_LOAD(xa, R0);
#pragma nounroll
    for (; R0 < MT; R0 += 2 * stride) {
        const int R1 = R0 + stride, R2 = R0 + 2 * stride;
        if (R1 < MT) P1_LOAD(xb, R1);
        P1_ROW(xa, R0);
        if (R2 < MT) P1_LOAD(xa, R2);
        if (R1 < MT) P1_ROW(xb, R1);
    }
#undef P1_LOAD
#undef P1_ROW
}

__device__ __forceinline__ void attn_unit(const P& p, int u, float* ldsf) {
    const int b = u >> 7, qb = (u >> 1) & 63, kvh = u & 1;
    const int tid = otid(), g = tid >> 7, qi = tid & 127, hq = kvh * 4 + g;
    const int t0 = qb * 128, t = t0 + qi;
    const bf16_t* PROJ = (const bf16_t*)(p.ws + WS_BIG);
    bf16_t* Y = (bf16_t*)(p.ws + WS_H);
    float* Ks = ldsf; float* Vs = ldsf + 128 * 64;
    const size_t Rq = (size_t)b * PB + CTX + t;
    float q[64], acc[64];
    {
        const uint4* qp = (const uint4*)(PROJ + Rq * NIN1 + 2064 + hq * 64);
#pragma unroll
        for (int i = 0; i < 8; ++i) { const uint4 v = qp[i]; q[i * 8 + 0] = bflo(v.x) * 0.125f; q[i * 8 + 1] = bfhi(v.x) * 0.125f; q[i * 8 + 2] = bflo(v.y) * 0.125f; q[i * 8 + 3] = bfhi(v.y) * 0.125f;
            q[i * 8 + 4] = bflo(v.z) * 0.125f; q[i * 8 + 5] = bfhi(v.z) * 0.125f; q[i * 8 + 6] = bflo(v.w) * 0.125f; q[i * 8 + 7] = bfhi(v.w) * 0.125f; }
    }
#pragma unroll
    for (int d = 0; d < 64; ++d) acc[d] = 0.f;
    float mx = p.in[34][hq], l = 1.f;
    for (int kt = 0; kt < 5; ++kt) {
        const int kbase = t0 - 128 + kt * 128;
        if (kt < 3 && (kbase < 0 || kbase >= SEQ)) continue;
        __syncthreads();
        {
            const int key = tid >> 2, d0 = (tid & 3) * 16;
            const size_t Rk = kt < 3 ? ((size_t)b * PB + CTX + kbase + key) : ((size_t)b * PB + (kt - 3) * 128 + key);
            const uint4* kp = (const uint4*)(PROJ + Rk * NIN1 + 2576 + kvh * 64 + d0);
            const uint4* vp = (const uint4*)(PROJ + Rk * NIN1 + 2704 + kvh * 64 + d0);
#pragma unroll
            for (int i = 0; i < 2; ++i) {
                const uint4 kv = kp[i], vv = vp[i];
                float* kd = Ks + key * 64 + d0 + i * 8; float* vd = Vs + key * 64 + d0 + i * 8;
                kd[0] = bflo(kv.x); kd[1] = bfhi(kv.x); kd[2] = bflo(kv.y); kd[3] = bfhi(kv.y); kd[4] = bflo(kv.z); kd[5] = bfhi(kv.z); kd[6] = bflo(kv.w); kd[7] = bfhi(kv.w);
                vd[0] = bflo(vv.x); vd[1] = bfhi(vv.x); vd[2] = bflo(vv.y); vd[3] = bfhi(vv.y); vd[4] = bflo(vv.z); vd[5] = bfhi(vv.z); vd[6] = bflo(vv.w); vd[7] = bfhi(vv.w);
            }
        }
        __syncthreads();
        for (int j = 0; j < 128; ++j) {
            float s = 0.f;
#pragma unroll
            for (int d4 = 0; d4 < 16; ++d4) { const float4 k4 = *(const float4*)(Ks + j * 64 + d4 * 4); s += q[d4 * 4] * k4.x + q[d4 * 4 + 1] * k4.y + q[d4 * 4 + 2] * k4.z + q[d4 * 4 + 3] * k4.w; }
            bool valid = true;
            if (kt < 3) { const int dk_ = kbase + j - t; valid = (dk_ <= 128) && (dk_ >= -128); }
            if (valid && s > mx) {
                const float corr = __expf(mx - s); l *= corr;
#pragma unroll
                for (int d = 0; d < 64; ++d) acc[d] *= corr;
                mx = s;
            }
            const float pr = valid ? __expf(s - mx) : 0.f;
            l += pr;
#pragma unroll
            for (int d4 = 0; d4 < 16; ++d4) { const float4 v4 = *(const float4*)(Vs + j * 64 + d4 * 4); acc[d4 * 4] += pr * v4.x; acc[d4 * 4 + 1] += pr * v4.y; acc[d4 * 4 + 2] += pr * v4.z; acc[d4 * 4 + 3] += pr * v4.w; }
        }
    }
    const float il = 1.f / l;
    uint4* yp = (uint4*)(Y + Rq * D + 512 + hq * 64);
#pragma unroll
    for (int i = 0; i < 8; ++i) { uint4 o; o.x = pk2(acc[i * 8] * il, acc[i * 8 + 1] * il); o.y = pk2(acc[i * 8 + 2] * il, acc[i * 8 + 3] * il); o.z = pk2(acc[i * 8 + 4] * il, acc[i * 8 + 5] * il); o.w = pk2(acc[i * 8 + 6] * il, acc[i * 8 + 7] * il); yp[i] = o; }
}

__device__ __forceinline__ void attn_unit_mfma(const P& p, int u, LAS unsigned char* lds) {
    constexpr int S64 = 144, OFF_K = 0, OFF_VT = 64 * S64, OFF_P = 2 * 64 * S64;
    const int b = u >> 7, qb = (u >> 1) & 63, kvh = u & 1;
    const int tid = otid(), lane = tid & 63, w = __builtin_amdgcn_readfirstlane(tid >> 6), r16 = lane & 15, q4 = lane >> 4;
    const int hq = kvh * 4 + (w >> 1), t0 = qb * 128, tq0 = t0 + (w & 1) * 64;
    const bf16_t* PROJ = (const bf16_t*)(p.ws + WS_BIG);
    bf16_t* Y = (bf16_t*)(p.ws + WS_H);
    LAS unsigned char* Pw = lds + OFF_P + w * (64 * S64);
    bf16x8 qf[4][2];
#pragma unroll
    for (int qt = 0; qt < 4; ++qt)
#pragma unroll
        for (int kb = 0; kb < 2; ++kb) qf[qt][kb] = *(const bf16x8*)(PROJ + ((size_t)b * PB + CTX + tq0 + qt * 16 + r16) * NIN1 + 2064 + hq * 64 + kb * 32 + q4 * 8);
    f32x4 oacc[4][4];
#pragma unroll
    for (int qt = 0; qt < 4; ++qt)
#pragma unroll
        for (int dt = 0; dt < 4; ++dt) oacc[qt][dt] = (f32x4){0.f, 0.f, 0.f, 0.f};
    constexpr float CS = 0.125f * 1.4426950408889634f;
    float m2[4], lp[4];
#pragma unroll
    for (int qt = 0; qt < 4; ++qt) { m2[qt] = p.in[34][hq] * 1.4426950408889634f; lp[qt] = (q4 == 0) ? 1.f : 0.f; }
    for (int kt = 0; kt < 10; ++kt) {
        const bool local = kt < 6; const int kbase = t0 - 128 + kt * 64;
        if (local && (kbase < 0 || kbase >= SEQ)) continue;
        LDS_SYNC();
        {
            const int key = tid >> 3, d8 = (tid & 7) * 8;
            const size_t Rk = local ? ((size_t)b * PB + CTX + kbase + key) : ((size_t)b * PB + (kt - 6) * 64 + key);
            const uint4 kv = *(const uint4*)(PROJ + Rk * NIN1 + 2576 + kvh * 64 + d8), vv = *(const uint4*)(PROJ + Rk * NIN1 + 2704 + kvh * 64 + d8);
            *(LAS u32x4*)(lds + OFF_K + key * S64 + d8 * 2) = (u32x4){kv.x, kv.y, kv.z, kv.w};
            const unsigned vw[4] = {vv.x, vv.y, vv.z, vv.w};
#pragma unroll
            for (int e = 0; e < 4; ++e) { *(LAS bf16_t*)(lds + OFF_VT + (d8 + 2 * e) * S64 + key * 2) = (bf16_t)(vw[e] & 0xffffu); *(LAS bf16_t*)(lds + OFF_VT + (d8 + 2 * e + 1) * S64 + key * 2) = (bf16_t)(vw[e] >> 16); }
        }
        LDS_SYNC();
        if (local && (kbase + 63 < tq0 - 128 || kbase > tq0 + 63 + 128)) continue;
        f32x4 st[4][4];
#pragma unroll
        for (int k16 = 0; k16 < 4; ++k16) {
            const bf16x8 a0 = *(const LAS bf16x8*)(lds + OFF_K + (k16 * 16 + r16) * S64 + q4 * 16), a1 = *(const LAS bf16x8*)(lds + OFF_K + (k16 * 16 + r16) * S64 + 64 + q4 * 16);
#pragma unroll
            for (int qt = 0; qt < 4; ++qt) {
                f32x4 d = __builtin_amdgcn_mfma_f32_16x16x32_bf16(a0, qf[qt][0], (f32x4){0.f, 0.f, 0.f, 0.f}, 0, 0, 0);
                st[k16][qt] = __builtin_amdgcn_mfma_f32_16x16x32_bf16(a1, qf[qt][1], d, 0, 0, 0);
            }
        }
#pragma unroll
        for (int qt = 0; qt < 4; ++qt) {
            float mx = -3.0e38f;
            if (local) {
                const int tq = tq0 + qt * 16 + r16;
#pragma unroll
                for (int k16 = 0; k16 < 4; ++k16)
#pragma unroll
                    for (int e = 0; e < 4; ++e) { const int dk_ = kbase + k16 * 16 + 4 * q4 + e - tq; if (dk_ > 128 || dk_ < -128) st[k16][qt][e] = -3.0e38f; }
            }
#pragma unroll
            for (int k16 = 0; k16 < 4; ++k16) mx = fmaxf(fmaxf(mx, fmaxf(st[k16][qt][0], st[k16][qt][1])), fmaxf(st[k16][qt][2], st[k16][qt][3]));
            mx = fmaxf(mx, __shfl_xor(mx, 16)); mx = fmaxf(mx, __shfl_xor(mx, 32));
            const float mn = fmaxf(m2[qt], mx * CS), corr = __builtin_amdgcn_exp2f(m2[qt] - mn);
            m2[qt] = mn; lp[qt] *= corr;
#pragma unroll
            for (int dt = 0; dt < 4; ++dt) { oacc[qt][dt][0] *= corr; oacc[qt][dt][1] *= corr; oacc[qt][dt][2] *= corr; oacc[qt][dt][3] *= corr; }
            float ls = 0.f;
#pragma unroll
            for (int k16 = 0; k16 < 4; ++k16) {
                const float p0 = __builtin_amdgcn_exp2f(fmaf(st[k16][qt][0], CS, -mn)), p1 = __builtin_amdgcn_exp2f(fmaf(st[k16][qt][1], CS, -mn)), p2 = __builtin_amdgcn_exp2f(fmaf(st[k16][qt][2], CS, -mn)), p3 = __builtin_amdgcn_exp2f(fmaf(st[k16][qt][3], CS, -mn));
                ls += (p0 + p1) + (p2 + p3);
                u32x2 o; o.x = pk2(p0, p1); o.y = pk2(p2, p3);
                *(LAS u32x2*)(Pw + (qt * 16 + r16) * S64 + (k16 * 16 + 4 * q4) * 2) = o;
            }
            lp[qt] += ls;
        }
        WAVE_FENCE();
#pragma unroll
        for (int kb = 0; kb < 2; ++kb) {
            bf16x8 vf[4];
#pragma unroll
            for (int dt = 0; dt < 4; ++dt) vf[dt] = *(const LAS bf16x8*)(lds + OFF_VT + (dt * 16 + r16) * S64 + kb * 64 + q4 * 16);
#pragma unroll
            for (int qt = 0; qt < 4; ++qt) {
                const bf16x8 pf = *(const LAS bf16x8*)(Pw + (qt * 16 + r16) * S64 + kb * 64 + q4 * 16);
#pragma unroll
                for (int dt = 0; dt < 4; ++dt) oacc[qt][dt] = __builtin_amdgcn_mfma_f32_16x16x32_bf16(vf[dt], pf, oacc[qt][dt], 0, 0, 0);
            }
        }
        WAVE_FENCE();
    }
#pragma unroll
    for (int qt = 0; qt < 4; ++qt) {
        float l = lp[qt]; l += __shfl_xor(l, 16); l += __shfl_xor(l, 32);
        const float il = 1.f / l;
        bf16_t* yp = Y + ((size_t)b * PB + CTX + tq0 + qt * 16 + r16) * D + 512 + hq * 64 + 4 * q4;
#pragma unroll
        for (int dt = 0; dt < 4; ++dt) { uint2 o; o.x = pk2(oacc[qt][dt][0] * il, oacc[qt][dt][1] * il); o.y = pk2(oacc[qt][dt][2] * il, oacc[qt][dt][3] * il); *(uint2*)(yp + dt * 16) = o; }
    }
}

__device__ __forceinline__ void ph_combine0(const P& p, int bid, int nb) {
    const int lane = otid() & 63, wv = otid() >> 6;
    const bf16_t* OF = (const bf16_t*)(p.ws + WS_SCR); const bf16_t* OB = OF + (size_t)MT * D;
    const bf16_t* PROJ = (const bf16_t*)(p.ws + WS_BIG);
    bf16_t* Y = (bf16_t*)(p.ws + WS_H);
    const int c0 = lane * 16, type = c0 >> 9, cc = c0 & 511;
    const float* nw = (type ? p.in[14] : p.in[13]) + (cc & 127);
    const int ogc = (type ? 3616 : 1056) + cc;
    for (int R = bid * 8 + wv; R < MT; R += nb * 8) {
        float o[16];
        const uint4* a = (const uint4*)(OF + (size_t)R * D + c0); const uint4* bq = (const uint4*)(OB + (size_t)R * D + c0);
        float ss = 0.f;
#pragma unroll
        for (int i = 0; i < 2; ++i) { const uint4 x = ntldu4(a + i), y = ntldu4(bq + i);
            o[i * 8 + 0] = bflo(x.x) + bflo(y.x); o[i * 8 + 1] = bfhi(x.x) + bfhi(y.x); o[i * 8 + 2] = bflo(x.y) + bflo(y.y); o[i * 8 + 3] = bfhi(x.y) + bfhi(y.y);
            o[i * 8 + 4] = bflo(x.z) + bflo(y.z); o[i * 8 + 5] = bfhi(x.z) + bfhi(y.z); o[i * 8 + 6] = bflo(x.w) + bflo(y.w); o[i * 8 + 7] = bfhi(x.w) + bfhi(y.w); }
#pragma unroll
        for (int e = 0; e < 16; ++e) ss += o[e] * o[e];
        ss += __shfl_xor(ss, 1); ss += __shfl_xor(ss, 2); ss += __shfl_xor(ss, 4);
        const float rs = rsqrtf(ss * (1.f / 128.f) + EPS);
        const uint4* gp = (const uint4*)(PROJ + (size_t)R * NIN0 + ogc);
        unsigned ow[8];
#pragma unroll
        for (int i = 0; i < 2; ++i) { const uint4 gv = ntldu4(gp + i);
            const float g0 = siluf_(bflo(gv.x)), g1 = siluf_(bfhi(gv.x)), g2 = siluf_(bflo(gv.y)), g3 = siluf_(bfhi(gv.y)), g4 = siluf_(bflo(gv.z)), g5 = siluf_(bfhi(gv.z)), g6 = siluf_(bflo(gv.w)), g7 = siluf_(bfhi(gv.w));
            const float4 w0 = *(const float4*)(nw + i * 8), w1 = *(const float4*)(nw + i * 8 + 4);
            ow[i * 4 + 0] = pk2(o[i * 8 + 0] * rs * w0.x * g0, o[i * 8 + 1] * rs * w0.y * g1); ow[i * 4 + 1] = pk2(o[i * 8 + 2] * rs * w0.z * g2, o[i * 8 + 3] * rs * w0.w * g3);
            ow[i * 4 + 2] = pk2(o[i * 8 + 4] * rs * w1.x * g4, o[i * 8 + 5] * rs * w1.y * g5); ow[i * 4 + 3] = pk2(o[i * 8 + 6] * rs * w1.z * g6, o[i * 8 + 7] * rs * w1.w * g7); }
        uint4* yp = (uint4*)(Y + (size_t)R * D + c0);
        yp[0] = make_uint4(ow[0], ow[1], ow[2], ow[3]); yp[1] = make_uint4(ow[4], ow[5], ow[6], ow[7]);
    }
}
__device__ __forceinline__ void ph_combine1(const P& p, int bid, int nb) {
    const int lane = otid() & 63, wv = otid() >> 6;
    const bf16_t* OF = (const bf16_t*)(p.ws + WS_OFB1); const bf16_t* OB = OF + (size_t)MT * 512;
    const bf16_t* PROJ = (const bf16_t*)(p.ws + WS_BIG);
    bf16_t* Y = (bf16_t*)(p.ws + WS_H);
    const int c0 = lane * 8;
    const float* nw = p.in[33] + (c0 & 127);
    for (int rr = bid * 8 + wv; rr < NB * SEQ; rr += nb * 8) {
        const int b = rr >> 13, t = rr & 8191; const size_t R = (size_t)b * PB + CTX + t;
        const uint4 x = ntldu4(OF + R * 512 + c0), y = ntldu4(OB + R * 512 + c0);
        float o[8];
        o[0] = bflo(x.x) + bflo(y.x); o[1] = bfhi(x.x) + bfhi(y.x); o[2] = bflo(x.y) + bflo(y.y); o[3] = bfhi(x.y) + bfhi(y.y);
        o[4] = bflo(x.z) + bflo(y.z); o[5] = bfhi(x.z) + bfhi(y.z); o[6] = bflo(x.w) + bflo(y.w); o[7] = bfhi(x.w) + bfhi(y.w);
        float ss = 0.f;
#pragma unroll
        for (int e = 0; e < 8; ++e) ss += o[e] * o[e];
        ss += __shfl_xor(ss, 1); ss += __shfl_xor(ss, 2); ss += __shfl_xor(ss, 4); ss += __shfl_xor(ss, 8);
        const float rs = rsqrtf(ss * (1.f / 128.f) + EPS);
        const uint4 gv = ntldu4(PROJ + R * NIN1 + 1552 + c0);
        const float4 w0 = *(const float4*)(nw), w1 = *(const float4*)(nw + 4);
        uint4 ov;
        ov.x = pk2(o[0] * rs * w0.x * siluf_(bflo(gv.x)), o[1] * rs * w0.y * siluf_(bfhi(gv.x))); ov.y = pk2(o[2] * rs * w0.z * siluf_(bflo(gv.y)), o[3] * rs * w0.w * siluf_(bfhi(gv.y)));
        ov.z = pk2(o[4] * rs * w1.x * siluf_(bflo(gv.z)), o[5] * rs * w1.y * siluf_(bfhi(gv.z))); ov.w = pk2(o[6] * rs * w1.z * siluf_(bflo(gv.w)), o[7] * rs * w1.w * siluf_(bfhi(gv.w)));
        *(uint4*)(Y + R * D + c0) = ov;
    }
}

__device__ __forceinline__ void ph_route(const P& p, int layer, LAS unsigned char* lds, int bid, int nb) {
    const int tid = otid(), lane = tid & 63, wv = __builtin_amdgcn_readfirstlane(tid >> 6);
    const int c = lane & 15, q = lane >> 4, e = lane & 31, half = lane >> 5;
    const float* MOD = (const float*)(p.ws + WS_MOD);
    const float* nw = (layer ? p.in[35] : p.in[16]);
    const float* rw = (layer ? p.in[36] : p.in[17]); const float* rb = (layer ? p.in[37] : p.in[18]);
    bf16_t* H = (bf16_t*)(p.ws + WS_H);
    int* cnt = (int*)(p.ws + WS_CNT) + layer * 128;
    int* TOK = (int*)(p.ws + WS_TOK); float* GATE = (float*)(p.ws + WS_GATE);
    constexpr int RS = 2064, OFF_LO = 16 * RS, OFF_PART = 32 * RS;
    bf16x8 bh[4][2], bl[4][2];
#pragma unroll
    for (int s = 0; s < 4; ++s)
#pragma unroll
        for (int nt = 0; nt < 2; ++nt) {
            const float* wp = rw + (size_t)(wv * 128 + s * 32 + 8 * q) * 32 + nt * 16 + c;
            unsigned hh[4], ll[4];
#pragma unroll
            for (int j = 0; j < 4; ++j) { const float w0 = wp[(2 * j) * 32], w1 = wp[(2 * j + 1) * 32]; hh[j] = pk2(w0, w1); ll[j] = pk2(w0 - bflo(hh[j]), w1 - bfhi(hh[j])); }
            const u32x4 hv = {hh[0], hh[1], hh[2], hh[3]}, lv = {ll[0], ll[1], ll[2], ll[3]};
            bh[s][nt] = __builtin_bit_cast(bf16x8, hv); bl[s][nt] = __builtin_bit_cast(bf16x8, lv);
        }
    const float rbe = rb[e];
    const int ngroups = layer ? (NB * SEQ / 16) : (MT / 16);
#define RT_ROW(gi_, t_) (layer ? ((((gi_) * 16 + wv * 2 + (t_)) >> 13) * PB + CTX + (((gi_) * 16 + wv * 2 + (t_)) & 8191)) : ((gi_) * 16 + wv * 2 + (t_)))
#define RT_LOAD(gi_) do { _Pragma("unroll") for (int t = 0; t < 2; ++t) { int b_, pp_; row_decode(RT_ROW(gi_, t), b_, pp_); const float* src_ = stream_row(p, 1, b_, pp_); \
        _Pragma("unroll") for (int i = 0; i < 4; ++i) xr[t][i] = ntld4(src_ + i * 256 + lane * 4); } } while (0)
    float4 xr[2][4];
    int gi = bid;
    if (gi < ngroups) RT_LOAD(gi);
    int pgrp = 0, pR = 0, pslot = 0, have = 0; float pwk = 0.f;
    LAS float* part = (LAS float*)(lds + OFF_PART);
#pragma nounroll
    for (; gi < ngroups; gi += nb) {
#pragma unroll
        for (int t = 0; t < 2; ++t) {
            const int R = RT_ROW(gi, t); int b, pp; row_decode(R, b, pp);
            const float* m = MOD + (size_t)(layer * 9 + (pp < CTX ? 8 : b)) * 6144 + 3072;
            float ss = 0.f;
#pragma unroll
            for (int i = 0; i < 4; ++i) ss += xr[t][i].x * xr[t][i].x + xr[t][i].y * xr[t][i].y + xr[t][i].z * xr[t][i].z + xr[t][i].w * xr[t][i].w;
            ss = wave_sum(ss);
            const float rs = rsqrtf(ss * (1.f / 1024.f) + EPS);
#pragma unroll
            for (int i = 0; i < 4; ++i) {
                const float4 w = *(const float4*)(nw + i * 256 + lane * 4), sh = *(const float4*)(m + i * 256 + lane * 4), sc = *(const float4*)(m + 1024 + i * 256 + lane * 4);
                const float v0 = xr[t][i].x * rs * w.x * (1.f + sc.x) + sh.x, v1 = xr[t][i].y * rs * w.y * (1.f + sc.y) + sh.y;
                const float v2 = xr[t][i].z * rs * w.z * (1.f + sc.z) + sh.z, v3 = xr[t][i].w * rs * w.w * (1.f + sc.w) + sh.w;
                const unsigned h0 = pk2(v0, v1), h1 = pk2(v2, v3);
                const unsigned l0 = pk2(v0 - bflo(h0), v1 - bfhi(h0)), l1 = pk2(v2 - bflo(h1), v3 - bfhi(h1));
                uint2 o; o.x = h0; o.y = h1; *(uint2*)(H + (size_t)R * D + i * 256 + lane * 4) = o;
                const u32x2 hv = {h0, h1}, lv = {l0, l1};
                *(LAS u32x2*)(lds + (wv * 2 + t) * RS + (i * 256 + lane * 4) * 2) = hv;
                *(LAS u32x2*)(lds + OFF_LO + (wv * 2 + t) * RS + (i * 256 + lane * 4) * 2) = lv;
            }
        }
        { const int gn = gi + nb; if (gn < ngroups) RT_LOAD(gn); }
        if (have && e < 4) { TOK[(size_t)pgrp * MT + pslot] = pR; GATE[(size_t)pgrp * MT + pslot] = pwk; }
        LDS_SYNC();
        {
            f32x4 a0 = {0.f, 0.f, 0.f, 0.f}, a1 = {0.f, 0.f, 0.f, 0.f};
#pragma unroll
            for (int s = 0; s < 4; ++s) {
                const int off = c * RS + (wv * 128 + s * 32 + 8 * q) * 2;
                const bf16x8 ah = *(const LAS bf16x8*)(lds + off), al = *(const LAS bf16x8*)(lds + OFF_LO + off);
                a0 = __builtin_amdgcn_mfma_f32_16x16x32_bf16(al, bh[s][0], a0, 0, 0, 0); a0 = __builtin_amdgcn_mfma_f32_16x16x32_bf16(ah, bl[s][0], a0, 0, 0, 0); a0 = __builtin_amdgcn_mfma_f32_16x16x32_bf16(ah, bh[s][0], a0, 0, 0, 0);
                a1 = __builtin_amdgcn_mfma_f32_16x16x32_bf16(al, bh[s][1], a1, 0, 0, 0); a1 = __builtin_amdgcn_mfma_f32_16x16x32_bf16(ah, bl[s][1], a1, 0, 0, 0); a1 = __builtin_amdgcn_mfma_f32_16x16x32_bf16(ah, bh[s][1], a1, 0, 0, 0);
            }
#pragma unroll
            for (int r = 0; r < 4; ++r) { part[(wv * 16 + 4 * q + r) * 32 + c] = a0[r]; part[(wv * 16 + 4 * q + r) * 32 + 16 + c] = a1[r]; }
        }
        LDS_SYNC();
        {
            const int tok = wv * 2 + half;
            float lg = rbe;
#pragma unroll
            for (int s = 0; s < 8; ++s) lg += part[(s * 16 + tok) * 32 + e];
            float tv[4]; int ti[4];
#pragma unroll
            for (int k = 0; k < 4; ++k) {
                float bv = lg; int bi = e;
#pragma unroll
                for (int o = 16; o > 0; o >>= 1) { const float ov = __shfl_xor(bv, o); const int oi = __shfl_xor(bi, o); if (ov > bv || (ov == bv && oi < bi)) { bv = ov; bi = oi; } }
                tv[k] = bv; ti[k] = bi;
                if (e == bi) lg = -3.0e38f;
            }
            if (e < 4) {
                const float m0 = tv[0];
                const float e0 = 1.f, e1 = __expf(tv[1] - m0), e2 = __expf(tv[2] - m0), e3 = __expf(tv[3] - m0);
                const float inv = 1.f / (e0 + e1 + e2 + e3);
                pwk = (e == 0 ? e0 : e == 1 ? e1 : e == 2 ? e2 : e3) * inv;
                const int ek = e == 0 ? ti[0] : e == 1 ? ti[1] : e == 2 ? ti[2] : ti[3];
                pgrp = e * NE + ek;
                pslot = atomicAdd(&cnt[pgrp], 1);
                pR = RT_ROW(gi, half);
            }
            have = 1;
        }
    }
    if (have && e < 4) { TOK[(size_t)pgrp * MT + pslot] = pR; GATE[(size_t)pgrp * MT + pslot] = pwk; }
#undef RT_ROW
#undef RT_LOAD
}

constexpr int NG = 4 * NE;
__device__ __forceinline__ void moe_table(const P& p, int layer, LAS int* tab) {
    __syncthreads();
    if (otid() < 64) {
        const int* cnt = (const int*)(p.ws + WS_CNT) + layer * 128;
        const int lane = otid();
        const int c0 = __hip_atomic_load(&cnt[2 * lane], __ATOMIC_RELAXED, __HIP_MEMORY_SCOPE_AGENT), c1 = __hip_atomic_load(&cnt[2 * lane + 1], __ATOMIC_RELAXED, __HIP_MEMORY_SCOPE_AGENT);
        const int t0 = (c0 + 255) >> 8, t1 = (c1 + 255) >> 8;
        int incl = t0 + t1;
#pragma unroll
        for (int o = 1; o < 64; o <<= 1) { const int t = __shfl_up(incl, o); if (lane >= o) incl += t; }
        const int excl = incl - (t0 + t1);
        tab[2 * lane] = excl; tab[2 * lane + 1] = excl + t0; tab[NG + 1 + 2 * lane] = c0; tab[NG + 1 + 2 * lane + 1] = c1;
        if (lane == 63) tab[NG] = incl;
    }
    __syncthreads();
}
__device__ __forceinline__ int moe_find(LAS const int* tab, int rt) { int g = 0;
#pragma unroll 8
    for (int k = 1; k < NG; ++k) if (tab[k] <= rt) g = k;
    return g; }

struct EpiUp {
    static constexpr bool ACT = true;
    __device__ __forceinline__ bool is_full() const { return true; }
    typedef EpiNoPre Pre;
    __device__ __forceinline__ void prefetch(int, int, int, Pre&) const {}
    bf16_t* abuf; const float* bup; int arow0  , pn;
    __device__ __forceinline__ f32x4 act(const f32x4 gl, const f32x4 li, int c) const {
        const int gc = pn * 128 + c;
        const f32x4 bg = *(const f32x4*)(bup + gc), bl = *(const f32x4*)(bup + 1024 + gc);
        f32x4 r;
#pragma unroll
        for (int h2 = 0; h2 < 2; ++h2) {
            f32x2 g = (f32x2){gl[2 * h2], gl[2 * h2 + 1]} + (f32x2){bg[2 * h2], bg[2 * h2 + 1]};
            f32x2 l = (f32x2){li[2 * h2], li[2 * h2 + 1]} + (f32x2){bl[2 * h2], bl[2 * h2 + 1]};
            g[0] = fminf(g[0], 7.f); g[1] = fminf(g[1], 7.f);
            l[0] = __builtin_amdgcn_fmed3f(l[0], -7.f, 7.f); l[1] = __builtin_amdgcn_fmed3f(l[1], -7.f, 7.f);
            const f32x2 t = g * (f32x2){-1.702f * 1.4426950408889634f, -1.702f * 1.4426950408889634f};
            f32x2 e = (f32x2){__builtin_amdgcn_exp2f(t[0]), __builtin_amdgcn_exp2f(t[1])};
            e = e + (f32x2){1.f, 1.f};
            const f32x2 s = g * (f32x2){__builtin_amdgcn_rcpf(e[0]), __builtin_amdgcn_rcpf(e[1])};
            const f32x2 o = __builtin_elementwise_fma(l, s, s);
            r[2 * h2] = o[0]; r[2 * h2 + 1] = o[1];
        }
        return r;
    }
    __device__ __forceinline__ void row(int r, int c8, const u32x4 v) const {
        __builtin_nontemporal_store(v, (u32x4*)(abuf + (size_t)(arow0 + r) * DFF + pn * 128 + c8));
    }
};

__device__ __forceinline__ void ph_moe_up(const P& p, int layer, LAS unsigned char* lds, int bid, int nb) {
    LAS int* tab = (LAS int*)(lds + LDS_CTL + 64);
    moe_table(p, layer, tab);
    const int ntiles = tab[NG];
    const int* TOK = (const int*)(p.ws + WS_TOK);
    const unsigned char* A = p.ws + WS_H;
    for (int it = 0;; ++it) {
        int rtg, pn; if (!unit_map(it, bid, nb, ntiles, 8, rtg, pn)) break;
        const int g = moe_find(tab, rtg), e = g & (NE - 1), rt = rtg - tab[g], c = tab[NG + 1 + g];
        int R0, C0, R1, C1; g8::stage_rc(otid() * 16, R0, C0); g8::stage_rc(otid() * 16 + 8192, R1, C1);
        const int* tk = TOK + (size_t)g * MT + rt * 256;
        const int s00 = R0, s01 = R1, s10 = 128 + R0, s11 = 128 + R1;
        const unsigned t00 = (rt * 256 + s00 < c) ? (unsigned)tk[s00] : 0u, t01 = (rt * 256 + s01 < c) ? (unsigned)tk[s01] : 0u;
        const unsigned t10 = (rt * 256 + s10 < c) ? (unsigned)tk[s10] : 0u, t11 = (rt * 256 + s11 < c) ? (unsigned)tk[s11] : 0u;
        EpiUp E{(bf16_t*)(p.ws + WS_BIG), (layer ? p.in[39] : p.in[20]) + (size_t)e * 2048, rtg * 256, pn};
        gemm_unit(lds, A, t00 * 2048u + C0 * 2u, t01 * 2048u + C1 * 2u, t10 * 2048u + C0 * 2u, t11 * 2048u + C1 * 2u,
                  p.ws + WS_WUP + ((size_t)e * 2048 + pn * 256) * 2048, E);
    }
}

struct PreDown { uint2 x[8]; float4 g[8]; int R[8]; float gate[8]; };
struct EpiDown {
    static constexpr bool ACT = false;
    __device__ __forceinline__ bool is_full() const { return !(ks & 8); }
    typedef PreDown Pre;
    const P* p; int layer, ks; const float* bdn; int col0;
    int tkv; float gatev;
    __device__ __forceinline__ void load8(int ai, int w2, int lane, int i0, Pre& pre) const {
        const bf16_t* Z = (const bf16_t*)(p->ws + WS_H);
#pragma unroll
        for (int i = 0; i < 8; ++i) {
            pre.R[i] = __builtin_amdgcn_readlane(tkv, ai * 16 + i0 + i); pre.gate[i] = __int_as_float(__builtin_amdgcn_readlane(__float_as_int(gatev), ai * 16 + i0 + i));
            const int Rc = pre.R[i] < 0 ? 0 : pre.R[i];
            int b, pp; row_decode(Rc, b, pp);
            pre.g[i] = *(const float4*)((const float*)(p->ws + WS_MOD) + (size_t)(layer * 9 + (pp < CTX ? 8 : b)) * 6144 + 5120 + col0 + lane * 4);
            if ((ks & 7) > 0) pre.x[i] = *(const uint2*)(Z + (size_t)Rc * D + col0 + lane * 4);
        }
    }
    __device__ __forceinline__ void store8(int ai, int w2, int lane, int i0, const LAS float* stg, const Pre& pre, const float4 bb) const {
        bf16_t* Z = (bf16_t*)(p->ws + WS_H);
#pragma unroll
        for (int i = 0; i < 8; ++i) {
            if (pre.R[i] >= 0) {
                const f32x4 a = *(const LAS f32x4*)(stg + (w2 * 16 + i0 + i) * 260 + lane * 4);
                const float4 gg = pre.g[i]; const float gate = pre.gate[i];
                float4 x = make_float4(0.f, 0.f, 0.f, 0.f);
                if ((ks & 7) > 0) { x.x = bflo(pre.x[i].x); x.y = bfhi(pre.x[i].x); x.z = bflo(pre.x[i].y); x.w = bfhi(pre.x[i].y); }
                x.x += gate * gg.x * (a[0] + bb.x); x.y += gate * gg.y * (a[1] + bb.y); x.z += gate * gg.z * (a[2] + bb.z); x.w += gate * gg.w * (a[3] + bb.w);
                uint2 o; o.x = pk2(x.x, x.y); o.y = pk2(x.z, x.w);
                *(uint2*)(Z + (size_t)pre.R[i] * D + col0 + lane * 4) = o;
            }
        }
    }
    __device__ __forceinline__ void prefetch(int ai, int w2, int lane, Pre& pre) const { load8(ai, w2, lane, 0, pre); }
    __device__ __forceinline__ void rows(int ai, int w2, int lane, const LAS float* stg, Pre& pre) const {
        const float4 bb = *(const float4*)(bdn + col0 + lane * 4);
        store8(ai, w2, lane, 0, stg, pre, bb);
        load8(ai, w2, lane, 8, pre);
        store8(ai, w2, lane, 8, stg, pre, bb);
    }
};

__device__ __forceinline__ void ph_moe_down(const P& p, int layer, int ks, LAS unsigned char* lds, int bid, int nb) {
    LAS int* tab = (LAS int*)(lds + LDS_CTL + 64);
    moe_table(p, layer, tab);
    const int tile0 = tab[ks * NE], ntiles = tab[(ks + 1) * NE] - tile0;
    const unsigned char* A = p.ws + WS_BIG;
    const int U = ntiles * 4, rfull = U / nb, urem = U - rfull * nb;
    const bool split = ((nb & 7) == 0) && urem > 0 && urem * 2 <= nb;
#pragma nounroll
    for (int it = 0;; ++it) {
        int rtl, pn, hoff = 0; bool full = true;
        if (split && it == rfull) {
            const int hidx = (bid & 7) * (nb >> 3) + (bid >> 3);
            if (hidx >= 2 * urem) break;
            hoff = hidx & 1; full = false;
            unit_decode(rfull * nb + (hidx >> 1), ntiles, 4, rtl, pn);
        } else if (!unit_map(it, bid, nb, ntiles, 4, rtl, pn)) break;
        const int rtg = tile0 + rtl;
        const int g = moe_find(tab, rtg), e = g & (NE - 1), rt = rtg - tab[g], c = tab[NG + 1 + g];
        unsigned a00, a01, a10, a11; a_offsets_plain((unsigned)rtg * 256u + (unsigned)hoff * 128u, a00, a01, a10, a11);
        int tkv = -1; float gatev = 0.f;
        { const int l2 = otid() & 63, w2 = __builtin_amdgcn_readfirstlane(otid() >> 6);
          const int slot = rt * 256 + (((l2 >> 4) & 1) + hoff) * 128 + w2 * 16 + (l2 & 15);
          if (l2 < 32 && slot < c) { tkv = ((const int*)(p.ws + WS_TOK) + (size_t)g * MT)[slot]; gatev = ((const float*)(p.ws + WS_GATE) + (size_t)g * MT)[slot]; } }
        EpiDown E{&p, layer, ks | (full ? 0 : 8), (layer ? p.in[41] : p.in[22]) + (size_t)e * 1024, pn * 256, tkv, gatev};
        gemm_unit(lds, A, a00, a01, a10, a11, p.ws + WS_WDN + ((size_t)e * 1024 + pn * 256) * 2048, E);
    }
}

__device__ __forceinline__ void ph_final(const P& p, int bid, int nb) {
    const int lane = otid() & 63, wv = otid() >> 6;
    const float* nw = p.in[42];
    for (int r = bid * 8 + wv; r < NB * SEQ; r += nb * 8) {
        float* row = p.out + (size_t)r * D;
        float4 x[4]; float ss = 0.f;
#pragma unroll
        for (int i = 0; i < 4; ++i) { x[i] = ntld4(row + i * 256 + lane * 4);
            const uint2 z = ntldu2((const bf16_t*)(p.ws + WS_H) + ((size_t)(r >> 13) * PB + CTX + (r & 8191)) * D + i * 256 + lane * 4);
            x[i].x += bflo(z.x); x[i].y += bfhi(z.x); x[i].z += bflo(z.y); x[i].w += bfhi(z.y);
            ss += x[i].x * x[i].x + x[i].y * x[i].y + x[i].z * x[i].z + x[i].w * x[i].w; }
        ss = wave_sum(ss);
        const float rs = rsqrtf(ss * (1.f / 1024.f) + EPS);
#pragma unroll
        for (int i = 0; i < 4; ++i) { const float4 w = *(const float4*)(nw + i * 256 + lane * 4); float4 o; o.x = x[i].x * rs * w.x; o.y = x[i].y * rs * w.y; o.z = x[i].z * rs * w.z; o.w = x[i].w * rs * w.w; *(float4*)(row + i * 256 + lane * 4) = o; }
    }
}

constexpr int N_PHASES = 20;

__global__ void __launch_bounds__(NTHR, 2) mk_fwd(P p) {
    extern __shared__ __attribute__((aligned(16))) unsigned char lds_raw[];
    LAS unsigned char* lds = (LAS unsigned char*)lds_raw;
    float* ldsf = (float*)lds_raw;
    const int bid = blockIdx.x, nb = gridDim.x;
    volatile LAS unsigned* xbw = (volatile LAS unsigned*)(lds + LDS_CTL);
    if (threadIdx.x < 16) xbw[threadIdx.x] = 0u;
    __syncthreads();
#if MK_PER_PHASE
    XcdBarrier bar; bar.bar = nullptr; bar.x = 0; bar.st = nullptr;
#define GRID_BAR() do { } while (0)
#else
    XcdBarrier bar = xcd_barrier_post((unsigned*)(p.ws + WS_CTL), xbw);
#define GRID_BAR() xcd_barrier(bar)
#endif
    const int lo = p.ph_lo, hi = p.ph_hi;
#define IN(k) (lo <= (k) && (k) < hi)
#define SEAM(k) do { if (IN((k) + 1)) GRID_BAR(); } while (0)

    if (IN(0)) { { ph0_mod(p, ldsf, bid, nb); ph0_convert(p, ldsf, bid, nb); } SEAM(0); }
    if (IN(1)) { ph_norm1(p, 0, bid, nb); SEAM(1); }
    if (IN(2)) { ph_inproj(p, 0, lds, bid, nb); SEAM(2); }
    if (IN(3)) {
        for (int u = bid; u < 256; u += nb) { if (u < 128) scan_l0_chunked<0>(p, u & 127, lds); else scan_l0_chunked<1>(p, u & 127, lds); } SEAM(3); }
    if (IN(4)) { ph_combine0(p, bid, nb); SEAM(4); }
    if (IN(5)) { ph_outproj(p, 0, lds, bid, nb); ph_convert_moe(p, 0, ldsf, bid, nb, 32); SEAM(5); }
    if (IN(6)) { ph_route(p, 0, lds, bid, nb); SEAM(6); }
    if (IN(7)) { ph_moe_up(p, 0, lds, bid, nb); SEAM(7); }
    if (IN(8)) {
#pragma nounroll
        for (int ks = 0; ks < 4; ++ks) { ph_moe_down(p, 0, ks, lds, bid, nb); if (ks < 3 || IN(9)) GRID_BAR(); }
    }
    if (IN(9)) { ph_norm1(p, 1, bid, nb); SEAM(9); }
    if (IN(10)) { ph_inproj(p, 1, lds, bid, nb); SEAM(10); }
    if (IN(11)) { ph_prep1(p, bid, nb); SEAM(11); }
    if (IN(12)) {
        ph_delta_T(p, lds, bid, nb);
        SEAM(12); }
    if (IN(13)) {
        if (nb >= 256) { if (bid < 128) scan_delta_chunked(p, bid, lds); else for (int u = bid - 128; u < 1024; u += nb - 128) attn_unit_mfma(p, u, lds); }
        else for (int u = bid; u < 128 + 1024; u += nb) { if (u < 128) scan_delta_chunked(p, u, lds); else attn_unit_mfma(p, u - 128, lds); }
        SEAM(13);
    }
    if (IN(14)) { ph_combine1(p, bid, nb); SEAM(14); }
    if (IN(15)) { ph_outproj(p, 1, lds, bid, nb); ph_convert_moe(p, 1, ldsf, bid, nb, 0); SEAM(15); }
    if (IN(16)) { ph_route(p, 1, lds, bid, nb); SEAM(16); }
    if (IN(17)) { ph_moe_up(p, 1, lds, bid, nb); SEAM(17); }
    if (IN(18)) {
#pragma nounroll
        for (int ks = 0; ks < 4; ++ks) { ph_moe_down(p, 1, ks, lds, bid, nb); if (ks < 3 || IN(19)) GRID_BAR(); }
    }
    if (IN(19)) { ph_final(p, bid, nb); }
#undef IN
#undef SEAM
}

extern "C" void kernel_launch(void* const* d_in, const int* in_sizes, int n_in, void* d_out, int out_size, void* d_ws, size_t ws_size, hipStream_t stream) {
    static int grid = 0;
    if (grid == 0) {
        if (n_in != 43 || out_size != NB * SEQ * D || ws_size < WS_END) { fprintf(stderr, "kernel_launch: unexpected problem (n_in %d out %d ws %zu need %zu)\n", n_in, out_size, ws_size, (size_t)WS_END); grid = -1; return; }
        int dev = 0, cus = 0, per_cu = 0;
        if (hipGetDevice(&dev) != hipSuccess || hipDeviceGetAttribute(&cus, hipDeviceAttributeMultiprocessorCount, dev) != hipSuccess) { grid = -1; return; }
        if (hipFuncSetAttribute((const void*)mk_fwd, hipFuncAttributeMaxDynamicSharedMemorySize, LDS_BYTES) != hipSuccess) { fprintf(stderr, "kernel_launch: hipFuncSetAttribute failed\n"); grid = -1; return; }
        if (hipOccupancyMaxActiveBlocksPerMultiprocessor(&per_cu, (const void*)mk_fwd, NTHR, LDS_BYTES) != hipSuccess || per_cu < 1) { fprintf(stderr, "kernel_launch: occupancy query says %d\n", per_cu); }
        (void)hipGetLastError();
        grid = cus;
    }
    if (grid < 0) return;
    (void)hipMemsetAsync(d_ws, 0, WS_ZERO_BYTES, stream);
    P prm;
    memset(&prm, 0, sizeof(prm));
    for (int i = 0; i < 43; ++i) prm.in[i] = (const float*)d_in[i];
    prm.out = (float*)d_out; prm.ws = (unsigned char*)d_ws;
#if MK_PER_PHASE
    for (int ph = 0; ph < N_PHASES; ++ph) { prm.ph_lo = ph; prm.ph_hi = ph + 1; hipLaunchKernelGGL(mk_fwd, dim3(grid), dim3(NTHR), LDS_BYTES, stream, prm); }
#else
    prm.ph_lo = 0; prm.ph_hi = N_PHASES; prm.dupa = PROBE_DUPA; prm.dupb = PROBE_DUPB;
    hipLaunchKernelGGL(mk_fwd, dim3(grid), dim3(NTHR), LDS_BYTES, stream, prm);
#endif
}
```

```cpp
#include <hip/hip_runtime.h>
#include <stdint.h>
#include <stdio.h>
#include <string.h>

#ifndef PROBE_DUPA
#define PROBE_DUPA 0
#endif
#ifndef PROBE_DUPB
#define PROBE_DUPB 0
#endif
#ifndef PROBE_DUP3
#define PROBE_DUP3 0
#endif
#ifndef PROBE_DUP12
#define PROBE_DUP12 0
#endif
#ifndef PROBE_DUP2
#define PROBE_DUP2 0
#endif
#ifndef PROBE_DUP7
#define PROBE_DUP7 0
#endif
#ifndef MK_PER_PHASE
#define MK_PER_PHASE 0
#endif

typedef unsigned short bf16_t;
typedef short bf16x8 __attribute__((ext_vector_type(8)));
typedef short bf16x4 __attribute__((ext_vector_type(4)));
typedef float f32x4 __attribute__((ext_vector_type(4)));
typedef unsigned u32x2 __attribute__((ext_vector_type(2)));
typedef unsigned u32x4 __attribute__((ext_vector_type(4)));
#define LAS __attribute__((address_space(3)))

constexpr int D = 1024, NB = 8, SEQ = 8192, CTX = 256, PB = SEQ + CTX  , MT = NB * PB  ;
constexpr int NIN0 = 4128, NIN0P = 4352, NIN1 = 2832, NIN1P = 3072;
constexpr int NE = 32, DFF = 1024;
constexpr int NTHR = 512;
constexpr float EPS = 1e-6f;
constexpr int LDS_CTL = 161792;
constexpr int LDS_BYTES = LDS_CTL + 2048;

constexpr size_t WS_CTL = 0;
constexpr size_t WS_CNT = 16384;
constexpr size_t WS_MOD = 65536;
constexpr size_t WS_ZERO_BYTES = 524288;
constexpr size_t WS_CTXS = 524288;
constexpr size_t WS_WIN0 = WS_CTXS + 8388608;
constexpr size_t WS_WIN1 = WS_WIN0 + 8912896;
constexpr size_t WS_WOUT = WS_WIN1 + 6291456;
constexpr size_t WS_TOK = WS_WOUT + 4194304;
constexpr size_t WS_GATE = WS_TOK + 34603008;
constexpr size_t WS_H = WS_GATE + 34603008;
constexpr size_t WS_BIG = WS_H + 138412032;
constexpr size_t WS_SCR = WS_BIG + 557973504;
constexpr size_t WS_OFB1 = WS_BIG + 382795776;
constexpr size_t WS_TM = WS_SCR + 207618048;
constexpr size_t WS_WUP = WS_SCR + 75497472;
constexpr size_t WS_WDN = WS_WUP + 134217728;
constexpr size_t WS_END = WS_SCR + 276824064;

#define XB_TMO      128
#define XB_XCNT(j)  (256  + 64 * (j))
#define XB_XSUB(j)  (1280 + 64 * (j))
#define XB_XGEN(j)  (2304 + 64 * (j))
#define XB_TOP      3328
#define XB_TOPGEN   3392
#define XCD_BAR_WORDS 3456
#define XB_SPIN_CAP (1u << 22)

__device__ __forceinline__ unsigned xb_ld(unsigned* p)              { return __hip_atomic_load(p, __ATOMIC_RELAXED, __HIP_MEMORY_SCOPE_AGENT); }
__device__ __forceinline__ unsigned xb_add(unsigned* p, unsigned v) { return __hip_atomic_fetch_add(p, v, __ATOMIC_RELAXED, __HIP_MEMORY_SCOPE_AGENT); }
__device__ __forceinline__ unsigned xb_xcc_id() { return (unsigned)__builtin_amdgcn_s_getreg((3 << 11) | 20) & 0xFu; }
#define XB_SPIN(cond, bar) do { unsigned _sp = 0; while (cond) { __builtin_amdgcn_s_sleep(1); \
    if ((++_sp & 255u) == 0u) { if (xb_ld(&(bar)[XB_TMO])) break; if (_sp > XB_SPIN_CAP) { atomicAdd(&(bar)[XB_TMO], 1u); break; } } } } while (0)

struct XcdBarrier { unsigned* bar; unsigned x; volatile LAS unsigned* st; };

__device__ __forceinline__ XcdBarrier xcd_barrier_post(unsigned* bar, volatile LAS unsigned* st) {
    XcdBarrier b; b.bar = bar; b.x = xb_xcc_id(); b.st = st;
    if (threadIdx.x == 0) (void)xb_add(&bar[XB_XCNT(b.x)], 1u);
    return b;
}
__device__ __forceinline__ void xcd_barrier_complete(unsigned* bar, unsigned x, unsigned& nloc, unsigned& nx) {
    const unsigned G = gridDim.x * gridDim.y * gridDim.z;
    unsigned sum, cnt, mine, sp = 0u;
    for (;;) {
        sum = 0u; cnt = 0u; mine = 0u;
#pragma unroll
        for (unsigned j = 0; j < 16; ++j) { const unsigned c = xb_ld(&bar[XB_XCNT(j)]); sum += c; cnt += (c > 0u) ? 1u : 0u; mine = (j == x) ? c : mine; }
        if (sum == G) break;
        __builtin_amdgcn_s_sleep(1);
        if ((++sp & 255u) == 0u) { if (xb_ld(&bar[XB_TMO])) break; if (sp > XB_SPIN_CAP) { atomicAdd(&bar[XB_TMO], 1u); break; } }
    }
    nloc = mine > 0u ? mine : 1u; nx = cnt > 0u ? cnt : 1u;
}
__device__ __forceinline__ void xcd_barrier(const XcdBarrier& b) {
    asm volatile("s_waitcnt vmcnt(0)" ::: "memory");
    __syncthreads();
    if (threadIdx.x == 0) {
        unsigned* bar = b.bar;
        __builtin_amdgcn_s_waitcnt(0);
        unsigned nloc = b.st[0], nx = b.st[1];
        if (nloc == 0u) { xcd_barrier_complete(bar, b.x, nloc, nx); b.st[0] = nloc; b.st[1] = nx; }
        const unsigned old = xb_add(&bar[XB_XSUB(b.x)], 1u);
        const unsigned gen = old / nloc;
        if (old + 1u == (gen + 1u) * nloc) {
            __builtin_amdgcn_fence(__ATOMIC_RELEASE, "agent");
            asm volatile("s_waitcnt vmcnt(0)" ::: "memory");
            const unsigned og = xb_add(&bar[XB_TOP], 1u);
            const unsigned tg = og / nx;
            if (og + 1u == (tg + 1u) * nx) xb_add(&bar[XB_TOPGEN], 1u);
            else XB_SPIN(xb_ld(&bar[XB_TOPGEN]) == tg, bar);
            __builtin_amdgcn_fence(__ATOMIC_ACQUIRE, "agent");
            xb_add(&bar[XB_XGEN(b.x)], 1u);
            asm volatile("s_waitcnt vmcnt(0)" ::: "memory");
        } else {
            XB_SPIN(xb_ld(&bar[XB_XGEN(b.x)]) == gen, bar);
            __builtin_amdgcn_fence(__ATOMIC_ACQUIRE, "agent");
            asm volatile("s_waitcnt vmcnt(0)" ::: "memory");
        }
    }
    __syncthreads();
}

__device__ __forceinline__ int otid() { int t = threadIdx.x; asm volatile("" : "+v"(t)); return t; }
__device__ __forceinline__ float bf2f(bf16_t v) { return __uint_as_float(((unsigned)v) << 16); }
__device__ __forceinline__ float bflo(unsigned w) { return __uint_as_float(w << 16); }
__device__ __forceinline__ float bfhi(unsigned w) { return __uint_as_float(w & 0xffff0000u); }
typedef __bf16 bf16v2 __attribute__((ext_vector_type(2)));
typedef float f32x2 __attribute__((ext_vector_type(2)));
__device__ __forceinline__ unsigned pk2(float lo, float hi) { const f32x2 v = {lo, hi}; const bf16v2 b = __builtin_convertvector(v, bf16v2); return __builtin_bit_cast(unsigned, b); }
__device__ __forceinline__ bf16_t f2bf(float f) { return (bf16_t)(pk2(f, f) & 0xffffu); }
__device__ __forceinline__ float sigmoidf_(float x) { return __builtin_amdgcn_rcpf(1.f + __expf(-x)); }
__device__ __forceinline__ float siluf_(float x) { return x * __builtin_amdgcn_rcpf(1.f + __expf(-x)); }
__device__ __forceinline__ float dppf(float v, const int ctrl_sel) {
    int r;
    if (ctrl_sel == 0) r = __builtin_amdgcn_update_dpp(0, __float_as_int(v), 0xB1, 0xf, 0xf, false);
    else if (ctrl_sel == 1) r = __builtin_amdgcn_update_dpp(0, __float_as_int(v), 0x4E, 0xf, 0xf, false);
    else r = __builtin_amdgcn_update_dpp(0, __float_as_int(v), 0x141, 0xf, 0xf, false);
    return __int_as_float(r);
}
__device__ __forceinline__ float red8(float v) { v += dppf(v, 0); v += dppf(v, 1); v += dppf(v, 2); return v; }
__device__ __forceinline__ float4 ntld4(const float* p) { const f32x4 v = __builtin_nontemporal_load((const f32x4*)p); return make_float4(v[0], v[1], v[2], v[3]); }
__device__ __forceinline__ uint4 ntldu4(const void* p) { const u32x4 v = __builtin_nontemporal_load((const u32x4*)p); return make_uint4(v[0], v[1], v[2], v[3]); }
__device__ __forceinline__ uint2 ntldu2(const void* p) { const u32x2 v = __builtin_nontemporal_load((const u32x2*)p); return make_uint2(v[0], v[1]); }
__device__ __forceinline__ float wave_sum(float v) {
#pragma unroll
    for (int o = 32; o > 0; o >>= 1) v += __shfl_xor(v, o);
    return v;
}

constexpr float FX_SCALE = 1048576.f, FX_INV = 1.f / 1048576.f;
#define LDS_SYNC() do { asm volatile("s_waitcnt lgkmcnt(0)" ::: "memory"); __builtin_amdgcn_s_barrier(); asm volatile("" ::: "memory"); } while (0)
#define WAVE_FENCE() do { asm volatile("s_waitcnt lgkmcnt(0)" ::: "memory"); __builtin_amdgcn_wave_barrier(); } while (0)
struct P { const float* in[43]; float* out; unsigned char* ws; int ph_lo, ph_hi, dupa, dupb; };

__device__ __forceinline__ void row_decode(int R, int& b, int& pp) { b = R / PB; pp = R - b * PB; }

__device__ __forceinline__ void ph0_mod(const P& p, float* ldsf, int bid, int nb) {
    float* MOD = (float*)(p.ws + WS_MOD);
    const int tid = otid();
    float* sc = ldsf;
    float* red = ldsf + 9 * 1024;
    for (int u = bid; u < 192; u += nb) {
        const int l = u / 96, cb = u % 96;
        const float* W = l ? p.in[23] : p.in[4]; const float* bias = l ? p.in[24] : p.in[5];
        __syncthreads();
        for (int i = tid; i < 9 * 1024; i += NTHR) { const int rr = i >> 10, k = i & 1023; const float v = rr < 8 ? p.in[1][rr * 1024 + k] : p.in[3][k]; sc[i] = siluf_(v); }
        __syncthreads();
        const int cq = tid & 15, ks = tid >> 4;
        const float* wp = W + (size_t)(ks * 32) * 6144 + cb * 64 + cq * 4;
        float4 acc[9];
#pragma unroll
        for (int rr = 0; rr < 9; ++rr) acc[rr] = make_float4(0.f, 0.f, 0.f, 0.f);
#pragma unroll 4
        for (int k4 = 0; k4 < 32; k4 += 4) {
            float4 w[4];
#pragma unroll
            for (int j = 0; j < 4; ++j) w[j] = ntld4(wp + (size_t)(k4 + j) * 6144);
#pragma unroll
            for (int rr = 0; rr < 9; ++rr) {
                const float4 s = *(const float4*)(sc + rr * 1024 + ks * 32 + k4);
                acc[rr].x += s.x * w[0].x + s.y * w[1].x + s.z * w[2].x + s.w * w[3].x; acc[rr].y += s.x * w[0].y + s.y * w[1].y + s.z * w[2].y + s.w * w[3].y;
                acc[rr].z += s.x * w[0].z + s.y * w[1].z + s.z * w[2].z + s.w * w[3].z; acc[rr].w += s.x * w[0].w + s.y * w[1].w + s.z * w[2].w + s.w * w[3].w;
            }
        }
#pragma unroll
        for (int rr = 0; rr < 9; ++rr) *(float4*)(red + (ks * 9 + rr) * 64 + cq * 4) = acc[rr];
        __syncthreads();
        for (int i = tid; i < 9 * 64; i += NTHR) { const int rr = i >> 6, c = i & 63;
            float s = 0.f;
#pragma unroll 8
            for (int k2 = 0; k2 < 32; ++k2) s += red[(k2 * 9 + rr) * 64 + c];
            MOD[(l * 9 + rr) * 6144 + cb * 64 + c] = s + bias[cb * 64 + c]; }
    }
}

template <int MAP>
__device__ __forceinline__ void cvt_tile(const float* __restrict__ src, int ldn, int nmax, int k0, int n0, bf16_t* __restrict__ dst, float* tile) {
    const int tid = otid();
    __syncthreads();
#pragma unroll
    for (int j = 0; j < 2; ++j) {
        const int r = (tid >> 4) + 32 * j, c4 = (tid & 15) * 4;
        float4 v = make_float4(0.f, 0.f, 0.f, 0.f);
        if (n0 + c4 < nmax) v = ntld4(src + (size_t)(k0 + r) * ldn + n0 + c4);
        tile[r * 65 + c4 + 0] = v.x; tile[r * 65 + c4 + 1] = v.y; tile[r * 65 + c4 + 2] = v.z; tile[r * 65 + c4 + 3] = v.w;
    }
    __syncthreads();
    const int n = tid >> 3, k8 = (tid & 7) * 8;
    if (n0 + n < nmax) {
        int nn = n0 + n;
        if (MAP == 1) { const int j = nn & 1023; nn = (j >> 7) * 256 + (nn >= 1024 ? 128 : 0) + (j & 127); }
        uint4 o;
        o.x = pk2(tile[(k8 + 0) * 65 + n], tile[(k8 + 1) * 65 + n]); o.y = pk2(tile[(k8 + 2) * 65 + n], tile[(k8 + 3) * 65 + n]);
        o.z = pk2(tile[(k8 + 4) * 65 + n], tile[(k8 + 5) * 65 + n]); o.w = pk2(tile[(k8 + 6) * 65 + n], tile[(k8 + 7) * 65 + n]);
        *(uint4*)(dst + (size_t)nn * 1024 + k0 + k8) = o;
    }
}

template <int MAP>
__device__ __forceinline__ void cvt_tile_wide(const float* __restrict__ src, int ldn, int k0, int n0, bf16_t* __restrict__ dst, float* tile) {
    const int tid = otid();
    __syncthreads();
    float4 v[8];
#pragma unroll
    for (int j = 0; j < 8; ++j) { const int r = (tid >> 6) + 8 * j, c4 = (tid & 63) * 4; v[j] = ntld4(src + (size_t)(k0 + r) * ldn + n0 + c4); }
#pragma unroll
    for (int j = 0; j < 8; ++j) { const int r = (tid >> 6) + 8 * j, c4 = (tid & 63) * 4; float* t = tile + r * 257 + c4; t[0] = v[j].x; t[1] = v[j].y; t[2] = v[j].z; t[3] = v[j].w; }
    __syncthreads();
#pragma unroll
    for (int j = 0; j < 4; ++j) {
        const int n = (tid >> 3) + 64 * j, k8 = (tid & 7) * 8;
        int nn = n0 + n;
        if (MAP == 1) { const int jj = nn & 1023; nn = (jj >> 7) * 256 + (nn >= 1024 ? 128 : 0) + (jj & 127); }
        uint4 o;
        o.x = pk2(tile[(k8 + 0) * 257 + n], tile[(k8 + 1) * 257 + n]); o.y = pk2(tile[(k8 + 2) * 257 + n], tile[(k8 + 3) * 257 + n]);
        o.z = pk2(tile[(k8 + 4) * 257 + n], tile[(k8 + 5) * 257 + n]); o.w = pk2(tile[(k8 + 6) * 257 + n], tile[(k8 + 7) * 257 + n]);
        *(uint4*)(dst + (size_t)nn * 1024 + k0 + k8) = o;
    }
}

__device__ __forceinline__ void ph0_convert(const P& p, float* ldsf, int bid, int nb) {
    for (int u = bid; u < 2272; u += nb) {
        if (u < 1040) { const int kt = u / 65, nt = u % 65; cvt_tile<0>(p.in[7], NIN0, NIN0, kt * 64, nt * 64, (bf16_t*)(p.ws + WS_WIN0), ldsf); }
        else if (u < 1760) { const int v = u - 1040, kt = v / 45, nt = v % 45; cvt_tile<0>(p.in[26], NIN1, NIN1, kt * 64, nt * 64, (bf16_t*)(p.ws + WS_WIN1), ldsf); }
        else if (u < 2016) { const int v = u - 1760, kt = v / 16, nt = v % 16; cvt_tile<0>(p.in[8], 1024, 1024, kt * 64, nt * 64, (bf16_t*)(p.ws + WS_WOUT), ldsf); }
        else { const int v = u - 2016, kt = v / 16, nt = v % 16; cvt_tile<0>(p.in[27], 1024, 1024, kt * 64, nt * 64, (bf16_t*)(p.ws + WS_WOUT) + 1024 * 1024, ldsf); }
    }
    const uint4 z = make_uint4(0u, 0u, 0u, 0u);
    uint4* z0 = (uint4*)(p.ws + WS_WIN0 + (size_t)NIN0 * 2048); const int n0 = (NIN0P - NIN0) * 2048 / 16;
    uint4* z1 = (uint4*)(p.ws + WS_WIN1 + (size_t)NIN1 * 2048); const int n1 = (NIN1P - NIN1) * 2048 / 16;
    for (int i = bid * NTHR + otid(); i < n0; i += nb * NTHR) z0[i] = z;
    for (int i = bid * NTHR + otid(); i < n1; i += nb * NTHR) z1[i] = z;
}

__device__ __forceinline__ void ph_convert_moe(const P& p, int layer, float* ldsf, int bid, int nb, int shift) {
    const float* wup = (layer ? p.in[38] : p.in[19]); const float* wdn = (layer ? p.in[40] : p.in[21]);
    bf16_t* up_t = (bf16_t*)(p.ws + WS_WUP); bf16_t* dn_t = (bf16_t*)(p.ws + WS_WDN);
    for (int u = (bid + shift) % nb; u < 6144; u += nb) {
        if (u < 4096) { const int e = u >> 7, v = u & 127, kt = v >> 3, nt = v & 7;
            cvt_tile_wide<1>(wup + (size_t)e * 1024 * 2048, 2048, kt * 64, nt * 256, up_t + (size_t)e * 2048 * 1024, ldsf); }
        else { const int w = u - 4096, e = w >> 6, v = w & 63, kt = v >> 2, nt = v & 3;
            cvt_tile_wide<0>(wdn + (size_t)e * 1024 * 1024, 1024, kt * 64, nt * 256, dn_t + (size_t)e * 1024 * 1024, ldsf); }
    }
}

template <int CONV>
__device__ __forceinline__ void norm_mod_row(float* __restrict__ src, const float* __restrict__ nw, const float* __restrict__ shift, const float* __restrict__ scale, int lane, float (&v)[16]) {
    float ss = 0.f;
#pragma unroll
    for (int i = 0; i < 4; ++i) {
        float4 x;
        if (CONV == 1) { const int4 xi = *(const int4*)(src + i * 256 + lane * 4); x.x = (float)xi.x * FX_INV; x.y = (float)xi.y * FX_INV; x.z = (float)xi.z * FX_INV; x.w = (float)xi.w * FX_INV; *(float4*)(src + i * 256 + lane * 4) = x; }
        else x = ntld4(src + i * 256 + lane * 4);
        if (CONV == 2) { int4 xi; xi.x = __float2int_rn(x.x * FX_SCALE); xi.y = __float2int_rn(x.y * FX_SCALE); xi.z = __float2int_rn(x.z * FX_SCALE); xi.w = __float2int_rn(x.w * FX_SCALE); *(int4*)(src + i * 256 + lane * 4) = xi; }
        v[i * 4 + 0] = x.x; v[i * 4 + 1] = x.y; v[i * 4 + 2] = x.z; v[i * 4 + 3] = x.w; ss += x.x * x.x + x.y * x.y + x.z * x.z + x.w * x.w; }
    ss = wave_sum(ss);
    const float rs = rsqrtf(ss * (1.f / 1024.f) + EPS);
#pragma unroll
    for (int i = 0; i < 4; ++i) {
        const float4 w = *(const float4*)(nw + i * 256 + lane * 4), sh = *(const float4*)(shift + i * 256 + lane * 4), sc = *(const float4*)(scale + i * 256 + lane * 4);
        v[i * 4 + 0] = v[i * 4 + 0] * rs * w.x * (1.f + sc.x) + sh.x; v[i * 4 + 1] = v[i * 4 + 1] * rs * w.y * (1.f + sc.y) + sh.y;
        v[i * 4 + 2] = v[i * 4 + 2] * rs * w.z * (1.f + sc.z) + sh.z; v[i * 4 + 3] = v[i * 4 + 3] * rs * w.w * (1.f + sc.w) + sh.w;
    }
}
__device__ __forceinline__ float* stream_row(const P& p, int layer_src  , int b, int pp) {
    if (pp < CTX) return (layer_src ? (float*)(p.ws + WS_CTXS) : (float*)p.in[2]) + (size_t)(b * CTX + pp) * D;
    return (layer_src ? p.out : (float*)p.in[0]) + (size_t)(b * SEQ + pp - CTX) * D;
}

__device__ __forceinline__ void ph_norm1(const P& p, int layer, int bid, int nb) {
    const int lane = otid() & 63, wv = otid() >> 6;
    const float* MOD = (const float*)(p.ws + WS_MOD);
    const float* nw = layer ? p.in[25] : p.in[6];
    bf16_t* H = (bf16_t*)(p.ws + WS_H);
    for (int R = bid * 8 + wv; R < MT; R += nb * 8) {
        int b, pp; row_decode(R, b, pp);
        float* src = stream_row(p, layer, b, pp);
        const float* m = MOD + (size_t)(layer * 9 + (pp < CTX ? 8 : b)) * 6144;
        float v[16];
        if (layer) {
            float ss = 0.f;
#pragma unroll
            for (int i = 0; i < 4; ++i) {
                float4 x = ntld4(src + i * 256 + lane * 4); const uint2 z = ntldu2(H + (size_t)R * D + i * 256 + lane * 4);
                x.x += bflo(z.x); x.y += bfhi(z.x); x.z += bflo(z.y); x.w += bfhi(z.y);
                if (pp >= CTX) *(float4*)(src + i * 256 + lane * 4) = x;
                v[i * 4 + 0] = x.x; v[i * 4 + 1] = x.y; v[i * 4 + 2] = x.z; v[i * 4 + 3] = x.w; ss += x.x * x.x + x.y * x.y + x.z * x.z + x.w * x.w;
            }
            ss = wave_sum(ss);
            const float rs = rsqrtf(ss * (1.f / 1024.f) + EPS);
#pragma unroll
            for (int i = 0; i < 4; ++i) {
                const float4 w = *(const float4*)(nw + i * 256 + lane * 4), sh = *(const float4*)(m + i * 256 + lane * 4), sc = *(const float4*)(m + 1024 + i * 256 + lane * 4);
                v[i * 4 + 0] = v[i * 4 + 0] * rs * w.x * (1.f + sc.x) + sh.x; v[i * 4 + 1] = v[i * 4 + 1] * rs * w.y * (1.f + sc.y) + sh.y;
                v[i * 4 + 2] = v[i * 4 + 2] * rs * w.z * (1.f + sc.z) + sh.z; v[i * 4 + 3] = v[i * 4 + 3] * rs * w.w * (1.f + sc.w) + sh.w;
            }
        } else norm_mod_row<0>(src, nw, m, m + 1024, lane, v);
#pragma unroll
        for (int i = 0; i < 4; ++i) { uint2 o; o.x = pk2(v[i * 4], v[i * 4 + 1]); o.y = pk2(v[i * 4 + 2], v[i * 4 + 3]); *(uint2*)(H + (size_t)R * D + i * 256 + lane * 4) = o; }
    }
}

namespace g8 {
constexpr int BK = 64, HALF = 128, HTB = HALF * BK * 2;
constexpr int STAGE_BYTES = 8 * HTB;
__device__ __forceinline__ int lds_byte(int r, int c) { const int st = (r >> 4) * 2 + (c >> 5), rr = r & 15, cc = c & 31, ob = rr * 64 + cc * 2; return st * 1024 + (ob ^ (((ob >> 9) & 1) << 5)); }
__device__ __forceinline__ void stage_rc(int b, int& R, int& C) { const int st = b / 1024, sb = b % 1024, swz = sb ^ (((sb >> 9) & 1) << 5); R = (st >> 1) * 16 + swz / 64; C = (st & 1) * 32 + (swz % 64) / 2; }
}

template <class Epi>
__device__ __forceinline__ void gemm_unit(LAS unsigned char* lds, const unsigned char* __restrict__ Abase, unsigned a00, unsigned a01, unsigned a10, unsigned a11,
                                          const unsigned char* __restrict__ Btile, const Epi& epi) {
    using namespace g8;
    const int tid = otid(), wid = __builtin_amdgcn_readfirstlane(tid >> 6), lane = tid & 63;
    int wr = wid >> 2, wc = wid & 3, fr = lane & 15, fq = lane >> 4;
    unsigned vb0, vb1;
    { int R, C; stage_rc(tid * 16, R, C); vb0 = (unsigned)(R * 1024 + C) * 2u; stage_rc(tid * 16 + 8192, R, C); vb1 = (unsigned)(R * 1024 + C) * 2u; }
    const unsigned ldsw = (unsigned)wid * 1024u;
    const int aoff = lds_byte(wr * 64 + fr, fq * 8), boff = lds_byte(wc * 32 + fr, fq * 8);
    constexpr unsigned hstepB = HALF * 1024 * 2;
#define G_SA(b, h) (((b) * 2 + (h)) * HTB)
#define G_SB(b, h) ((4 + (b) * 2 + (h)) * HTB)
#define G_GL(gp, lo) __builtin_amdgcn_global_load_lds((const unsigned*)(gp), (LAS unsigned*)(lds + (lo)), 16, 0, 0)
#define G_STA(bufoff, h, kt) do { const unsigned char* _ub = Abase + (size_t)((kt) * 128); G_GL(_ub + ((h) ? a10 : a00), (bufoff) + ldsw); G_GL(_ub + ((h) ? a11 : a01), (bufoff) + ldsw + 8192); } while (0)
#define G_STB(bufoff, h, kt) do { const unsigned char* _ub = Btile + (size_t)((h) * hstepB + (kt) * 128); G_GL(_ub + vb0, (bufoff) + ldsw); G_GL(_ub + vb1, (bufoff) + ldsw + 8192); } while (0)
#define G_LDA(dst, b, h) do { _Pragma("unroll") for (int m = 0; m < 4; ++m) _Pragma("unroll") for (int k = 0; k < 2; ++k) dst[m][k] = *(const LAS bf16x8*)(lds + G_SA(b, h) + aoff + m * 2048 + k * 1024); } while (0)
#define G_LDB(dst, b, h) do { _Pragma("unroll") for (int n = 0; n < 2; ++n) _Pragma("unroll") for (int k = 0; k < 2; ++k) dst[n][k] = *(const LAS bf16x8*)(lds + G_SB(b, h) + boff + n * 2048 + k * 1024); } while (0)
#define G_MMA(ai, bj, At_, Bt_) do { __builtin_amdgcn_s_setprio(1); _Pragma("unroll") for (int m = 0; m < 4; ++m) _Pragma("unroll") for (int n = 0; n < 2; ++n) _Pragma("unroll") for (int k = 0; k < 2; ++k) \
        acc[ai][bj][m][n] = __builtin_amdgcn_mfma_f32_16x16x32_bf16(Bt_[n][k], At_[m][k], acc[ai][bj][m][n], 0, 0, 0); __builtin_amdgcn_s_setprio(0); } while (0)
#define G_WV(n) asm volatile("s_waitcnt vmcnt(" #n ")" ::: "memory")
#define G_WL(n) asm volatile("s_waitcnt lgkmcnt(" #n ")" ::: "memory")
#define G_BAR __builtin_amdgcn_s_barrier()
#define G_SCHED __builtin_amdgcn_sched_barrier(0)
    f32x4 acc[2][2][4][2];
#pragma unroll
    for (int a = 0; a < 2; ++a)
#pragma unroll
        for (int b = 0; b < 2; ++b)
#pragma unroll
            for (int m = 0; m < 4; ++m)
#pragma unroll
                for (int n = 0; n < 2; ++n) acc[a][b][m][n] = (f32x4){0.f, 0.f, 0.f, 0.f};
    bf16x8 At[4][2], B0[2][2], B1[2][2];
    constexpr int nt = 1024 / BK;
    G_STB(G_SB(0, 0), 0, 0); G_STA(G_SA(0, 0), 0, 0); G_STB(G_SB(0, 1), 1, 0); G_STA(G_SA(0, 1), 1, 0);
    if (wr == 1) G_BAR;
    G_WV(4); G_BAR;
    G_STB(G_SB(1, 0), 0, 1); G_STA(G_SA(1, 0), 0, 1); G_STB(G_SB(1, 1), 1, 1);
    G_WV(6); G_BAR;
    for (int t = 0; t < nt - 2; t += 2) {
        G_LDB(B0, 0, 0); G_SCHED; G_LDA(At, 0, 0); G_STA(G_SA(1, 1), 1, t + 1);
        G_WL(8); G_BAR; G_WL(0); G_MMA(0, 0, At, B0); G_BAR; G_SCHED;
        G_LDB(B1, 0, 1); G_STB(G_SB(0, 0), 0, t + 2);
        G_BAR; G_WL(0); G_MMA(0, 1, At, B1); G_BAR;
        G_LDA(At, 0, 1); G_STA(G_SA(0, 0), 0, t + 2);
        G_BAR; G_WL(0); if (epi.is_full()) G_MMA(1, 0, At, B0); G_BAR; G_SCHED;
        G_STB(G_SB(0, 1), 1, t + 2);
        G_WV(6); G_BAR; if (epi.is_full()) G_MMA(1, 1, At, B1); G_BAR;
        G_LDB(B0, 1, 0); G_SCHED; G_LDA(At, 1, 0); G_STA(G_SA(0, 1), 1, t + 2);
        G_WL(8); G_BAR; G_WL(0); G_MMA(0, 0, At, B0); G_BAR; G_SCHED;
        G_LDB(B1, 1, 1); G_STB(G_SB(1, 0), 0, t + 3);
        G_BAR; G_WL(0); G_MMA(0, 1, At, B1); G_BAR;
        G_LDA(At, 1, 1); G_STA(G_SA(1, 0), 0, t + 3);
        G_BAR; G_WL(0); if (epi.is_full()) G_MMA(1, 0, At, B0); G_BAR; G_SCHED;
        G_STB(G_SB(1, 1), 1, t + 3);
        G_WV(6); G_BAR; if (epi.is_full()) G_MMA(1, 1, At, B1); G_BAR;
    }
    { G_LDB(B0, 0, 0); G_WV(0); G_LDA(At, 0, 0); G_STA(G_SA(1, 1), 1, nt - 1);
      G_BAR; G_WL(0); G_MMA(0, 0, At, B0); G_BAR;
      G_LDB(B1, 0, 1); G_BAR; G_WL(0); G_MMA(0, 1, At, B1); G_BAR;
      G_LDA(At, 0, 1); G_WV(4); G_BAR; G_WL(0); if (epi.is_full()) G_MMA(1, 0, At, B0); if (epi.is_full()) G_MMA(1, 1, At, B1); G_BAR; }
    { G_LDB(B0, 1, 0); G_LDA(At, 1, 0); G_WV(2); G_BAR; G_WL(0); G_MMA(0, 0, At, B0); G_BAR;
      G_LDB(B1, 1, 1); G_WV(0); G_BAR; G_WL(0); G_MMA(0, 1, At, B1); G_BAR;
      G_LDA(At, 1, 1); G_BAR; G_WL(0); if (epi.is_full()) G_MMA(1, 0, At, B0); if (epi.is_full()) G_MMA(1, 1, At, B1); G_BAR; }
    if (wr == 0) G_BAR;
    int tz = otid(); asm volatile("" : "+v"(tz));
    const int w2 = __builtin_amdgcn_readfirstlane(tz >> 6), l2 = tz & 63; wr = w2 >> 2; wc = w2 & 3; fr = l2 & 15; fq = l2 >> 4;
    LAS float* stg = (LAS float*)lds;
    if constexpr (Epi::ACT) {
#pragma unroll
        for (int ai = 0; ai < 2; ++ai)
#pragma unroll
            for (int m = 0; m < 4; ++m)
#pragma unroll
                for (int n = 0; n < 2; ++n) {
                    const f32x4 r = epi.act(acc[ai][0][m][n], acc[ai][1][m][n], wc * 32 + n * 16 + fq * 4);
                    u32x2 o; o.x = pk2(r[0], r[1]); o.y = pk2(r[2], r[3]);
                    *(LAS u32x2*)(lds + (ai * 128 + wr * 64 + m * 16 + fr) * 272 + (wc * 32 + n * 16 + fq * 4) * 2) = o;
                }
        LDS_SYNC();
#pragma unroll 2
        for (int i = 0; i < 8; ++i) { const int r = w2 * 32 + i * 4 + (l2 >> 4), c8 = (l2 & 15) * 8; epi.row(r, c8, *(const LAS u32x4*)(lds + r * 272 + c8 * 2)); }
        LDS_SYNC();
    } else {
#pragma unroll
    for (int ai = 0; ai < 2; ++ai) {
        if (ai == 1 && !epi.is_full()) break;
        typename Epi::Pre pre; epi.prefetch(ai, w2, l2, pre);
#pragma unroll
        for (int bj = 0; bj < 2; ++bj)
#pragma unroll
            for (int m = 0; m < 4; ++m)
#pragma unroll
                for (int n = 0; n < 2; ++n)
                    *(LAS f32x4*)(stg + (wr * 64 + m * 16 + fr) * 260 + bj * 128 + wc * 32 + n * 16 + fq * 4) = acc[ai][bj][m][n];
        LDS_SYNC();
        epi.rows(ai, w2, l2, stg, pre);
        LDS_SYNC();
    }
    }
#undef G_SA
#undef G_SB
#undef G_GL
#undef G_STA
#undef G_STB
#undef G_LDA
#undef G_LDB
#undef G_MMA
#undef G_WV
#undef G_WL
#undef G_BAR
#undef G_SCHED
}

__device__ __forceinline__ int perm32(int rho) { const int n = rho >> 4, i = rho & 15; return 8 * (i >> 2) + 4 * n + (i & 3); }
template <class Sched, class Epi>
__device__ __forceinline__ void gemm_stream(LAS unsigned char* lds, const unsigned char* __restrict__ Abase, Sched& S, const Epi& E) {
    using namespace g8;
    typedef typename Sched::UnitT UnitT;
    const int tid = otid(), wid = __builtin_amdgcn_readfirstlane(tid >> 6), lane = tid & 63;
    int wr = wid >> 2, wc = wid & 3, fr = lane & 15, fq = lane >> 4;
    unsigned vb0, vb1;
    { int R, C; stage_rc(tid * 16, R, C); const int Rb0 = Epi::PERM ? ((R & ~31) + perm32(R & 31)) : R; vb0 = (unsigned)(Rb0 * 1024 + C) * 2u;
      stage_rc(tid * 16 + 8192, R, C); const int Rb1 = Epi::PERM ? ((R & ~31) + perm32(R & 31)) : R; vb1 = (unsigned)(Rb1 * 1024 + C) * 2u; }
    const unsigned ldsw = (unsigned)wid * 1024u;
    const int aoff = lds_byte(wr * 64 + fr, fq * 8), boff = lds_byte(wc * 32 + fr, fq * 8);
    constexpr unsigned hstepB = HALF * 1024 * 2;
#define S_SA(b, h) (((b) * 2 + (h)) * HTB)
#define S_SB(b, h) ((4 + (b) * 2 + (h)) * HTB)
#define S_GL(gp, lo) __builtin_amdgcn_global_load_lds((const unsigned*)(gp), (LAS unsigned*)(lds + (lo)), 16, 0, 0)
#define S_STA(bufoff, U, h, kt) do { const unsigned char* _ub = Abase + (size_t)((kt) * 128); S_GL(_ub + (U).a[h][0], (bufoff) + ldsw); S_GL(_ub + (U).a[h][1], (bufoff) + ldsw + 8192); } while (0)
#define S_STB(bufoff, U, h, kt) do { const unsigned char* _ub = (U).Bt + (size_t)((h) * hstepB + (kt) * 128); S_GL(_ub + vb0, (bufoff) + ldsw); S_GL(_ub + vb1, (bufoff) + ldsw + 8192); } while (0)
#define S_LDA(dst, b, h) do { _Pragma("unroll") for (int m = 0; m < 4; ++m) _Pragma("unroll") for (int k = 0; k < 2; ++k) dst[m][k] = *(const LAS bf16x8*)(lds + S_SA(b, h) + aoff + m * 2048 + k * 1024); } while (0)
#define S_LDB(dst, b, h) do { _Pragma("unroll") for (int n = 0; n < 2; ++n) _Pragma("unroll") for (int k = 0; k < 2; ++k) dst[n][k] = *(const LAS bf16x8*)(lds + S_SB(b, h) + boff + n * 2048 + k * 1024); } while (0)
#define S_MMA(ai, bj, At_, Bt_) do { __builtin_amdgcn_s_setprio(1); _Pragma("unroll") for (int m = 0; m < 4; ++m) _Pragma("unroll") for (int n = 0; n < 2; ++n) _Pragma("unroll") for (int k = 0; k < 2; ++k) \
        acc[ai][bj][m][n] = __builtin_amdgcn_mfma_f32_16x16x32_bf16(Bt_[n][k], At_[m][k], acc[ai][bj][m][n], 0, 0, 0); __builtin_amdgcn_s_setprio(0); } while (0)
#define S_WV(n) asm volatile("s_waitcnt vmcnt(" #n ")" ::: "memory")
#define S_WL(n) asm volatile("s_waitcnt lgkmcnt(" #n ")" ::: "memory")
#define S_BAR __builtin_amdgcn_s_barrier()
#define S_SCHED __builtin_amdgcn_sched_barrier(0)
    UnitT cur, nxt; int ui = 0;
    if (!S.next(0, cur)) return;
    f32x4 acc[2][2][4][2];
#pragma unroll
    for (int a = 0; a < 2; ++a)
#pragma unroll
        for (int b = 0; b < 2; ++b)
#pragma unroll
            for (int m = 0; m < 4; ++m)
#pragma unroll
                for (int n = 0; n < 2; ++n) acc[a][b][m][n] = (f32x4){0.f, 0.f, 0.f, 0.f};
    bf16x8 At[4][2], B0[2][2], B1[2][2];
    constexpr int nt = 1024 / BK;
    S_STB(S_SB(0, 0), cur, 0, 0); S_STA(S_SA(0, 0), cur, 0, 0); S_STB(S_SB(0, 1), cur, 1, 0); S_STA(S_SA(0, 1), cur, 1, 0);
    if (wr == 1) S_BAR;
    S_WV(4); S_BAR;
    S_STB(S_SB(1, 0), cur, 0, 1); S_STA(S_SA(1, 0), cur, 0, 1); S_STB(S_SB(1, 1), cur, 1, 1);
    S_WV(6); S_BAR;
    for (;;) {
        const bool has_next = S.next(ui + 1, nxt);
        if (!has_next) nxt = cur;
#pragma unroll 1
        for (int t = 0; t < nt; t += 2) {
            const bool last = (t == nt - 2);
            S_LDB(B0, 0, 0); S_SCHED; S_LDA(At, 0, 0); S_STA(S_SA(1, 1), cur, 1, t + 1);
            S_WL(8); S_BAR; S_WL(0); S_MMA(0, 0, At, B0); S_BAR; S_SCHED;
            S_LDB(B1, 0, 1); if (last) S_STB(S_SB(0, 0), nxt, 0, 0); else S_STB(S_SB(0, 0), cur, 0, t + 2);
            S_BAR; S_WL(0); S_MMA(0, 1, At, B1); S_BAR;
            S_LDA(At, 0, 1); if (last) S_STA(S_SA(0, 0), nxt, 0, 0); else S_STA(S_SA(0, 0), cur, 0, t + 2);
            S_BAR; S_WL(0); S_MMA(1, 0, At, B0); S_BAR; S_SCHED;
            if (last) S_STB(S_SB(0, 1), nxt, 1, 0); else S_STB(S_SB(0, 1), cur, 1, t + 2);
            S_WV(6); S_BAR; S_MMA(1, 1, At, B1); S_BAR;
            S_LDB(B0, 1, 0); S_SCHED; S_LDA(At, 1, 0); if (last) S_STA(S_SA(0, 1), nxt, 1, 0); else S_STA(S_SA(0, 1), cur, 1, t + 2);
            S_WL(8); S_BAR; S_WL(0); S_MMA(0, 0, At, B0); S_BAR; S_SCHED;
            S_LDB(B1, 1, 1); if (last) S_STB(S_SB(1, 0), nxt, 0, 1); else S_STB(S_SB(1, 0), cur, 0, t + 3);
            S_BAR; S_WL(0); S_MMA(0, 1, At, B1); S_BAR;
            S_LDA(At, 1, 1); if (last) S_STA(S_SA(1, 0), nxt, 0, 1); else S_STA(S_SA(1, 0), cur, 0, t + 3);
            S_BAR; S_WL(0); S_MMA(1, 0, At, B0); S_BAR; S_SCHED;
            if (last) S_STB(S_SB(1, 1), nxt, 1, 1); else S_STB(S_SB(1, 1), cur, 1, t + 3);
            S_WV(6); S_BAR; S_MMA(1, 1, At, B1); S_BAR;
        }
        E(acc, cur, wr, wc, fr, fq);
        if (!has_next) break;
#pragma unroll
        for (int a = 0; a < 2; ++a)
#pragma unroll
            for (int b = 0; b < 2; ++b)
#pragma unroll
                for (int m = 0; m < 4; ++m)
#pragma unroll
                    for (int n = 0; n < 2; ++n) acc[a][b][m][n] = (f32x4){0.f, 0.f, 0.f, 0.f};
        cur = nxt; ++ui;
    }
    S_WV(0);
    if (wr == 0) S_BAR;
    S_BAR;
#undef S_SA
#undef S_SB
#undef S_GL
#undef S_STA
#undef S_STB
#undef S_LDA
#undef S_LDB
#undef S_MMA
#undef S_WV
#undef S_WL
#undef S_BAR
#undef S_SCHED
}

__device__ __forceinline__ void a_offsets_plain(unsigned row0, unsigned& a00, unsigned& a01, unsigned& a10, unsigned& a11) {
    int R0, C0, R1, C1; g8::stage_rc(otid() * 16, R0, C0); g8::stage_rc(otid() * 16 + 8192, R1, C1);
    a00 = (row0 + R0) * 2048u + C0 * 2u; a01 = (row0 + R1) * 2048u + C1 * 2u;
    a10 = (row0 + 128 + R0) * 2048u + C0 * 2u; a11 = (row0 + 128 + R1) * 2048u + C1 * 2u;
}

__device__ __forceinline__ void unit_decode(int L, int nM, int nN, int& pm, int& pn) {
    const int nig = 8 * nN, gid = L / nig, fm = gid * 8, gsz = (nM - fm) < 8 ? (nM - fm) : 8, rem = L - gid * nig;
    if (gsz == 8) { pm = fm + (rem & 7); pn = rem >> 3; }
    else { pm = fm + rem % gsz; pn = rem / gsz; }
}
__device__ __forceinline__ bool unit_map(int i, int bid, int nb, int nM, int nN, int& pm, int& pn) {
    int L;
    if ((nb & 7) == 0) L = (i * 8 + (bid & 7)) * (nb >> 3) + (bid >> 3); else L = i * nb + bid;
    if (L >= nM * nN) return false;
    unit_decode(L, nM, nN, pm, pn);
    return true;
}

struct EpiNoPre { };
struct EpiProj {
    static constexpr bool ACT = false;
    __device__ __forceinline__ bool is_full() const { return true; }
    typedef EpiNoPre Pre;
    bf16_t* out; int ld, nreal, row0, col0;
    __device__ __forceinline__ void prefetch(int, int, int, Pre&) const {}
    __device__ __forceinline__ void rows(int ai, int w2, int lane, const LAS float* stg, const Pre&) const {
        const int col = col0 + lane * 4;
        if (col < nreal) {
#pragma unroll 4
            for (int i = 0; i < 16; ++i) { const int r = w2 * 16 + i; const f32x4 a = *(const LAS f32x4*)(stg + r * 260 + lane * 4);
                u32x2 o; o.x = pk2(a[0], a[1]); o.y = pk2(a[2], a[3]); __builtin_nontemporal_store(o, (u32x2*)(out + (size_t)(row0 + ai * 128 + r) * ld + col)); }
        }
    }
};

struct UnitPlain { unsigned a[2][2]; const unsigned char* Bt; int row0, col0; };
struct SchedPlain {
    typedef UnitPlain UnitT;
    const unsigned char* Bt; int bid, nb, nM, nN;
    __device__ __forceinline__ bool next(int i, UnitT& u) const {
        int pm, pn; if (!unit_map(i, bid, nb, nM, nN, pm, pn)) return false;
        a_offsets_plain(pm * 256, u.a[0][0], u.a[0][1], u.a[1][0], u.a[1][1]);
        u.Bt = Bt + (size_t)pn * 256 * 2048; u.row0 = pm * 256; u.col0 = pn * 256; return true;
    }
};
struct DEpiProj {
    static constexpr bool PERM = true;
    bf16_t* out; int ld, nreal;
    __device__ __forceinline__ void operator()(const f32x4 (&acc)[2][2][4][2], const UnitPlain& u, int wr, int wc, int fr, int fq) const {
#pragma unroll
        for (int ai = 0; ai < 2; ++ai)
#pragma unroll
            for (int m = 0; m < 4; ++m) {
                bf16_t* rowp = out + (size_t)(u.row0 + ai * 128 + wr * 64 + m * 16 + fr) * ld;
#pragma unroll
                for (int bj = 0; bj < 2; ++bj) {
                    const int col = u.col0 + bj * 128 + wc * 32 + 8 * fq;
                    if (col < nreal) { const f32x4 v0 = acc[ai][bj][m][0], v1 = acc[ai][bj][m][1];
                        u32x4 o; o.x = pk2(v0[0], v0[1]); o.y = pk2(v0[2], v0[3]); o.z = pk2(v1[0], v1[1]); o.w = pk2(v1[2], v1[3]);
                        __builtin_nontemporal_store(o, (u32x4*)(rowp + col)); }
                }
            }
    }
};
__device__ __forceinline__ void ph_inproj(const P& p, int layer, LAS unsigned char* lds, int bid, int nb) {
    SchedPlain S{p.ws + (layer ? WS_WIN1 : WS_WIN0), bid, nb, MT / 256, layer ? (NIN1P / 256) : (NIN0P / 256)};
    DEpiProj E{(bf16_t*)(p.ws + WS_BIG), layer ? NIN1 : NIN0, layer ? NIN1 : NIN0};
    __syncthreads();
    gemm_stream(lds, p.ws + WS_H, S, E);
    __syncthreads();
}

struct Pre8 { float4 x[8]; };
struct EpiOut {
    static constexpr bool ACT = false;
    __device__ __forceinline__ bool is_full() const { return true; }
    typedef Pre8 Pre;
    const float* src; float* dst; const float* g; size_t ro0; int col0;
    __device__ __forceinline__ void prefetch(int ai, int w2, int lane, Pre& pre) const {
#pragma unroll
        for (int i = 0; i < 8; ++i) pre.x[i] = ntld4(src + ro0 + (size_t)(ai * 128 + w2 * 16 + i) * D + col0 + lane * 4);
    }
    __device__ __forceinline__ void rows(int ai, int w2, int lane, const LAS float* stg, const Pre& pre) const {
        const int col = col0 + lane * 4; const float4 gg = *(const float4*)(g + col);
        float4 x2[8];
#pragma unroll
        for (int i = 0; i < 8; ++i) x2[i] = ntld4(src + ro0 + (size_t)(ai * 128 + w2 * 16 + 8 + i) * D + col);
#pragma unroll
        for (int i = 0; i < 16; ++i) {
            const int r = w2 * 16 + i; const f32x4 a = *(const LAS f32x4*)(stg + r * 260 + lane * 4);
            const float4 x = i < 8 ? pre.x[i & 7] : x2[i & 7];
            float4 y; y.x = x.x + gg.x * a[0]; y.y = x.y + gg.y * a[1]; y.z = x.z + gg.z * a[2]; y.w = x.w + gg.w * a[3];
            *(float4*)(dst + ro0 + (size_t)(ai * 128 + r) * D + col) = y;
        }
    }
};

__device__ __forceinline__ void ph_outproj(const P& p, int layer, LAS unsigned char* lds, int bid, int nb) {
    const int nrt = layer ? 256 : 264;
    const int nunits = nrt * 4;
    const unsigned char* A = p.ws + WS_H;
    const unsigned char* Bt = p.ws + WS_WOUT + (size_t)layer * 1024 * 2048;
    (void)nunits;
    for (int it = 0;; ++it) {
        int j, pn; if (!unit_map(it, bid, nb, nrt, 4, j, pn)) break;
        const int pm = layer ? ((j >> 5) * 33 + 1 + (j & 31)) : j;
        unsigned a00, a01, a10, a11; a_offsets_plain(pm * 256, a00, a01, a10, a11);
        int b, pp0; row_decode(pm * 256, b, pp0);
        const bool isctx = pp0 < CTX;
        const float* MOD = (const float*)(p.ws + WS_MOD);
        EpiOut E{isctx ? (layer ? (const float*)(p.ws + WS_CTXS) : p.in[2]) : (layer ? (const float*)p.out : p.in[0]), isctx ? (float*)(p.ws + WS_CTXS) : p.out,
                 MOD + (size_t)(layer * 9 + (isctx ? 8 : b)) * 6144 + 2048, isctx ? (size_t)(b * CTX + pp0) * D : (size_t)(b * SEQ + pp0 - CTX) * D, pn * 256};
        gemm_unit(lds, A, a00, a01, a10, a11, Bt + (size_t)pn * 256 * 2048, E);
    }
}

constexpr int TC = 32;
__device__ __forceinline__ int seq_pp(int n, int dir) { return dir == 0 ? n : (n < CTX ? (CTX - 1 - n) : (PB + CTX - 1 - n)); }

template <int DK, int MODE  >
__device__ __forceinline__ void scan_chunk(const float* qs, const float* ks_, const float* as_, const float* vs, const float* egs, const float* bts, float* os, float (&S)[DK / 8], int w, int cl, int ksl) {
    constexpr int NR = DK / 8;
    for (int tt = 0; tt < TC; ++tt) {
        const float vv = vs[tt * 64 + w * 8 + cl];
        float qv[NR], kv[NR], av[NR];
#pragma unroll
        for (int r4 = 0; r4 < NR / 4; ++r4) {
            const float4 q4 = *(const float4*)(qs + tt * DK + ksl * NR + r4 * 4); qv[r4 * 4] = q4.x; qv[r4 * 4 + 1] = q4.y; qv[r4 * 4 + 2] = q4.z; qv[r4 * 4 + 3] = q4.w;
            if (MODE != 1) { const float4 k4 = *(const float4*)(ks_ + tt * DK + ksl * NR + r4 * 4); kv[r4 * 4] = k4.x; kv[r4 * 4 + 1] = k4.y; kv[r4 * 4 + 2] = k4.z; kv[r4 * 4 + 3] = k4.w; }
            if (MODE != 2) { const float4 a4 = *(const float4*)(as_ + tt * DK + ksl * NR + r4 * 4); av[r4 * 4] = a4.x; av[r4 * 4 + 1] = a4.y; av[r4 * 4 + 2] = a4.z; av[r4 * 4 + 3] = a4.w; }
        }
        float o = 0.f;
        if (MODE == 0) {
#pragma unroll
            for (int r = 0; r < NR; ++r) { S[r] = av[r] * S[r] + kv[r] * vv; o += qv[r] * S[r]; }
        } else if (MODE == 1) {
#pragma unroll
            for (int r = 0; r < NR; ++r) { S[r] = av[r] * S[r] + (1.f - av[r]) * vv; o += qv[r] * S[r]; }
        } else {
            const float eg = egs[tt], bt = bts[tt];
            float kS = 0.f;
#pragma unroll
            for (int r = 0; r < NR; ++r) kS += kv[r] * S[r];
            kS = red8(kS);
            const float c = bt * (vv - eg * kS);
#pragma unroll
            for (int r = 0; r < NR; ++r) { S[r] = eg * S[r] + kv[r] * c; o += qv[r] * S[r]; }
        }
        o = red8(o);
        if (ksl == 0) os[tt * 64 + w * 8 + cl] = o;
    }
}

__device__ __forceinline__ void scan_unit_l0(const P& p, int u, float* ldsf) {
    const int type = u >> 7, idx = u & 127, b = idx >> 4, h = (idx >> 2) & 3, dir = (idx >> 1) & 1, half = idx & 1;
    const int tid = otid(), lane = tid & 63, w = tid >> 6, cl = lane >> 3, ksl = lane & 7;
    const bf16_t* PROJ = (const bf16_t*)(p.ws + WS_BIG);
    bf16_t* OD = (bf16_t*)(p.ws + WS_SCR) + (size_t)dir * MT * D;
    if (type == 0) {
        float* qs = ldsf; float* ks_ = qs + TC * 64; float* as_ = ks_ + TC * 64; float* vs = as_ + TC * 64; float* os = vs + TC * 64; float* rs = os + TC * 64;
        const float* W2 = (dir ? p.in[11] : p.in[9]); const float* B2 = (dir ? p.in[12] : p.in[10]);
        const int i = tid & 63;
        float w2c[16];
#pragma unroll
        for (int m = 0; m < 16; ++m) w2c[m] = W2[m * 256 + h * 64 + i];
        const float b2c = B2[h * 64 + i];
        float S[8];
#pragma unroll
        for (int r = 0; r < 8; ++r) S[r] = 0.f;
        for (int c0 = 0; c0 < PB; c0 += TC) {
            __syncthreads();
#pragma unroll
            for (int j = 0; j < 4; ++j) {
                const int t = (tid >> 6) + 8 * j; const size_t R = (size_t)b * PB + seq_pp(c0 + t, dir);
                const bf16_t* row = PROJ + R * NIN0;
                qs[t * 64 + i] = bf2f(row[h * 64 + i]) * 0.125f;
                ks_[t * 64 + i] = bf2f(row[256 + h * 64 + i]);
                vs[t * 64 + i] = bf2f(row[512 + h * 128 + half * 64 + i]);
            }
            { const int t = tid >> 4, m = tid & 15; const size_t R = (size_t)b * PB + seq_pp(c0 + t, dir); rs[t * 16 + m] = bf2f(PROJ[R * NIN0 + 1024 + dir * 16 + m]); }
            __syncthreads();
#pragma unroll
            for (int j = 0; j < 4; ++j) {
                const int t = (tid >> 6) + 8 * j;
                float z = b2c;
#pragma unroll
                for (int m = 0; m < 16; ++m) z += rs[t * 16 + m] * w2c[m];
                const float ls = fminf(z, 0.f) - __logf(1.f + __expf(-fabsf(z)));
                as_[t * 64 + i] = __expf(ls * (1.f / 16.f));
            }
            __syncthreads();
            scan_chunk<64, 0>(qs, ks_, as_, vs, nullptr, nullptr, os, S, w, cl, ksl);
            __syncthreads();
            { const int t = tid >> 4, c4 = (tid & 15) * 4; const size_t R = (size_t)b * PB + seq_pp(c0 + t, dir);
              uint2 o; o.x = pk2(os[t * 64 + c4], os[t * 64 + c4 + 1]); o.y = pk2(os[t * 64 + c4 + 2], os[t * 64 + c4 + 3]);
              *(uint2*)(OD + R * D + h * 128 + half * 64 + c4) = o; }
        }
    } else {
        float* qs = ldsf; float* fs = qs + TC * 128; float* vs = fs + TC * 128; float* os = vs + TC * 64;
        const int i = tid & 127;
        const float* lbl = p.in[15];
        const float lb = 1.f / (1.f + __expf(lbl[512 + h * 128 + i] - lbl[h * 128 + i]));
        float S[16];
#pragma unroll
        for (int r = 0; r < 16; ++r) S[r] = 0.f;
        for (int c0 = 0; c0 < PB; c0 += TC) {
            __syncthreads();
#pragma unroll
            for (int j = 0; j < 8; ++j) {
                const int t = (tid >> 7) + 4 * j; const size_t R = (size_t)b * PB + seq_pp(c0 + t, dir);
                const bf16_t* row = PROJ + R * NIN0;
                qs[t * 128 + i] = bf2f(row[1568 + h * 128 + i]);
                const float z = bf2f(row[2080 + dir * 512 + h * 128 + i]);
                fs[t * 128 + i] = lb + (1.f - lb) * sigmoidf_(z);
            }
#pragma unroll
            for (int j = 0; j < 4; ++j) {
                const int t = (tid >> 6) + 8 * j; const size_t R = (size_t)b * PB + seq_pp(c0 + t, dir);
                vs[t * 64 + (tid & 63)] = bf2f(PROJ[R * NIN0 + 3104 + h * 128 + half * 64 + (tid & 63)]);
            }
            __syncthreads();
            scan_chunk<128, 1>(qs, nullptr, fs, vs, nullptr, nullptr, os, S, w, cl, ksl);
            __syncthreads();
            { const int t = tid >> 4, c4 = (tid & 15) * 4; const size_t R = (size_t)b * PB + seq_pp(c0 + t, dir);
              uint2 o; o.x = pk2(os[t * 64 + c4], os[t * 64 + c4 + 1]); o.y = pk2(os[t * 64 + c4 + 2], os[t * 64 + c4 + 3]);
              *(uint2*)(OD + R * D + 512 + h * 128 + half * 64 + c4) = o; }
        }
    }
}

template <int NK>
__device__ __forceinline__ f32x4 mma_tile(const LAS unsigned char* A, int strideA, int rowA0, const LAS unsigned char* B, int strideB, int rowB0, f32x4 acc, int lane) {
    const int r = lane & 15, q = lane >> 4;
    const LAS unsigned char* ap = A + (rowA0 + r) * strideA + q * 16;
    const LAS unsigned char* bp = B + (rowB0 + r) * strideB + q * 16;
#pragma unroll
    for (int kb = 0; kb < NK; ++kb) {
        const bf16x8 a = *(const LAS bf16x8*)(ap + kb * 64), b = *(const LAS bf16x8*)(bp + kb * 64);
        acc = __builtin_amdgcn_mfma_f32_16x16x32_bf16(a, b, acc, 0, 0, 0);
    }
    return acc;
}
template <int NK>
__device__ __forceinline__ f32x4 mma_tile_rows(const LAS unsigned char* A, int strideA, int rowA, const LAS unsigned char* B, int strideB, int rowB0, f32x4 acc, int lane) {
    const int r = lane & 15, q = lane >> 4;
    const LAS unsigned char* ap = A + rowA * strideA + q * 16;
    const LAS unsigned char* bp = B + (rowB0 + r) * strideB + q * 16;
#pragma unroll
    for (int kb = 0; kb < NK; ++kb) {
        const bf16x8 a = *(const LAS bf16x8*)(ap + kb * 64), b = *(const LAS bf16x8*)(bp + kb * 64);
        acc = __builtin_amdgcn_mfma_f32_16x16x32_bf16(a, b, acc, 0, 0, 0);
    }
    return acc;
}
__device__ __forceinline__ float fexp(float x) { return __builtin_amdgcn_exp2f(x * 1.4426950408889634f); }
__device__ __forceinline__ float flog(float x) { return __builtin_amdgcn_logf(x) * 0.6931471805599453f; }
__device__ __forceinline__ float clamp80(float x) { return fminf(fmaxf(x, -80.f), 80.f); }

template <int TYPE  >
__device__ __forceinline__ void scan_l0_chunked(const P& p, int idx, LAS unsigned char* lds) {
    constexpr int DK = TYPE ? 128 : 64, C = 64, CPT = DK / 64, TL = 8, NSEG = 8;
    constexpr int SQ = DK * 2 + 16, S64 = 144;
    constexpr int OFF_QM = 0, OFF_KM = OFF_QM + C * SQ, OFF_QS = OFF_KM + C * SQ, OFF_KL = OFF_QS + C * SQ, OFF_VT = OFF_KL + DK * S64, OFF_P = OFF_VT + 64 * S64,
                  OFF_S0 = OFF_P + 64 * S64, OFF_S1 = OFF_S0 + 64 * SQ, OFF_TOT = OFF_S1 + 64 * SQ, OFF_D = OFF_TOT + NSEG * DK * 4, OFF_END = OFF_D + DK * 4;
    static_assert(OFF_END <= LDS_CTL, "scan LDS");
    const int b = idx >> 4, h = (idx >> 2) & 3, dir = (idx >> 1) & 1, half = idx & 1;
    const int tid = otid(), lane = tid & 63, w = __builtin_amdgcn_readfirstlane(tid >> 6), r16 = lane & 15, q4 = lane >> 4;
    const int i0 = lane * CPT, seg = w;
    const bf16_t* PROJ = (const bf16_t*)(p.ws + WS_BIG);
    bf16_t* OD = (bf16_t*)(p.ws + WS_SCR) + (size_t)dir * MT * D + (TYPE ? 512 : 0) + h * 128 + half * 64;
    LAS float* TOT = (LAS float*)(lds + OFF_TOT); LAS float* DV = (LAS float*)(lds + OFF_D);
    float lb[CPT], b2c = 0.f; float w2c[16];
    if (TYPE) { const float* lbl = p.in[15];
#pragma unroll
        for (int c = 0; c < CPT; ++c) lb[c] = 1.f / (1.f + fexp(lbl[512 + h * 128 + i0 + c] - lbl[h * 128 + i0 + c])); }
    else { const float* W2 = dir ? p.in[11] : p.in[9]; const float* B2 = dir ? p.in[12] : p.in[10]; lb[0] = 0.f;
#pragma unroll
        for (int m = 0; m < 16; ++m) w2c[m] = W2[m * 256 + h * 64 + i0];
        b2c = B2[h * 64 + i0]; }
    const int qcol = TYPE ? (1568 + h * 128 + i0) : (h * 64 + i0);
    const int zcol = TYPE ? (2080 + dir * 512 + h * 128 + i0) : (256 + h * 64 + i0);
    const int vcol = (TYPE ? (3104 + h * 128) : (512 + h * 128)) + half * 64 + (tid & 7) * 8;
    constexpr int NST = TYPE ? 4 : 2;
    const int it = TYPE ? w : (w >> 1), ct0 = TYPE ? 0 : ((w & 1) * 2);
    f32x4 sacc[NST];
#pragma unroll
    for (int k = 0; k < NST; ++k) sacc[k] = (f32x4){0.f, 0.f, 0.f, 0.f};
    __syncthreads();
    for (int k = tid; k < 64 * SQ / 4; k += NTHR) ((LAS unsigned*)(lds + OFF_S0))[k] = 0u;
    int cur = 0;
    unsigned rq[TL], rz[TL]; uint4 rv; uint4 rr[TYPE ? 1 : 2 * TL];
#define L0_LOAD(n) do { \
        _Pragma("unroll") for (int j = 0; j < TL; ++j) { const size_t R = (size_t)b * PB + seq_pp((n) * C + seg * TL + j, dir); const bf16_t* row = PROJ + R * NIN0; \
            if (CPT == 2) { rq[j] = *(const unsigned*)(row + qcol); rz[j] = *(const unsigned*)(row + zcol); } else { rq[j] = row[qcol]; rz[j] = row[zcol]; } \
            if (!TYPE) { rr[2 * j] = *(const uint4*)(row + 1024 + dir * 16); rr[2 * j + 1] = *(const uint4*)(row + 1024 + dir * 16 + 8); } } \
        { const size_t R = (size_t)b * PB + seq_pp((n) * C + (tid >> 3), dir); rv = *(const uint4*)(PROJ + R * NIN0 + vcol); } } while (0)
    L0_LOAD(0);
    for (int n = 0; n < PB / C; ++n) {
        float qv[CPT][TL], kv[CPT][TL], Bl[CPT][TL];
        float run[CPT];
#pragma unroll
        for (int c = 0; c < CPT; ++c) run[c] = 0.f;
#pragma unroll
        for (int j = 0; j < TL; ++j) {
#pragma unroll
            for (int c = 0; c < CPT; ++c) {
                const float qr = c ? bfhi(rq[j]) : bflo(rq[j]), zr = c ? bfhi(rz[j]) : bflo(rz[j]);
                float G;
                if (TYPE) { const float f = lb[c] + (1.f - lb[c]) * __builtin_amdgcn_rcpf(1.f + fexp(-zr)); G = flog(f); kv[c][j] = 1.f - f; qv[c][j] = qr; }
                else {
                    const uint4 r0 = rr[2 * j], r1 = rr[2 * j + 1];
                    float z = b2c;
                    z += bflo(r0.x) * w2c[0] + bfhi(r0.x) * w2c[1] + bflo(r0.y) * w2c[2] + bfhi(r0.y) * w2c[3] + bflo(r0.z) * w2c[4] + bfhi(r0.z) * w2c[5] + bflo(r0.w) * w2c[6] + bfhi(r0.w) * w2c[7];
                    z += bflo(r1.x) * w2c[8] + bfhi(r1.x) * w2c[9] + bflo(r1.y) * w2c[10] + bfhi(r1.y) * w2c[11] + bflo(r1.z) * w2c[12] + bfhi(r1.z) * w2c[13] + bflo(r1.w) * w2c[14] + bfhi(r1.w) * w2c[15];
                    G = (fminf(z, 0.f) - flog(1.f + fexp(-fabsf(z)))) * (1.f / 16.f);
                    kv[c][j] = zr; qv[c][j] = qr * 0.125f;
                }
                run[c] += G; Bl[c][j] = run[c];
            }
        }
#pragma unroll
        for (int c = 0; c < CPT; ++c) TOT[seg * DK + i0 + c] = run[c];
        const uint4 vraw = rv;
        LDS_SYNC();
        float offs[CPT], mref[CPT], blast[CPT];
#pragma unroll
        for (int c = 0; c < CPT; ++c) { offs[c] = 0.f; mref[c] = 0.f; blast[c] = 0.f; }
#pragma unroll
        for (int s2 = 0; s2 < NSEG; ++s2)
#pragma unroll
            for (int c = 0; c < CPT; ++c) { const float tv = TOT[s2 * DK + i0 + c]; offs[c] += (s2 < seg) ? tv : 0.f; mref[c] += (s2 < NSEG / 2) ? tv : 0.f; blast[c] += tv; }
        {
            unsigned kl[CPT][TL / 2];
#pragma unroll
            for (int j = 0; j < TL; ++j) {
                const int t = seg * TL + j;
                float qm[CPT], km[CPT], qs[CPT], kq[CPT];
#pragma unroll
                for (int c = 0; c < CPT; ++c) { const float Bt = offs[c] + Bl[c][j]; const float e1 = fexp(clamp80(Bt - mref[c])), e2 = __builtin_amdgcn_rcpf(e1), eb = fexp(Bt), el = fexp(blast[c] - Bt);
                    qm[c] = qv[c][j] * e1; km[c] = kv[c][j] * e2; qs[c] = qv[c][j] * eb; kq[c] = kv[c][j] * el; }
                if (CPT == 2) {
                    *(LAS unsigned*)(lds + OFF_QM + t * SQ + i0 * 2) = pk2(qm[0], qm[CPT - 1]);
                    *(LAS unsigned*)(lds + OFF_KM + t * SQ + i0 * 2) = pk2(km[0], km[CPT - 1]);
                    *(LAS unsigned*)(lds + OFF_QS + t * SQ + i0 * 2) = pk2(qs[0], qs[CPT - 1]);
                } else {
                    *(LAS bf16_t*)(lds + OFF_QM + t * SQ + i0 * 2) = f2bf(qm[0]);
                    *(LAS bf16_t*)(lds + OFF_KM + t * SQ + i0 * 2) = f2bf(km[0]);
                    *(LAS bf16_t*)(lds + OFF_QS + t * SQ + i0 * 2) = f2bf(qs[0]);
                }
#pragma unroll
                for (int c = 0; c < CPT; ++c) {
                    if (j & 1) kl[c][j >> 1] = (kl[c][j >> 1] & 0xffffu) | ((unsigned)f2bf(kq[c]) << 16); else kl[c][j >> 1] = (unsigned)f2bf(kq[c]);
                }
            }
#pragma unroll
            for (int c = 0; c < CPT; ++c) {
                *(LAS u32x4*)(lds + OFF_KL + (i0 + c) * S64 + (seg * TL) * 2) = (u32x4){kl[c][0], kl[c][1], kl[c][2], kl[c][3]};
                if (seg == 0) DV[i0 + c] = fexp(blast[c]);
            }
            const int tv = tid >> 3, c8 = (tid & 7) * 8;
            const unsigned vw[4] = {vraw.x, vraw.y, vraw.z, vraw.w};
#pragma unroll
            for (int e = 0; e < 4; ++e) { *(LAS bf16_t*)(lds + OFF_VT + (c8 + 2 * e) * S64 + tv * 2) = (bf16_t)(vw[e] & 0xffffu); *(LAS bf16_t*)(lds + OFF_VT + (c8 + 2 * e + 1) * S64 + tv * 2) = (bf16_t)(vw[e] >> 16); }
        }
        LDS_SYNC();
        if (n + 1 < PB / C) L0_LOAD(n + 1);
#pragma unroll
        for (int k = 0; k < 2; ++k) {
            const int tile = w + 8 * k, st = tile >> 2, tt = tile & 3;
            f32x4 d = (f32x4){0.f, 0.f, 0.f, 0.f};
            if (st <= tt) d = mma_tile<DK / 32>(lds + OFF_KM, SQ, st * 16, lds + OFF_QM, SQ, tt * 16, d, lane);
            const int s0 = st * 16 + 4 * q4, t = tt * 16 + r16;
            u32x2 o; o.x = pk2(s0 <= t ? d[0] : 0.f, s0 + 1 <= t ? d[1] : 0.f); o.y = pk2(s0 + 2 <= t ? d[2] : 0.f, s0 + 3 <= t ? d[3] : 0.f);
            *(LAS u32x2*)(lds + OFF_P + t * S64 + s0 * 2) = o;
        }
        {
            const f32x4 dv = *(const LAS f32x4*)(DV + it * 16 + 4 * q4);
            const int snx = cur ? OFF_S0 : OFF_S1;
#pragma unroll
            for (int k = 0; k < NST; ++k) {
                const int ct = ct0 + k;
                f32x4 a = sacc[k]; a[0] *= dv[0]; a[1] *= dv[1]; a[2] *= dv[2]; a[3] *= dv[3];
                a = mma_tile<2>(lds + OFF_KL, S64, it * 16, lds + OFF_VT, S64, ct * 16, a, lane);
                sacc[k] = a;
                u32x2 o; o.x = pk2(a[0], a[1]); o.y = pk2(a[2], a[3]);
                *(LAS u32x2*)(lds + snx + (ct * 16 + r16) * SQ + (it * 16 + 4 * q4) * 2) = o;
            }
        }
        LDS_SYNC();
        {
            const int scu = cur ? OFF_S1 : OFF_S0;
#pragma unroll
            for (int k = 0; k < 2; ++k) {
                const int tile = 2 * w + k, ct = tile >> 2, tt = tile & 3;
                f32x4 d = (f32x4){0.f, 0.f, 0.f, 0.f};
                d = mma_tile<2>(lds + OFF_VT, S64, ct * 16, lds + OFF_P, S64, tt * 16, d, lane);
                d = mma_tile<DK / 32>(lds + scu, SQ, ct * 16, lds + OFF_QS, SQ, tt * 16, d, lane);
                const size_t R = (size_t)b * PB + seq_pp(n * C + tt * 16 + r16, dir);
                uint2 o; o.x = pk2(d[0], d[1]); o.y = pk2(d[2], d[3]);
                *(uint2*)(OD + R * D + ct * 16 + 4 * q4) = o;
            }
        }
        cur ^= 1;
    }
#undef L0_LOAD
}

__device__ __forceinline__ void scan_unit_delta(const P& p, int idx, float* ldsf) {
    const int b = idx >> 4, h = (idx >> 2) & 3, dir = (idx >> 1) & 1, half = idx & 1;
    const int tid = otid(), lane = tid & 63, w = tid >> 6, cl = lane >> 3, ksl = lane & 7;
    const bf16_t* PROJ = (const bf16_t*)(p.ws + WS_BIG);
    const bf16_t* QKV = (const bf16_t*)(p.ws + WS_SCR);
    bf16_t* OD = (bf16_t*)(p.ws + WS_OFB1) + (size_t)dir * MT * 512;
    float* qs = ldsf; float* ks_ = qs + TC * 128; float* vs = ks_ + TC * 128; float* os = vs + TC * 64; float* egs = os + TC * 64; float* bts = egs + TC;
    const float Aexp = __expf((dir ? p.in[31] : p.in[29])[h]); const float dtb = (dir ? p.in[32] : p.in[30])[h];
    const int i = tid & 127;
    float S[16];
#pragma unroll
    for (int r = 0; r < 16; ++r) S[r] = 0.f;
    for (int c0 = 0; c0 < PB; c0 += TC) {
        __syncthreads();
#pragma unroll
        for (int j = 0; j < 8; ++j) {
            const int t = (tid >> 7) + 4 * j; const size_t R = (size_t)b * PB + seq_pp(c0 + t, dir);
            const bf16_t* row = QKV + R * 1536;
            qs[t * 128 + i] = bf2f(row[h * 128 + i]);
            ks_[t * 128 + i] = bf2f(row[512 + h * 128 + i]);
        }
#pragma unroll
        for (int j = 0; j < 4; ++j) {
            const int t = (tid >> 6) + 8 * j; const size_t R = (size_t)b * PB + seq_pp(c0 + t, dir);
            vs[t * 64 + (tid & 63)] = bf2f(QKV[R * 1536 + 1024 + h * 128 + half * 64 + (tid & 63)]);
        }
        if (tid < TC) {
            const size_t R = (size_t)b * PB + seq_pp(c0 + tid, dir);
            const float a = bf2f(PROJ[R * NIN1 + 1544 + dir * 4 + h]) + dtb;
            const float sp = a > 20.f ? a : __logf(1.f + __expf(a));
            egs[tid] = __expf(-Aexp * sp);
            bts[tid] = sigmoidf_(bf2f(PROJ[R * NIN1 + 1536 + dir * 4 + h]));
        }
        __syncthreads();
        scan_chunk<128, 2>(qs, ks_, nullptr, vs, egs, bts, os, S, w, cl, ksl);
        __syncthreads();
        if (seq_pp(c0, dir) >= CTX) {
            const int t = tid >> 4, c4 = (tid & 15) * 4; const size_t R = (size_t)b * PB + seq_pp(c0 + t, dir);
            uint2 o; o.x = pk2(os[t * 64 + c4], os[t * 64 + c4 + 1]); o.y = pk2(os[t * 64 + c4 + 2], os[t * 64 + c4 + 3]);
            *(uint2*)(OD + R * 512 + h * 128 + half * 64 + c4) = o;
        }
    }
}

__device__ __forceinline__ void ph_delta_T(const P& p, LAS unsigned char* lds, int bid, int nb) {
    const int tid = otid(), lane = tid & 63, w = __builtin_amdgcn_readfirstlane(tid >> 6), r16 = lane & 15, q4 = lane >> 4;
    LAS unsigned char* wl = lds + w * 17920;
    LAS float* GA = (LAS float*)(wl + 17408); LAS float* BE = GA + 64;
    LAS float* Af = (LAS float*)wl;
    const bf16_t* PROJ = (const bf16_t*)(p.ws + WS_BIG);
    const bf16_t* QKV = (const bf16_t*)(p.ws + WS_SCR);
    bf16_t* TM = (bf16_t*)(p.ws + WS_TM);
    __syncthreads();
    for (int u = bid * 8 + w; u < 8448; u += nb * 8) {
        const int n = u % 132, hh = (u / 132) & 3, b = (u / 528) & 7, dir = u / 4224;
        const size_t R = (size_t)b * PB + seq_pp(n * 64 + lane, dir);
        const float Aexp = __expf((dir ? p.in[31] : p.in[29])[hh]), dtb = (dir ? p.in[32] : p.in[30])[hh];
        const float a = bf2f(PROJ[R * NIN1 + 1544 + dir * 4 + hh]) + dtb;
        const float sp = a > 20.f ? a : __logf(1.f + __expf(a));
        float gam = -Aexp * sp;
        const float beta = sigmoidf_(bf2f(PROJ[R * NIN1 + 1536 + dir * 4 + hh]));
#pragma unroll
        for (int o = 1; o < 64; o <<= 1) { const float t = __shfl_up(gam, o); if (lane >= o) gam += t; }
        GA[lane] = gam; BE[lane] = beta;
        { float* GB = (float*)(p.ws + WS_WIN0) + (size_t)u * 128; GB[lane] = gam; GB[64 + lane] = beta; }
        {
#pragma unroll
          for (int j = 0; j < 16; ++j) { const int row = 4 * j + (lane >> 4); const size_t Rr = (size_t)b * PB + seq_pp(n * 64 + row, dir);
              const uint4 v = *(const uint4*)(QKV + Rr * 1536 + 512 + hh * 128 + (lane & 15) * 8); *(LAS u32x4*)(wl + row * 272 + (lane & 15) * 16) = (u32x4){v.x, v.y, v.z, v.w}; } }
        WAVE_FENCE();
        f32x4 at[10];
        { int ix = 0;
#pragma unroll
          for (int tt = 0; tt < 4; ++tt)
#pragma unroll
            for (int st = 0; st <= tt; ++st) { at[ix] = mma_tile<4>(wl, 272, tt * 16, wl, 272, st * 16, (f32x4){0.f, 0.f, 0.f, 0.f}, lane); ++ix; } }
        float gsig[4], gtau[4][4], btau[4][4];
#pragma unroll
        for (int st = 0; st < 4; ++st) gsig[st] = GA[st * 16 + r16];
#pragma unroll
        for (int tt = 0; tt < 4; ++tt) { const f32x4 g4 = *(const LAS f32x4*)(GA + tt * 16 + 4 * q4), b4 = *(const LAS f32x4*)(BE + tt * 16 + 4 * q4);
#pragma unroll
            for (int e = 0; e < 4; ++e) { gtau[tt][e] = g4[e]; btau[tt][e] = b4[e]; } }
        WAVE_FENCE();
        LAS float* AD = (LAS float*)wl;
        LAS unsigned char* AO = wl + 4096;
        LAS unsigned char* TT = wl + 8704;
        LAS float* YS = (LAS float*)(wl + 13312);
        { int ix = 0;
#pragma unroll
          for (int tt = 0; tt < 4; ++tt)
#pragma unroll
            for (int st = 0; st <= tt; ++st) {
#pragma unroll
                for (int e = 0; e < 4; ++e) { const int tau = tt * 16 + 4 * q4 + e, sg = st * 16 + r16;
                    const float val = (sg < tau) ? btau[tt][e] * __expf(gtau[tt][e] - gsig[st]) * at[ix][e] : 0.f;
                    if (st == tt) AD[tau * 16 + r16] = val; else *(LAS bf16_t*)(AO + (tau - 16) * 96 + sg * 2) = f2bf(val); }
                ++ix; } }
        WAVE_FENCE();
        float T[64];
#pragma unroll
        for (int i = 0; i < 4; ++i) {
            float y[16];
#pragma unroll
            for (int r = 0; r < 16; ++r) y[r] = 0.f;
            if (i > 0) {
#pragma unroll
                for (int ct = 0; ct < i; ++ct) {
                    f32x4 d = (f32x4){0.f, 0.f, 0.f, 0.f};
                    const LAS unsigned char* ap = AO + ((i - 1) * 16 + r16) * 96; const LAS unsigned char* bp = TT + (ct * 16 + r16) * 96;
                    const bf16x8 z8 = {0, 0, 0, 0, 0, 0, 0, 0};
                    if (i >= 2) d = __builtin_amdgcn_mfma_f32_16x16x32_bf16(*(const LAS bf16x8*)(ap + q4 * 16), *(const LAS bf16x8*)(bp + q4 * 16), d, 0, 0, 0);
                    if (i == 1 || i == 3) {
                        const int ko = (i == 3) ? 64 : 0;
                        bf16x8 av = *(const LAS bf16x8*)(ap + ko + q4 * 16), bv = *(const LAS bf16x8*)(bp + ko + q4 * 16);
                        if (q4 >= 2) { av = z8; bv = z8; }
                        d = __builtin_amdgcn_mfma_f32_16x16x32_bf16(av, bv, d, 0, 0, 0);
                    }
#pragma unroll
                    for (int e = 0; e < 4; ++e) YS[(4 * q4 + e) * 52 + ct * 16 + r16] = d[e];
                }
                WAVE_FENCE();
                if (lane < 16 * i) {
#pragma unroll
                    for (int r = 0; r < 16; ++r) y[r] = YS[r * 52 + lane];
                }
            }
#pragma unroll
            for (int r = 0; r < 16; ++r) {
                float acc = ((i * 16 + r == lane) ? 1.f : 0.f) - y[r];
#pragma unroll
                for (int k4 = 0; k4 * 4 < r; ++k4) {
                    const f32x4 a4 = *(const LAS f32x4*)(AD + (i * 16 + r) * 16 + k4 * 4);
#pragma unroll
                    for (int e = 0; e < 4; ++e) if (k4 * 4 + e < r) acc -= a4[e] * T[i * 16 + k4 * 4 + e];
                }
                T[i * 16 + r] = acc;
            }
            if (i < 3) {
                if (lane < 48) {
                    const u32x4 v0 = {pk2(T[i * 16 + 0], T[i * 16 + 1]), pk2(T[i * 16 + 2], T[i * 16 + 3]), pk2(T[i * 16 + 4], T[i * 16 + 5]), pk2(T[i * 16 + 6], T[i * 16 + 7])};
                    const u32x4 v1 = {pk2(T[i * 16 + 8], T[i * 16 + 9]), pk2(T[i * 16 + 10], T[i * 16 + 11]), pk2(T[i * 16 + 12], T[i * 16 + 13]), pk2(T[i * 16 + 14], T[i * 16 + 15])};
                    *(LAS u32x4*)(TT + lane * 96 + i * 32) = v0; *(LAS u32x4*)(TT + lane * 96 + i * 32 + 16) = v1;
                }
                WAVE_FENCE();
            }
        }
        WAVE_FENCE();
#pragma unroll
        for (int r = 0; r < 64; ++r) *(LAS bf16_t*)(wl + r * 144 + lane * 2) = f2bf(T[r]);
        WAVE_FENCE();
#pragma unroll
        for (int j = 0; j < 8; ++j) { const int row = 8 * j + (lane >> 3), pc = lane & 7;
            const u32x4 v = *(const LAS u32x4*)(wl + row * 144 + pc * 16); *(uint4*)(TM + (size_t)u * 4096 + row * 64 + pc * 8) = make_uint4(v[0], v[1], v[2], v[3]); }
        WAVE_FENCE();
    }
}

__device__ __forceinline__ void scan_delta_chunked(const P& p, int idx, LAS unsigned char* lds) {
    constexpr int C = 64, SQ = 272, S64 = 144;
    constexpr int OFF_KR = 0, OFF_QR = OFF_KR + 64 * SQ, OFF_QG = OFF_QR + 64 * SQ, OFF_NKG = OFF_QG + 64 * SQ, OFF_KLT = OFF_NKG + 64 * SQ,
                  OFF_VBT = OFF_KLT + 128 * S64, OFF_P2 = OFF_VBT + 64 * S64, OFF_VNT = OFF_P2 + 64 * S64, OFF_ST0 = OFF_VNT + 64 * S64, OFF_ST1 = OFF_ST0 + 64 * SQ,
                  OFF_GA = OFF_ST1 + 64 * SQ, OFF_VB = OFF_GA + 256, OFF_END = OFF_VB + 64 * S64;
    static_assert(OFF_END <= LDS_CTL, "delta LDS");
    const int b = idx >> 4, h = (idx >> 2) & 3, dir = (idx >> 1) & 1, half = idx & 1;
    const int tid = otid(), lane = tid & 63, w = __builtin_amdgcn_readfirstlane(tid >> 6), r16 = lane & 15, q4 = lane >> 4;
    const bf16_t* PROJ = (const bf16_t*)(p.ws + WS_BIG);
    const bf16_t* QKV = (const bf16_t*)(p.ws + WS_SCR);
    const bf16_t* TM = (const bf16_t*)(p.ws + WS_TM) + (size_t)(((dir * 8 + b) * 4 + h) * 132) * 4096;
    bf16_t* OD = (bf16_t*)(p.ws + WS_OFB1) + (size_t)dir * MT * 512 + h * 128 + half * 64;
    LAS float* GA = (LAS float*)(lds + OFF_GA);
    const float* GB = (const float*)(p.ws + WS_WIN0) + (size_t)(((dir * 8 + b) * 4 + h) * 132) * 128;
    const int pk = lane & 15, rk_ = 8 * w + (lane >> 4), pv = lane & 7, rv_ = 8 * w + (lane >> 3);
    f32x4 sacc[4];
#pragma unroll
    for (int k = 0; k < 4; ++k) sacc[k] = (f32x4){0.f, 0.f, 0.f, 0.f};
    __syncthreads();
    for (int k = tid; k < 64 * SQ / 4; k += NTHR) ((LAS unsigned*)(lds + OFF_ST0))[k] = 0u;
    int cur = 0;
    uint4 rk0, rk1, rq0, rq1, rvv; float gtok, btok; bf16x8 tn0, tn1;
    uint4 pk0, pk1, pq0, pq1, pvv; float ptok, pbtk; bf16x8 pt0, pt1;
#define DL_LOAD(XK0, XK1, XQ0, XQ1, XVV, XTOK, XBTK, XT0, XT1, n) do { \
        const size_t R0 = (size_t)b * PB + seq_pp((n) * C + rk_, dir), R1 = (size_t)b * PB + seq_pp((n) * C + rk_ + 4, dir), RV = (size_t)b * PB + seq_pp((n) * C + rv_, dir); \
        XQ0 = *(const uint4*)(QKV + R0 * 1536 + h * 128 + pk * 8); XQ1 = *(const uint4*)(QKV + R1 * 1536 + h * 128 + pk * 8); \
        XK0 = *(const uint4*)(QKV + R0 * 1536 + 512 + h * 128 + pk * 8); XK1 = *(const uint4*)(QKV + R1 * 1536 + 512 + h * 128 + pk * 8); \
        XVV = *(const uint4*)(QKV + RV * 1536 + 1024 + h * 128 + half * 64 + pv * 8); \
        { const float* gb = GB + (size_t)(n) * 128; XTOK = gb[lane]; XBTK = gb[64 + lane]; } \
        { const bf16_t* tp = TM + (size_t)(n) * 4096 + ((w >> 1) * 16 + r16) * 64 + q4 * 8; XT0 = *(const bf16x8*)tp; XT1 = *(const bf16x8*)(tp + 32); } } while (0)
    DL_LOAD(rk0, rk1, rq0, rq1, rvv, gtok, btok, tn0, tn1, 0);
    DL_LOAD(pk0, pk1, pq0, pq1, pvv, ptok, pbtk, pt0, pt1, 1);
    for (int n = 0; n < PB / C; ++n) {
        float egl, eltok; unsigned qg[8];
        const bf16x8 tf0 = tn0, tf1 = tn1;
        {
            const float glast = __shfl(gtok, 63);
            const float gk0 = __shfl(gtok, rk_), gk1 = __shfl(gtok, rk_ + 4), bk0 = __shfl(btok, rk_), bk1 = __shfl(btok, rk_ + 4), bvv = __shfl(btok, rv_);
            egl = fexp(glast); eltok = fexp(glast - gtok);
            if (w == 0) GA[lane] = gtok;
            const float eg0 = fexp(gk0), eg1 = fexp(gk1), nb0 = -bk0 * eg0, nb1 = -bk1 * eg1;
            const int o0 = rk_ * SQ + pk * 16, o1 = (rk_ + 4) * SQ + pk * 16;
            *(LAS u32x4*)(lds + OFF_KR + o0) = (u32x4){rk0.x, rk0.y, rk0.z, rk0.w}; *(LAS u32x4*)(lds + OFF_KR + o1) = (u32x4){rk1.x, rk1.y, rk1.z, rk1.w};
            *(LAS u32x4*)(lds + OFF_QR + o0) = (u32x4){rq0.x, rq0.y, rq0.z, rq0.w}; *(LAS u32x4*)(lds + OFF_QR + o1) = (u32x4){rq1.x, rq1.y, rq1.z, rq1.w};
            const unsigned qw[8] = {rq0.x, rq0.y, rq0.z, rq0.w, rq1.x, rq1.y, rq1.z, rq1.w};
            const unsigned kw[8] = {rk0.x, rk0.y, rk0.z, rk0.w, rk1.x, rk1.y, rk1.z, rk1.w};
            unsigned nkg[8];
#pragma unroll
            for (int e = 0; e < 8; ++e) {
                const float eg = e < 4 ? eg0 : eg1, nbg = e < 4 ? nb0 : nb1;
                qg[e] = pk2(bflo(qw[e]) * eg, bfhi(qw[e]) * eg);
                nkg[e] = pk2(bflo(kw[e]) * nbg, bfhi(kw[e]) * nbg);
            }
            *(LAS u32x4*)(lds + OFF_NKG + o0) = (u32x4){nkg[0], nkg[1], nkg[2], nkg[3]}; *(LAS u32x4*)(lds + OFF_NKG + o1) = (u32x4){nkg[4], nkg[5], nkg[6], nkg[7]};
            *(LAS u32x4*)(lds + OFF_VB + rv_ * S64 + pv * 16) = (u32x4){pk2(bflo(rvv.x) * bvv, bfhi(rvv.x) * bvv), pk2(bflo(rvv.y) * bvv, bfhi(rvv.y) * bvv), pk2(bflo(rvv.z) * bvv, bfhi(rvv.z) * bvv), pk2(bflo(rvv.w) * bvv, bfhi(rvv.w) * bvv)};
        }
        LDS_SYNC();
        *(LAS u32x4*)(lds + OFF_QG + rk_ * SQ + pk * 16) = (u32x4){qg[0], qg[1], qg[2], qg[3]}; *(LAS u32x4*)(lds + OFF_QG + (rk_ + 4) * SQ + pk * 16) = (u32x4){qg[4], qg[5], qg[6], qg[7]};
        {
            const u32x4 ka = *(const LAS u32x4*)(lds + OFF_KR + lane * SQ + w * 32), kb = *(const LAS u32x4*)(lds + OFF_KR + lane * SQ + w * 32 + 16);
            const unsigned kw2[8] = {ka[0], ka[1], ka[2], ka[3], kb[0], kb[1], kb[2], kb[3]};
#pragma unroll
            for (int e = 0; e < 8; ++e) { *(LAS bf16_t*)(lds + OFF_KLT + (16 * w + 2 * e) * S64 + lane * 2) = f2bf(bflo(kw2[e]) * eltok); *(LAS bf16_t*)(lds + OFF_KLT + (16 * w + 2 * e + 1) * S64 + lane * 2) = f2bf(bfhi(kw2[e]) * eltok); }
        }
        rk0 = pk0; rk1 = pk1; rq0 = pq0; rq1 = pq1; rvv = pvv; gtok = ptok; btok = pbtk; tn0 = pt0; tn1 = pt1;
        if (n + 2 < PB / C) DL_LOAD(pk0, pk1, pq0, pq1, pvv, ptok, pbtk, pt0, pt1, n + 2);
        const int stc = cur ? OFF_ST1 : OFF_ST0, stn = cur ? OFF_ST0 : OFF_ST1;
#pragma unroll
        for (int k = 0; k < 2; ++k) {
            const int tile = w + 8 * k, st = tile >> 2, tt = tile & 3;
            f32x4 d = (f32x4){0.f, 0.f, 0.f, 0.f};
            if (st <= tt) d = mma_tile<4>(lds + OFF_KR, SQ, st * 16, lds + OFF_QR, SQ, tt * 16, d, lane);
            const int s0 = st * 16 + 4 * q4, t = tt * 16 + r16;
            const float gt = GA[t]; const f32x4 gs = *(const LAS f32x4*)(GA + s0);
            u32x2 o; o.x = pk2(s0 <= t ? d[0] * fexp(gt - gs[0]) : 0.f, s0 + 1 <= t ? d[1] * fexp(gt - gs[1]) : 0.f);
            o.y = pk2(s0 + 2 <= t ? d[2] * fexp(gt - gs[2]) : 0.f, s0 + 3 <= t ? d[3] * fexp(gt - gs[3]) : 0.f);
            *(LAS u32x2*)(lds + OFF_P2 + t * S64 + s0 * 2) = o;
        }
#pragma unroll
        for (int k = 0; k < 2; ++k) {
            const int st = w >> 1, ct = (w & 1) * 2 + k;
            LAS u32x2* zp = (LAS u32x2*)(lds + OFF_VBT + (ct * 16 + r16) * S64 + (st * 16 + 4 * q4) * 2);
            const LAS unsigned char* vbp = lds + OFF_VB + (st * 16 + 4 * q4) * S64 + (ct * 16 + r16) * 2;
            f32x4 d = (f32x4){bf2f(*(const LAS bf16_t*)vbp), bf2f(*(const LAS bf16_t*)(vbp + S64)), bf2f(*(const LAS bf16_t*)(vbp + 2 * S64)), bf2f(*(const LAS bf16_t*)(vbp + 3 * S64))};
            d = mma_tile<4>(lds + OFF_NKG, SQ, st * 16, lds + stc, SQ, ct * 16, d, lane);
            u32x2 o; o.x = pk2(d[0], d[1]); o.y = pk2(d[2], d[3]);
            *zp = o;
        }
        LDS_SYNC();
#pragma unroll
        for (int k = 0; k < 2; ++k) {
            const int tt = w >> 1, ct = (w & 1) * 2 + k;
            const LAS unsigned char* zb = lds + OFF_VBT + (ct * 16 + r16) * S64 + q4 * 16;
            const bf16x8 b0 = *(const LAS bf16x8*)zb, b1 = *(const LAS bf16x8*)(zb + 64);
            f32x4 d = __builtin_amdgcn_mfma_f32_16x16x32_bf16(tf0, b0, (f32x4){0.f, 0.f, 0.f, 0.f}, 0, 0, 0);
            d = __builtin_amdgcn_mfma_f32_16x16x32_bf16(tf1, b1, d, 0, 0, 0);
            u32x2 o; o.x = pk2(d[0], d[1]); o.y = pk2(d[2], d[3]);
            *(LAS u32x2*)(lds + OFF_VNT + (ct * 16 + r16) * S64 + (tt * 16 + 4 * q4) * 2) = o;
        }
        LDS_SYNC();
        {
            const bool lat = seq_pp(n * C, dir) >= CTX;
            uint4 ov;
            {
                const int tt = w >> 1, cA = 32 * (w & 1) + 8 * (r16 >> 2) + (r16 & 3);
#pragma unroll
                for (int k = 0; k < 2; ++k) {
                    f32x4 d = mma_tile_rows<2>(lds + OFF_VNT, S64, cA + 4 * k, lds + OFF_P2, S64, tt * 16, (f32x4){0.f, 0.f, 0.f, 0.f}, lane);
                    d = mma_tile_rows<4>(lds + stc, SQ, cA + 4 * k, lds + OFF_QG, SQ, tt * 16, d, lane);
                    if (k == 0) { ov.x = pk2(d[0], d[1]); ov.y = pk2(d[2], d[3]); } else { ov.z = pk2(d[0], d[1]); ov.w = pk2(d[2], d[3]); }
                }
                if (lat) { const size_t R = (size_t)b * PB + seq_pp(n * C + tt * 16 + r16, dir); *(uint4*)(OD + R * 512 + 32 * (w & 1) + 8 * q4) = ov; }
            }
#pragma unroll
            for (int ct = 0; ct < 4; ++ct) {
                f32x4 a = sacc[ct]; a[0] *= egl; a[1] *= egl; a[2] *= egl; a[3] *= egl;
                a = mma_tile<2>(lds + OFF_KLT, S64, w * 16, lds + OFF_VNT, S64, ct * 16, a, lane);
                sacc[ct] = a;
                u32x2 o; o.x = pk2(a[0], a[1]); o.y = pk2(a[2], a[3]);
                *(LAS u32x2*)(lds + stn + (ct * 16 + r16) * SQ + (w * 16 + 4 * q4) * 2) = o;
            }
        }
        cur ^= 1;
    }
#undef DL_LOAD
}

__device__ __forceinline__ void ph_prep1(const P& p, int bid, int nb) {
    const int lane = otid() & 63, wv = __builtin_amdgcn_readfirstlane(otid() >> 6);
    bf16_t* PROJ = (bf16_t*)(p.ws + WS_BIG);
    bf16_t* QKV = (bf16_t*)(p.ws + WS_SCR);
    const float* cw = p.in[28];
    const int stride = nb * 8;
    const unsigned lane16 = (unsigned)lane * 16u;
#define P1_LOAD(X, R_) do { int b_, pp_; row_decode((R_), b_, pp_); const int lo_ = pp_ < CTX ? 0 : CTX, hi_ = pp_ < CTX ? CTX : PB; \
        _Pragma("unroll") for (int j = 0; j < 5; ++j) { const int q_ = pp_ + j - 2; const bool ok_ = q_ >= lo_ && q_ < hi_; \
            const unsigned char* rowp_ = (const unsigned char*)(PROJ + (size_t)((R_) + j - 2) * NIN1);        \
            _Pragma("unroll") for (int g = 0; g < 3; ++g) { X[g][j] = make_uint4(0u, 0u, 0u, 0u); if (ok_) X[g][j] = *(const uint4*)(rowp_ + g * 1024 + lane16); } } } while (0)
#define P1_ROW(X, R_) do { const int R = (R_); int b, pp; row_decode(R, b, pp); \
        unsigned rq[6];        \
        if (pp >= CTX) { _Pragma("unroll") for (int k = 0; k < 3; ++k) { const int m = lane + 64 * k; if (m < 160) { const bf16_t* q = PROJ + (size_t)R * NIN1 + 2064 + (m >> 4) * 64 + (m & 15) * 2; \
            rq[2 * k] = *(const unsigned*)q; rq[2 * k + 1] = *(const unsigned*)(q + 32); } } } \
        _Pragma("unroll") for (int g = 0; g < 3; ++g) { \
            const int ch = g * 512 + lane * 8; \
            float a[8]; \
            _Pragma("unroll") for (int e = 0; e < 8; ++e) a[e] = 0.f; \
            _Pragma("unroll") for (int j = 0; j < 5; ++j) { \
                const uint4 xv = X[g][j]; \
                const float4 w0 = *(const float4*)(cw + j * 1536 + ch), w1 = *(const float4*)(cw + j * 1536 + ch + 4); \
                a[0] += w0.x * bflo(xv.x); a[1] += w0.y * bfhi(xv.x); a[2] += w0.z * bflo(xv.y); a[3] += w0.w * bfhi(xv.y); \
                a[4] += w1.x * bflo(xv.z); a[5] += w1.y * bfhi(xv.z); a[6] += w1.z * bflo(xv.w); a[7] += w1.w * bfhi(xv.w); } \
            float ss = 0.f; \
            _Pragma("unroll") for (int e = 0; e < 8; ++e) { a[e] = siluf_(a[e]); ss += a[e] * a[e]; } \
            if (g < 2) { \
                ss += __shfl_xor(ss, 1); ss += __shfl_xor(ss, 2); ss += __shfl_xor(ss, 4); ss += __shfl_xor(ss, 8); \
                const float sc = rsqrtf(ss + EPS) * (g == 0 ? 0.08838834764831845f : 1.f); \
                _Pragma("unroll") for (int e = 0; e < 8; ++e) a[e] *= sc; } \
            uint4 o; o.x = pk2(a[0], a[1]); o.y = pk2(a[2], a[3]); o.z = pk2(a[4], a[5]); o.w = pk2(a[6], a[7]); \
            *(uint4*)(QKV + (size_t)R * 1536 + ch) = o; } \
        if (pp >= CTX) { \
            const int t = pp - CTX; const float rowp = (float)(t >> 6), colp = (float)(t & 63); \
            _Pragma("unroll") for (int k = 0; k < 3; ++k) { \
                const int m = lane + 64 * k; \
                if (m < 160) { \
                    const int hd = m >> 4, f2 = (m & 15) * 2; \
                    const float pos = (f2 < 16 ? rowp : colp) * 0.15915494309189535f; \
                    const float rev0 = pos * __builtin_amdgcn_exp2f(-(float)(f2 & 15) * (13.287712379549449f / 16.f)), rev1 = pos * __builtin_amdgcn_exp2f(-(float)((f2 + 1) & 15) * (13.287712379549449f / 16.f)); \
                    const float sn0 = __builtin_amdgcn_sinf(rev0), cs0 = __builtin_amdgcn_cosf(rev0), sn1 = __builtin_amdgcn_sinf(rev1), cs1 = __builtin_amdgcn_cosf(rev1); \
                    bf16_t* q = PROJ + (size_t)R * NIN1 + 2064 + hd * 64 + f2; \
                    const float x1a = bflo(rq[2 * k]), x1b = bfhi(rq[2 * k]), x2a = bflo(rq[2 * k + 1]), x2b = bfhi(rq[2 * k + 1]); \
                    *(unsigned*)q = pk2(x1a * cs0 - x2a * sn0, x1b * cs1 - x2b * sn1); *(unsigned*)(q + 32) = pk2(x2a * cs0 + x1a * sn0, x2b * cs1 + x1b * sn1); } } } } while (0)
    uint4 xa[3][5], xb[3][5];
    int R0 = bid * 8 + wv;
    if (R0 < MT) P1_LOAD(xa, R0);
#pragma nounroll
    for (; R0 < MT; R0 += 2 * stride) {
        const int R1 = R0 + stride, R2 = R0 + 2 * stride;
        if (R1 < MT) P1_LOAD(xb, R1);
        P1_ROW(xa, R0);
        if (R2 < MT) P1_LOAD(xa, R2);
        if (R1 < MT) P1_ROW(xb, R1);
    }
#undef P1_LOAD
#undef P1_ROW
}

__device__ __forceinline__ void attn_unit(const P& p, int u, float* ldsf) {
    const int b = u >> 7, qb = (u >> 1) & 63, kvh = u & 1;
    const int tid = otid(), g = tid >> 7, qi = tid & 127, hq = kvh * 4 + g;
    const int t0 = qb * 128, t = t0 + qi;
    const bf16_t* PROJ = (const bf16_t*)(p.ws + WS_BIG);
    bf16_t* Y = (bf16_t*)(p.ws + WS_H);
    float* Ks = ldsf; float* Vs = ldsf + 128 * 64;
    const size_t Rq = (size_t)b * PB + CTX + t;
    float q[64], acc[64];
    {
        const uint4* qp = (const uint4*)(PROJ + Rq * NIN1 + 2064 + hq * 64);
#pragma unroll
        for (int i = 0; i < 8; ++i) { const uint4 v = qp[i]; q[i * 8 + 0] = bflo(v.x) * 0.125f; q[i * 8 + 1] = bfhi(v.x) * 0.125f; q[i * 8 + 2] = bflo(v.y) * 0.125f; q[i * 8 + 3] = bfhi(v.y) * 0.125f;
            q[i * 8 + 4] = bflo(v.z) * 0.125f; q[i * 8 + 5] = bfhi(v.z) * 0.125f; q[i * 8 + 6] = bflo(v.w) * 0.125f; q[i * 8 + 7] = bfhi(v.w) * 0.125f; }
    }
#pragma unroll
    for (int d = 0; d < 64; ++d) acc[d] = 0.f;
    float mx = p.in[34][hq], l = 1.f;
    for (int kt = 0; kt < 5; ++kt) {
        const int kbase = t0 - 128 + kt * 128;
        if (kt < 3 && (kbase < 0 || kbase >= SEQ)) continue;
        __syncthreads();
        {
            const int key = tid >> 2, d0 = (tid & 3) * 16;
            const size_t Rk = kt < 3 ? ((size_t)b * PB + CTX + kbase + key) : ((size_t)b * PB + (kt - 3) * 128 + key);
            const uint4* kp = (const uint4*)(PROJ + Rk * NIN1 + 2576 + kvh * 64 + d0);
            const uint4* vp = (const uint4*)(PROJ + Rk * NIN1 + 2704 + kvh * 64 + d0);
#pragma unroll
            for (int i = 0; i < 2; ++i) {
                const uint4 kv = kp[i], vv = vp[i];
                float* kd = Ks + key * 64 + d0 + i * 8; float* vd = Vs + key * 64 + d0 + i * 8;
                kd[0] = bflo(kv.x); kd[1] = bfhi(kv.x); kd[2] = bflo(kv.y); kd[3] = bfhi(kv.y); kd[4] = bflo(kv.z); kd[5] = bfhi(kv.z); kd[6] = bflo(kv.w); kd[7] = bfhi(kv.w);
                vd[0] = bflo(vv.x); vd[1] = bfhi(vv.x); vd[2] = bflo(vv.y); vd[3] = bfhi(vv.y); vd[4] = bflo(vv.z); vd[5] = bfhi(vv.z); vd[6] = bflo(vv.w); vd[7] = bfhi(vv.w);
            }
        }
        __syncthreads();
        for (int j = 0; j < 128; ++j) {
            float s = 0.f;
#pragma unroll
            for (int d4 = 0; d4 < 16; ++d4) { const float4 k4 = *(const float4*)(Ks + j * 64 + d4 * 4); s += q[d4 * 4] * k4.x + q[d4 * 4 + 1] * k4.y + q[d4 * 4 + 2] * k4.z + q[d4 * 4 + 3] * k4.w; }
            bool valid = true;
            if (kt < 3) { const int dk_ = kbase + j - t; valid = (dk_ <= 128) && (dk_ >= -128); }
            if (valid && s > mx) {
                const float corr = __expf(mx - s); l *= corr;
#pragma unroll
                for (int d = 0; d < 64; ++d) acc[d] *= corr;
                mx = s;
            }
            const float pr = valid ? __expf(s - mx) : 0.f;
            l += pr;
#pragma unroll
            for (int d4 = 0; d4 < 16; ++d4) { const float4 v4 = *(const float4*)(Vs + j * 64 + d4 * 4); acc[d4 * 4] += pr * v4.x; acc[d4 * 4 + 1] += pr * v4.y; acc[d4 * 4 + 2] += pr * v4.z; acc[d4 * 4 + 3] += pr * v4.w; }
        }
    }
    const float il = 1.f / l;
    uint4* yp = (uint4*)(Y + Rq * D + 512 + hq * 64);
#pragma unroll
    for (int i = 0; i < 8; ++i) { uint4 o; o.x = pk2(acc[i * 8] * il, acc[i * 8 + 1] * il); o.y = pk2(acc[i * 8 + 2] * il, acc[i * 8 + 3] * il); o.z = pk2(acc[i * 8 + 4] * il, acc[i * 8 + 5] * il); o.w = pk2(acc[i * 8 + 6] * il, acc[i * 8 + 7] * il); yp[i] = o; }
}

__device__ __forceinline__ void attn_unit_mfma(const P& p, int u, LAS unsigned char* lds) {
    constexpr int S64 = 144, OFF_K = 0, OFF_VT = 64 * S64, OFF_P = 2 * 64 * S64;
    const int b = u >> 7, qb = (u >> 1) & 63, kvh = u & 1;
    const int tid = otid(), lane = tid & 63, w = __builtin_amdgcn_readfirstlane(tid >> 6), r16 = lane & 15, q4 = lane >> 4;
    const int hq = kvh * 4 + (w >> 1), t0 = qb * 128, tq0 = t0 + (w & 1) * 64;
    const bf16_t* PROJ = (const bf16_t*)(p.ws + WS_BIG);
    bf16_t* Y = (bf16_t*)(p.ws + WS_H);
    LAS unsigned char* Pw = lds + OFF_P + w * (64 * S64);
    bf16x8 qf[4][2];
#pragma unroll
    for (int qt = 0; qt < 4; ++qt)
#pragma unroll
        for (int kb = 0; kb < 2; ++kb) qf[qt][kb] = *(const bf16x8*)(PROJ + ((size_t)b * PB + CTX + tq0 + qt * 16 + r16) * NIN1 + 2064 + hq * 64 + kb * 32 + q4 * 8);
    f32x4 oacc[4][4];
#pragma unroll
    for (int qt = 0; qt < 4; ++qt)
#pragma unroll
        for (int dt = 0; dt < 4; ++dt) oacc[qt][dt] = (f32x4){0.f, 0.f, 0.f, 0.f};
    constexpr float CS = 0.125f * 1.4426950408889634f;
    float m2[4], lp[4];
#pragma unroll
    for (int qt = 0; qt < 4; ++qt) { m2[qt] = p.in[34][hq] * 1.4426950408889634f; lp[qt] = (q4 == 0) ? 1.f : 0.f; }
    for (int kt = 0; kt < 10; ++kt) {
        const bool local = kt < 6; const int kbase = t0 - 128 + kt * 64;
        if (local && (kbase < 0 || kbase >= SEQ)) continue;
        LDS_SYNC();
        {
            const int key = tid >> 3, d8 = (tid & 7) * 8;
            const size_t Rk = local ? ((size_t)b * PB + CTX + kbase + key) : ((size_t)b * PB + (kt - 6) * 64 + key);
            const uint4 kv = *(const uint4*)(PROJ + Rk * NIN1 + 2576 + kvh * 64 + d8), vv = *(const uint4*)(PROJ + Rk * NIN1 + 2704 + kvh * 64 + d8);
            *(LAS u32x4*)(lds + OFF_K + key * S64 + d8 * 2) = (u32x4){kv.x, kv.y, kv.z, kv.w};
            const unsigned vw[4] = {vv.x, vv.y, vv.z, vv.w};
#pragma unroll
            for (int e = 0; e < 4; ++e) { *(LAS bf16_t*)(lds + OFF_VT + (d8 + 2 * e) * S64 + key * 2) = (bf16_t)(vw[e] & 0xffffu); *(LAS bf16_t*)(lds + OFF_VT + (d8 + 2 * e + 1) * S64 + key * 2) = (bf16_t)(vw[e] >> 16); }
        }
        LDS_SYNC();
        if (local && (kbase + 63 < tq0 - 128 || kbase > tq0 + 63 + 128)) continue;
        f32x4 st[4][4];
#pragma unroll
        for (int k16 = 0; k16 < 4; ++k16) {
            const bf16x8 a0 = *(const LAS bf16x8*)(lds + OFF_K + (k16 * 16 + r16) * S64 + q4 * 16), a1 = *(const LAS bf16x8*)(lds + OFF_K + (k16 * 16 + r16) * S64 + 64 + q4 * 16);
#pragma unroll
            for (int qt = 0; qt < 4; ++qt) {
                f32x4 d = __builtin_amdgcn_mfma_f32_16x16x32_bf16(a0, qf[qt][0], (f32x4){0.f, 0.f, 0.f, 0.f}, 0, 0, 0);
                st[k16][qt] = __builtin_amdgcn_mfma_f32_16x16x32_bf16(a1, qf[qt][1], d, 0, 0, 0);
            }
        }
#pragma unroll
        for (int qt = 0; qt < 4; ++qt) {
            float mx = -3.0e38f;
            if (local) {
                const int tq = tq0 + qt * 16 + r16;
#pragma unroll
                for (int k16 = 0; k16 < 4; ++k16)
#pragma unroll
                    for (int e = 0; e < 4; ++e) { const int dk_ = kbase + k16 * 16 + 4 * q4 + e - tq; if (dk_ > 128 || dk_ < -128) st[k16][qt][e] = -3.0e38f; }
            }
#pragma unroll
            for (int k16 = 0; k16 < 4; ++k16) mx = fmaxf(fmaxf(mx, fmaxf(st[k16][qt][0], st[k16][qt][1])), fmaxf(st[k16][qt][2], st[k16][qt][3]));
            mx = fmaxf(mx, __shfl_xor(mx, 16)); mx = fmaxf(mx, __shfl_xor(mx, 32));
            const float mn = fmaxf(m2[qt], mx * CS), corr = __builtin_amdgcn_exp2f(m2[qt] - mn);
            m2[qt] = mn; lp[qt] *= corr;
#pragma unroll
            for (int dt = 0; dt < 4; ++dt) { oacc[qt][dt][0] *= corr; oacc[qt][dt][1] *= corr; oacc[qt][dt][2] *= corr; oacc[qt][dt][3] *= corr; }
            float ls = 0.f;
#pragma unroll
            for (int k16 = 0; k16 < 4; ++k16) {
                const float p0 = __builtin_amdgcn_exp2f(fmaf(st[k16][qt][0], CS, -mn)), p1 = __builtin_amdgcn_exp2f(fmaf(st[k16][qt][1], CS, -mn)), p2 = __builtin_amdgcn_exp2f(fmaf(st[k16][qt][2], CS, -mn)), p3 = __builtin_amdgcn_exp2f(fmaf(st[k16][qt][3], CS, -mn));
                ls += (p0 + p1) + (p2 + p3);
                u32x2 o; o.x = pk2(p0, p1); o.y = pk2(p2, p3);
                *(LAS u32x2*)(Pw + (qt * 16 + r16) * S64 + (k16 * 16 + 4 * q4) * 2) = o;
            }
            lp[qt] += ls;
        }
        WAVE_FENCE();
#pragma unroll
        for (int kb = 0; kb < 2; ++kb) {
            bf16x8 vf[4];
#pragma unroll
            for (int dt = 0; dt < 4; ++dt) vf[dt] = *(const LAS bf16x8*)(lds + OFF_VT + (dt * 16 + r16) * S64 + kb * 64 + q4 * 16);
#pragma unroll
            for (int qt = 0; qt < 4; ++qt) {
                const bf16x8 pf = *(const LAS bf16x8*)(Pw + (qt * 16 + r16) * S64 + kb * 64 + q4 * 16);
#pragma unroll
                for (int dt = 0; dt < 4; ++dt) oacc[qt][dt] = __builtin_amdgcn_mfma_f32_16x16x32_bf16(vf[dt], pf, oacc[qt][dt], 0, 0, 0);
            }
        }
        WAVE_FENCE();
    }
#pragma unroll
    for (int qt = 0; qt < 4; ++qt) {
        float l = lp[qt]; l += __shfl_xor(l, 16); l += __shfl_xor(l, 32);
        const float il = 1.f / l;
        bf16_t* yp = Y + ((size_t)b * PB + CTX + tq0 + qt * 16 + r16) * D + 512 + hq * 64 + 4 * q4;
#pragma unroll
        for (int dt = 0; dt < 4; ++dt) { uint2 o; o.x = pk2(oacc[qt][dt][0] * il, oacc[qt][dt][1] * il); o.y = pk2(oacc[qt][dt][2] * il, oacc[qt][dt][3] * il); *(uint2*)(yp + dt * 16) = o; }
    }
}

__device__ __forceinline__ void ph_combine0(const P& p, int bid, int nb) {
    const int lane = otid() & 63, wv = otid() >> 6;
    const bf16_t* OF = (const bf16_t*)(p.ws + WS_SCR); const bf16_t* OB = OF + (size_t)MT * D;
    const bf16_t* PROJ = (const bf16_t*)(p.ws + WS_BIG);
    bf16_t* Y = (bf16_t*)(p.ws + WS_H);
    const int c0 = lane * 16, type = c0 >> 9, cc = c0 & 511;
    const float* nw = (type ? p.in[14] : p.in[13]) + (cc & 127);
    const int ogc = (type ? 3616 : 1056) + cc;
    for (int R = bid * 8 + wv; R < MT; R += nb * 8) {
        float o[16];
        const uint4* a = (const uint4*)(OF + (size_t)R * D + c0); const uint4* bq = (const uint4*)(OB + (size_t)R * D + c0);
        float ss = 0.f;
#pragma unroll
        for (int i = 0; i < 2; ++i) { const uint4 x = ntldu4(a + i), y = ntldu4(bq + i);
            o[i * 8 + 0] = bflo(x.x) + bflo(y.x); o[i * 8 + 1] = bfhi(x.x) + bfhi(y.x); o[i * 8 + 2] = bflo(x.y) + bflo(y.y); o[i * 8 + 3] = bfhi(x.y) + bfhi(y.y);
            o[i * 8 + 4] = bflo(x.z) + bflo(y.z); o[i * 8 + 5] = bfhi(x.z) + bfhi(y.z); o[i * 8 + 6] = bflo(x.w) + bflo(y.w); o[i * 8 + 7] = bfhi(x.w) + bfhi(y.w); }
#pragma unroll
        for (int e = 0; e < 16; ++e) ss += o[e] * o[e];
        ss += __shfl_xor(ss, 1); ss += __shfl_xor(ss, 2); ss += __shfl_xor(ss, 4);
        const float rs = rsqrtf(ss * (1.f / 128.f) + EPS);
        const uint4* gp = (const uint4*)(PROJ + (size_t)R * NIN0 + ogc);
        unsigned ow[8];
#pragma unroll
        for (int i = 0; i < 2; ++i) { const uint4 gv = ntldu4(gp + i);
            const float g0 = siluf_(bflo(gv.x)), g1 = siluf_(bfhi(gv.x)), g2 = siluf_(bflo(gv.y)), g3 = siluf_(bfhi(gv.y)), g4 = siluf_(bflo(gv.z)), g5 = siluf_(bfhi(gv.z)), g6 = siluf_(bflo(gv.w)), g7 = siluf_(bfhi(gv.w));
            const float4 w0 = *(const float4*)(nw + i * 8), w1 = *(const float4*)(nw + i * 8 + 4);
            ow[i * 4 + 0] = pk2(o[i * 8 + 0] * rs * w0.x * g0, o[i * 8 + 1] * rs * w0.y * g1); ow[i * 4 + 1] = pk2(o[i * 8 + 2] * rs * w0.z * g2, o[i * 8 + 3] * rs * w0.w * g3);
            ow[i * 4 + 2] = pk2(o[i * 8 + 4] * rs * w1.x * g4, o[i * 8 + 5] * rs * w1.y * g5); ow[i * 4 + 3] = pk2(o[i * 8 + 6] * rs * w1.z * g6, o[i * 8 + 7] * rs * w1.w * g7); }
        uint4* yp = (uint4*)(Y + (size_t)R * D + c0);
        yp[0] = make_uint4(ow[0], ow[1], ow[2], ow[3]); yp[1] = make_uint4(ow[4], ow[5], ow[6], ow[7]);
    }
}
__device__ __forceinline__ void ph_combine1(const P& p, int bid, int nb) {
    const int lane = otid() & 63, wv = otid() >> 6;
    const bf16_t* OF = (const bf16_t*)(p.ws + WS_OFB1); const bf16_t* OB = OF + (size_t)MT * 512;
    const bf16_t* PROJ = (const bf16_t*)(p.ws + WS_BIG);
    bf16_t* Y = (bf16_t*)(p.ws + WS_H);
    const int c0 = lane * 8;
    const float* nw = p.in[33] + (c0 & 127);
    for (int rr = bid * 8 + wv; rr < NB * SEQ; rr += nb * 8) {
        const int b = rr >> 13, t = rr & 8191; const size_t R = (size_t)b * PB + CTX + t;
        const uint4 x = ntldu4(OF + R * 512 + c0), y = ntldu4(OB + R * 512 + c0);
        float o[8];
        o[0] = bflo(x.x) + bflo(y.x); o[1] = bfhi(x.x) + bfhi(y.x); o[2] = bflo(x.y) + bflo(y.y); o[3] = bfhi(x.y) + bfhi(y.y);
        o[4] = bflo(x.z) + bflo(y.z); o[5] = bfhi(x.z) + bfhi(y.z); o[6] = bflo(x.w) + bflo(y.w); o[7] = bfhi(x.w) + bfhi(y.w);
        float ss = 0.f;
#pragma unroll
        for (int e = 0; e < 8; ++e) ss += o[e] * o[e];
        ss += __shfl_xor(ss, 1); ss += __shfl_xor(ss, 2); ss += __shfl_xor(ss, 4); ss += __shfl_xor(ss, 8);
        const float rs = rsqrtf(ss * (1.f / 128.f) + EPS);
        const uint4 gv = ntldu4(PROJ + R * NIN1 + 1552 + c0);
        const float4 w0 = *(const float4*)(nw), w1 = *(const float4*)(nw + 4);
        uint4 ov;
        ov.x = pk2(o[0] * rs * w0.x * siluf_(bflo(gv.x)), o[1] * rs * w0.y * siluf_(bfhi(gv.x))); ov.y = pk2(o[2] * rs * w0.z * siluf_(bflo(gv.y)), o[3] * rs * w0.w * siluf_(bfhi(gv.y)));
        ov.z = pk2(o[4] * rs * w1.x * siluf_(bflo(gv.z)), o[5] * rs * w1.y * siluf_(bfhi(gv.z))); ov.w = pk2(o[6] * rs * w1.z * siluf_(bflo(gv.w)), o[7] * rs * w1.w * siluf_(bfhi(gv.w)));
        *(uint4*)(Y + R * D + c0) = ov;
    }
}

__device__ __forceinline__ void ph_route(const P& p, int layer, LAS unsigned char* lds, int bid, int nb) {
    const int tid = otid(), lane = tid & 63, wv = __builtin_amdgcn_readfirstlane(tid >> 6);
    const int c = lane & 15, q = lane >> 4, e = lane & 31, half = lane >> 5;
    const float* MOD = (const float*)(p.ws + WS_MOD);
    const float* nw = (layer ? p.in[35] : p.in[16]);
    const float* rw = (layer ? p.in[36] : p.in[17]); const float* rb = (layer ? p.in[37] : p.in[18]);
    bf16_t* H = (bf16_t*)(p.ws + WS_H);
    int* cnt = (int*)(p.ws + WS_CNT) + layer * 4096;
    int* TOK = (int*)(p.ws + WS_TOK); float* GATE = (float*)(p.ws + WS_GATE);
    constexpr int RS = 2064, OFF_LO = 16 * RS, OFF_PART = 32 * RS;
    bf16x8 bh[4][2], bl[4][2];
#pragma unroll
    for (int s = 0; s < 4; ++s)
#pragma unroll
        for (int nt = 0; nt < 2; ++nt) {
            const float* wp = rw + (size_t)(wv * 128 + s * 32 + 8 * q) * 32 + nt * 16 + c;
            unsigned hh[4], ll[4];
#pragma unroll
            for (int j = 0; j < 4; ++j) { const float w0 = wp[(2 * j) * 32], w1 = wp[(2 * j + 1) * 32]; hh[j] = pk2(w0, w1); ll[j] = pk2(w0 - bflo(hh[j]), w1 - bfhi(hh[j])); }
            const u32x4 hv = {hh[0], hh[1], hh[2], hh[3]}, lv = {ll[0], ll[1], ll[2], ll[3]};
            bh[s][nt] = __builtin_bit_cast(bf16x8, hv); bl[s][nt] = __builtin_bit_cast(bf16x8, lv);
        }
    const float rbe = rb[e];
    const int ngroups = layer ? (NB * SEQ / 16) : (MT / 16);
#define RT_ROW(gi_, t_) (layer ? ((((gi_) * 16 + wv * 2 + (t_)) >> 13) * PB + CTX + (((gi_) * 16 + wv * 2 + (t_)) & 8191)) : ((gi_) * 16 + wv * 2 + (t_)))
#define RT_LOAD(gi_) do { _Pragma("unroll") for (int t = 0; t < 2; ++t) { int b_, pp_; row_decode(RT_ROW(gi_, t), b_, pp_); const float* src_ = stream_row(p, 1, b_, pp_); \
        _Pragma("unroll") for (int i = 0; i < 4; ++i) xr[t][i] = ntld4(src_ + i * 256 + lane * 4); } } while (0)
    float4 xr[2][4];
    int gi = bid;
    if (gi < ngroups) RT_LOAD(gi);
    int pgrp = 0, pR = 0, pslot = 0, have = 0; float pwk = 0.f;
    LAS float* part = (LAS float*)(lds + OFF_PART);
#pragma nounroll
    for (; gi < ngroups; gi += nb) {
#pragma unroll
        for (int t = 0; t < 2; ++t) {
            const int R = RT_ROW(gi, t); int b, pp; row_decode(R, b, pp);
            const float* m = MOD + (size_t)(layer * 9 + (pp < CTX ? 8 : b)) * 6144 + 3072;
            float ss = 0.f;
#pragma unroll
            for (int i = 0; i < 4; ++i) ss += xr[t][i].x * xr[t][i].x + xr[t][i].y * xr[t][i].y + xr[t][i].z * xr[t][i].z + xr[t][i].w * xr[t][i].w;
            ss = wave_sum(ss);
            const float rs = rsqrtf(ss * (1.f / 1024.f) + EPS);
#pragma unroll
            for (int i = 0; i < 4; ++i) {
                const float4 w = *(const float4*)(nw + i * 256 + lane * 4), sh = *(const float4*)(m + i * 256 + lane * 4), sc = *(const float4*)(m + 1024 + i * 256 + lane * 4);
                const float v0 = xr[t][i].x * rs * w.x * (1.f + sc.x) + sh.x, v1 = xr[t][i].y * rs * w.y * (1.f + sc.y) + sh.y;
                const float v2 = xr[t][i].z * rs * w.z * (1.f + sc.z) + sh.z, v3 = xr[t][i].w * rs * w.w * (1.f + sc.w) + sh.w;
                const unsigned h0 = pk2(v0, v1), h1 = pk2(v2, v3);
                const unsigned l0 = pk2(v0 - bflo(h0), v1 - bfhi(h0)), l1 = pk2(v2 - bflo(h1), v3 - bfhi(h1));
                uint2 o; o.x = h0; o.y = h1; *(uint2*)(H + (size_t)R * D + i * 256 + lane * 4) = o;
                const u32x2 hv = {h0, h1}, lv = {l0, l1};
                *(LAS u32x2*)(lds + (wv * 2 + t) * RS + (i * 256 + lane * 4) * 2) = hv;
                *(LAS u32x2*)(lds + OFF_LO + (wv * 2 + t) * RS + (i * 256 + lane * 4) * 2) = lv;
            }
        }
        { const int gn = gi + nb; if (gn < ngroups) RT_LOAD(gn); }
        if (have && e < 4) { TOK[(size_t)pgrp * MT + pslot] = pR; GATE[(size_t)pgrp * MT + pslot] = pwk; }
        LDS_SYNC();
        {
            f32x4 a0 = {0.f, 0.f, 0.f, 0.f}, a1 = {0.f, 0.f, 0.f, 0.f};
#pragma unroll
            for (int s = 0; s < 4; ++s) {
                const int off = c * RS + (wv * 128 + s * 32 + 8 * q) * 2;
                const bf16x8 ah = *(const LAS bf16x8*)(lds + off), al = *(const LAS bf16x8*)(lds + OFF_LO + off);
                a0 = __builtin_amdgcn_mfma_f32_16x16x32_bf16(al, bh[s][0], a0, 0, 0, 0); a0 = __builtin_amdgcn_mfma_f32_16x16x32_bf16(ah, bl[s][0], a0, 0, 0, 0); a0 = __builtin_amdgcn_mfma_f32_16x16x32_bf16(ah, bh[s][0], a0, 0, 0, 0);
                a1 = __builtin_amdgcn_mfma_f32_16x16x32_bf16(al, bh[s][1], a1, 0, 0, 0); a1 = __builtin_amdgcn_mfma_f32_16x16x32_bf16(ah, bl[s][1], a1, 0, 0, 0); a1 = __builtin_amdgcn_mfma_f32_16x16x32_bf16(ah, bh[s][1], a1, 0, 0, 0);
            }
#pragma unroll
            for (int r = 0; r < 4; ++r) { part[(wv * 16 + 4 * q + r) * 32 + c] = a0[r]; part[(wv * 16 + 4 * q + r) * 32 + 16 + c] = a1[r]; }
        }
        LDS_SYNC();
        {
            const int tok = wv * 2 + half;
            float lg = rbe;
#pragma unroll
            for (int s = 0; s < 8; ++s) lg += part[(s * 16 + tok) * 32 + e];
            float tv[4]; int ti[4];
#pragma unroll
            for (int k = 0; k < 4; ++k) {
                float bv = lg; int bi = e;
#pragma unroll
                for (int o = 16; o > 0; o >>= 1) { const float ov = __shfl_xor(bv, o); const int oi = __shfl_xor(bi, o); if (ov > bv || (ov == bv && oi < bi)) { bv = ov; bi = oi; } }
                tv[k] = bv; ti[k] = bi;
                if (e == bi) lg = -3.0e38f;
            }
            if (e < 4) {
                const float m0 = tv[0];
                const float e0 = 1.f, e1 = __expf(tv[1] - m0), e2 = __expf(tv[2] - m0), e3 = __expf(tv[3] - m0);
                const float inv = 1.f / (e0 + e1 + e2 + e3);
                pwk = (e == 0 ? e0 : e == 1 ? e1 : e == 2 ? e2 : e3) * inv;
                const int ek = e == 0 ? ti[0] : e == 1 ? ti[1] : e == 2 ? ti[2] : ti[3];
                pgrp = e * NE + ek;
                pslot = atomicAdd(&cnt[pgrp * 32], 1);
                pR = RT_ROW(gi, half);
            }
            have = 1;
        }
    }
    if (have && e < 4) { TOK[(size_t)pgrp * MT + pslot] = pR; GATE[(size_t)pgrp * MT + pslot] = pwk; }
#undef RT_ROW
#undef RT_LOAD
}

constexpr int NG = 4 * NE;
__device__ __forceinline__ void moe_table(const P& p, int layer, LAS int* tab) {
    __syncthreads();
    if (otid() < 64) {
        const int* cnt = (const int*)(p.ws + WS_CNT) + layer * 4096;
        const int lane = otid();
        const int c0 = __hip_atomic_load(&cnt[(2 * lane) * 32], __ATOMIC_RELAXED, __HIP_MEMORY_SCOPE_AGENT), c1 = __hip_atomic_load(&cnt[(2 * lane + 1) * 32], __ATOMIC_RELAXED, __HIP_MEMORY_SCOPE_AGENT);
        const int t0 = (c0 + 255) >> 8, t1 = (c1 + 255) >> 8;
        int incl = t0 + t1;
#pragma unroll
        for (int o = 1; o < 64; o <<= 1) { const int t = __shfl_up(incl, o); if (lane >= o) incl += t; }
        const int excl = incl - (t0 + t1);
        tab[2 * lane] = excl; tab[2 * lane + 1] = excl + t0; tab[NG + 1 + 2 * lane] = c0; tab[NG + 1 + 2 * lane + 1] = c1;
        if (lane == 63) tab[NG] = incl;
    }
    __syncthreads();
}
__device__ __forceinline__ int moe_find(LAS const int* tab, int rt) {
    const int lane = otid() & 63;
    const unsigned long long b0 = __builtin_amdgcn_ballot_w64(tab[1 + lane] <= rt);
    const unsigned long long b1 = __builtin_amdgcn_ballot_w64(lane < 63 && tab[65 + lane] <= rt);
    return __builtin_popcountll(b0) + __builtin_popcountll(b1); }

struct EpiUp {
    static constexpr bool ACT = true;
    __device__ __forceinline__ bool is_full() const { return true; }
    typedef EpiNoPre Pre;
    __device__ __forceinline__ void prefetch(int, int, int, Pre&) const {}
    bf16_t* abuf; const float* bup; int arow0  , pn;
    __device__ __forceinline__ f32x4 act(const f32x4 gl, const f32x4 li, int c) const {
        const int gc = pn * 128 + c;
        const f32x4 bg = *(const f32x4*)(bup + gc), bl = *(const f32x4*)(bup + 1024 + gc);
        f32x4 r;
#pragma unroll
        for (int h2 = 0; h2 < 2; ++h2) {
            f32x2 g = (f32x2){gl[2 * h2], gl[2 * h2 + 1]} + (f32x2){bg[2 * h2], bg[2 * h2 + 1]};
            f32x2 l = (f32x2){li[2 * h2], li[2 * h2 + 1]} + (f32x2){bl[2 * h2], bl[2 * h2 + 1]};
            g[0] = fminf(g[0], 7.f); g[1] = fminf(g[1], 7.f);
            l[0] = __builtin_amdgcn_fmed3f(l[0], -7.f, 7.f); l[1] = __builtin_amdgcn_fmed3f(l[1], -7.f, 7.f);
            const f32x2 t = g * (f32x2){-1.702f * 1.4426950408889634f, -1.702f * 1.4426950408889634f};
            f32x2 e = (f32x2){__builtin_amdgcn_exp2f(t[0]), __builtin_amdgcn_exp2f(t[1])};
            e = e + (f32x2){1.f, 1.f};
            const f32x2 s = g * (f32x2){__builtin_amdgcn_rcpf(e[0]), __builtin_amdgcn_rcpf(e[1])};
            const f32x2 o = __builtin_elementwise_fma(l, s, s);
            r[2 * h2] = o[0]; r[2 * h2 + 1] = o[1];
        }
        return r;
    }
    __device__ __forceinline__ void row(int r, int c8, const u32x4 v) const {
        __builtin_nontemporal_store(v, (u32x4*)(abuf + (size_t)(arow0 + r) * DFF + pn * 128 + c8));
    }
};

__device__ __forceinline__ void ph_moe_up(const P& p, int layer, LAS unsigned char* lds, int bid, int nb) {
    LAS int* tab = (LAS int*)(lds + LDS_CTL + 64);
    moe_table(p, layer, tab);
    const int ntiles = tab[NG];
    const int* TOK = (const int*)(p.ws + WS_TOK);
    const unsigned char* A = p.ws + WS_H;
#define UP_FETCH(it_, ok_, rtg_, pn_, e_, q00, q01, q10, q11) do { \
        ok_ = unit_map(it_, bid, nb, ntiles, 8, rtg_, pn_); q00 = q01 = q10 = q11 = 0u; e_ = 0; \
        if (ok_) { const int g_ = moe_find(tab, rtg_), rt_ = rtg_ - tab[g_], c_ = tab[NG + 1 + g_]; e_ = g_ & (NE - 1); \
            int R0_, C0_, R1_, C1_; g8::stage_rc(otid() * 16, R0_, C0_); g8::stage_rc(otid() * 16 + 8192, R1_, C1_); \
            const int* tk_ = TOK + (size_t)g_ * MT + rt_ * 256; \
            if (rt_ * 256 + R0_ < c_) q00 = (unsigned)tk_[R0_]; if (rt_ * 256 + R1_ < c_) q01 = (unsigned)tk_[R1_]; \
            if (rt_ * 256 + 128 + R0_ < c_) q10 = (unsigned)tk_[128 + R0_]; if (rt_ * 256 + 128 + R1_ < c_) q11 = (unsigned)tk_[128 + R1_]; } } while (0)
    bool ok, okn; int rtg, pn, e, rtgn, pnn, en; unsigned t00, t01, t10, t11, n00, n01, n10, n11;
    UP_FETCH(0, ok, rtg, pn, e, t00, t01, t10, t11);
#pragma nounroll
    for (int it = 0; ok; ++it) {
        UP_FETCH(it + 1, okn, rtgn, pnn, en, n00, n01, n10, n11);
        int R0, C0, R1, C1; g8::stage_rc(otid() * 16, R0, C0); g8::stage_rc(otid() * 16 + 8192, R1, C1);
        EpiUp E{(bf16_t*)(p.ws + WS_BIG), (layer ? p.in[39] : p.in[20]) + (size_t)e * 2048, rtg * 256, pn};
        gemm_unit(lds, A, t00 * 2048u + C0 * 2u, t01 * 2048u + C1 * 2u, t10 * 2048u + C0 * 2u, t11 * 2048u + C1 * 2u,
                  p.ws + WS_WUP + ((size_t)e * 2048 + pn * 256) * 2048, E);
        ok = okn; rtg = rtgn; pn = pnn; e = en; t00 = n00; t01 = n01; t10 = n10; t11 = n11;
    }
#undef UP_FETCH
}

struct PreDown { uint2 x[8]; float4 g[8]; int R[8]; float gate[8]; };
struct EpiDown {
    static constexpr bool ACT = false;
    __device__ __forceinline__ bool is_full() const { return !(ks & 8); }
    typedef PreDown Pre;
    const P* p; int layer, ks; const float* bdn; int col0;
    int tkv; float gatev;
    __device__ __forceinline__ void load8(int ai, int w2, int lane, int i0, Pre& pre) const {
        const bf16_t* Z = (const bf16_t*)(p->ws + WS_H);
#pragma unroll
        for (int i = 0; i < 8; ++i) {
            pre.R[i] = __builtin_amdgcn_readlane(tkv, ai * 16 + i0 + i); pre.gate[i] = __int_as_float(__builtin_amdgcn_readlane(__float_as_int(gatev), ai * 16 + i0 + i));
            const int Rc = pre.R[i] < 0 ? 0 : pre.R[i];
            int b, pp; row_decode(Rc, b, pp);
            pre.g[i] = *(const float4*)((const float*)(p->ws + WS_MOD) + (size_t)(layer * 9 + (pp < CTX ? 8 : b)) * 6144 + 5120 + col0 + lane * 4);
            if ((ks & 7) > 0) pre.x[i] = *(const uint2*)(Z + (size_t)Rc * D + col0 + lane * 4);
        }
    }
    __device__ __forceinline__ void store8(int ai, int w2, int lane, int i0, const LAS float* stg, const Pre& pre, const float4 bb) const {
        bf16_t* Z = (bf16_t*)(p->ws + WS_H);
#pragma unroll
        for (int i = 0; i < 8; ++i) {
            if (pre.R[i] >= 0) {
                const f32x4 a = *(const LAS f32x4*)(stg + (w2 * 16 + i0 + i) * 260 + lane * 4);
                const float4 gg = pre.g[i]; const float gate = pre.gate[i];
                float4 x = make_float4(0.f, 0.f, 0.f, 0.f);
                if ((ks & 7) > 0) { x.x = bflo(pre.x[i].x); x.y = bfhi(pre.x[i].x); x.z = bflo(pre.x[i].y); x.w = bfhi(pre.x[i].y); }
                x.x += gate * gg.x * (a[0] + bb.x); x.y += gate * gg.y * (a[1] + bb.y); x.z += gate * gg.z * (a[2] + bb.z); x.w += gate * gg.w * (a[3] + bb.w);
                uint2 o; o.x = pk2(x.x, x.y); o.y = pk2(x.z, x.w);
                *(uint2*)(Z + (size_t)pre.R[i] * D + col0 + lane * 4) = o;
            }
        }
    }
    __device__ __forceinline__ void prefetch(int ai, int w2, int lane, Pre& pre) const { load8(ai, w2, lane, 0, pre); }
    __device__ __forceinline__ void rows(int ai, int w2, int lane, const LAS float* stg, Pre& pre) const {
        const float4 bb = *(const float4*)(bdn + col0 + lane * 4);
        store8(ai, w2, lane, 0, stg, pre, bb);
        load8(ai, w2, lane, 8, pre);
        store8(ai, w2, lane, 8, stg, pre, bb);
    }
};

__device__ __forceinline__ void ph_moe_down(const P& p, int layer, int ks, LAS unsigned char* lds, int bid, int nb) {
    LAS int* tab = (LAS int*)(lds + LDS_CTL + 64);
    const int tile0 = tab[ks * NE], ntiles = tab[(ks + 1) * NE] - tile0;
    const unsigned char* A = p.ws + WS_BIG;
    const int U = ntiles * 4, rfull = U / nb, urem = U - rfull * nb;
    const bool split = ((nb & 7) == 0) && urem > 0 && urem * 2 <= nb;
#pragma nounroll
    for (int it = 0;; ++it) {
        int rtl, pn, hoff = 0; bool full = true;
        if (split && it == rfull) {
            const int hidx = (bid & 7) * (nb >> 3) + (bid >> 3);
            if (hidx >= 2 * urem) break;
            hoff = hidx & 1; full = false;
            unit_decode(rfull * nb + (hidx >> 1), ntiles, 4, rtl, pn);
        } else if (!unit_map(it, bid, nb, ntiles, 4, rtl, pn)) break;
        const int rtg = tile0 + rtl;
        const int g = moe_find(tab, rtg), e = g & (NE - 1), rt = rtg - tab[g], c = tab[NG + 1 + g];
        unsigned a00, a01, a10, a11; a_offsets_plain((unsigned)rtg * 256u + (unsigned)hoff * 128u, a00, a01, a10, a11);
        int tkv = -1; float gatev = 0.f;
        { const int l2 = otid() & 63, w2 = __builtin_amdgcn_readfirstlane(otid() >> 6);
          const int slot = rt * 256 + (((l2 >> 4) & 1) + hoff) * 128 + w2 * 16 + (l2 & 15);
          if (l2 < 32 && slot < c) { tkv = ((const int*)(p.ws + WS_TOK) + (size_t)g * MT)[slot]; gatev = ((const float*)(p.ws + WS_GATE) + (size_t)g * MT)[slot]; } }
        EpiDown E{&p, layer, ks | (full ? 0 : 8), (layer ? p.in[41] : p.in[22]) + (size_t)e * 1024, pn * 256, tkv, gatev};
        gemm_unit(lds, A, a00, a01, a10, a11, p.ws + WS_WDN + ((size_t)e * 1024 + pn * 256) * 2048, E);
    }
}

__device__ __forceinline__ void ph_final(const P& p, int bid, int nb) {
    const int lane = otid() & 63, wv = otid() >> 6;
    const float* nw = p.in[42];
    for (int r = bid * 8 + wv; r < NB * SEQ; r += nb * 8) {
        float* row = p.out + (size_t)r * D;
        float4 x[4]; float ss = 0.f;
#pragma unroll
        for (int i = 0; i < 4; ++i) { x[i] = ntld4(row + i * 256 + lane * 4);
            const uint2 z = ntldu2((const bf16_t*)(p.ws + WS_H) + ((size_t)(r >> 13) * PB + CTX + (r & 8191)) * D + i * 256 + lane * 4);
            x[i].x += bflo(z.x); x[i].y += bfhi(z.x); x[i].z += bflo(z.y); x[i].w += bfhi(z.y);
            ss += x[i].x * x[i].x + x[i].y * x[i].y + x[i].z * x[i].z + x[i].w * x[i].w; }
        ss = wave_sum(ss);
        const float rs = rsqrtf(ss * (1.f / 1024.f) + EPS);
#pragma unroll
        for (int i = 0; i < 4; ++i) { const float4 w = *(const float4*)(nw + i * 256 + lane * 4); float4 o; o.x = x[i].x * rs * w.x; o.y = x[i].y * rs * w.y; o.z = x[i].z * rs * w.z; o.w = x[i].w * rs * w.w; *(float4*)(row + i * 256 + lane * 4) = o; }
    }
}

constexpr int N_PHASES = 20;

__global__ void __launch_bounds__(NTHR, 2) mk_fwd(P p) {
    extern __shared__ __attribute__((aligned(16))) unsigned char lds_raw[];
    LAS unsigned char* lds = (LAS unsigned char*)lds_raw;
    float* ldsf = (float*)lds_raw;
    const int bid = blockIdx.x, nb = gridDim.x;
    volatile LAS unsigned* xbw = (volatile LAS unsigned*)(lds + LDS_CTL);
    if (threadIdx.x < 16) xbw[threadIdx.x] = 0u;
    __syncthreads();
#if MK_PER_PHASE
    XcdBarrier bar; bar.bar = nullptr; bar.x = 0; bar.st = nullptr;
#define GRID_BAR() do { } while (0)
#else
    XcdBarrier bar = xcd_barrier_post((unsigned*)(p.ws + WS_CTL), xbw);
#define GRID_BAR() xcd_barrier(bar)
#endif
    const int lo = p.ph_lo, hi = p.ph_hi;
#define IN(k) (lo <= (k) && (k) < hi)
#define SEAM(k) do { if (IN((k) + 1)) GRID_BAR(); } while (0)

    if (IN(0)) { { ph0_mod(p, ldsf, bid, nb); ph0_convert(p, ldsf, bid, nb); } SEAM(0); }
    if (IN(1)) { ph_norm1(p, 0, bid, nb); SEAM(1); }
    if (IN(2)) { ph_inproj(p, 0, lds, bid, nb); SEAM(2); }
    if (IN(3)) {
        for (int u = bid; u < 256; u += nb) { const int i7 = u & 127, ix = ((i7 >> 4) << 4) | ((i7 & 7) << 1) | ((i7 >> 3) & 1);
            if (u < 128) scan_l0_chunked<0>(p, ix, lds); else scan_l0_chunked<1>(p, ix, lds); } SEAM(3); }
    if (IN(4)) { ph_combine0(p, bid, nb); SEAM(4); }
    if (IN(5)) { ph_outproj(p, 0, lds, bid, nb); ph_convert_moe(p, 0, ldsf, bid, nb, 32); SEAM(5); }
    if (IN(6)) { ph_route(p, 0, lds, bid, nb); SEAM(6); }
    if (IN(7)) { ph_moe_up(p, 0, lds, bid, nb); SEAM(7); }
    if (IN(8)) {
#pragma nounroll
        for (int ks = 0; ks < 4; ++ks) { ph_moe_down(p, 0, ks, lds, bid, nb); if (ks < 3 || IN(9)) GRID_BAR(); }
    }
    if (IN(9)) { ph_norm1(p, 1, bid, nb); SEAM(9); }
    if (IN(10)) { ph_inproj(p, 1, lds, bid, nb); SEAM(10); }
    if (IN(11)) { ph_prep1(p, bid, nb); SEAM(11); }
    if (IN(12)) {
        ph_delta_T(p, lds, bid, nb);
        SEAM(12); }
    if (IN(13)) {
        if (nb >= 256) { if (bid < 128) scan_delta_chunked(p, ((bid >> 4) << 4) | ((bid & 7) << 1) | ((bid >> 3) & 1), lds); else for (int u = bid - 128; u < 1024; u += nb - 128) attn_unit_mfma(p, u, lds); }
        else for (int u = bid; u < 128 + 1024; u += nb) { if (u < 128) scan_delta_chunked(p, u, lds); else attn_unit_mfma(p, u - 128, lds); }
        SEAM(13);
    }
    if (IN(14)) { ph_combine1(p, bid, nb); SEAM(14); }
    if (IN(15)) { ph_outproj(p, 1, lds, bid, nb); ph_convert_moe(p, 1, ldsf, bid, nb, 0); SEAM(15); }
    if (IN(16)) { ph_route(p, 1, lds, bid, nb); SEAM(16); }
    if (IN(17)) { ph_moe_up(p, 1, lds, bid, nb); SEAM(17); }
    if (IN(18)) {
#pragma nounroll
        for (int ks = 0; ks < 4; ++ks) { ph_moe_down(p, 1, ks, lds, bid, nb); if (ks < 3 || IN(19)) GRID_BAR(); }
    }
    if (IN(19)) { ph_final(p, bid, nb); }
#undef IN
#undef SEAM
}

extern "C" void kernel_launch(void* const* d_in, const int* in_sizes, int n_in, void* d_out, int out_size, void* d_ws, size_t ws_size, hipStream_t stream) {
    static int grid = 0;
    if (grid == 0) {
        if (n_in != 43 || out_size != NB * SEQ * D || ws_size < WS_END) { fprintf(stderr, "kernel_launch: unexpected problem (n_in %d out %d ws %zu need %zu)\n", n_in, out_size, ws_size, (size_t)WS_END); grid = -1; return; }
        int dev = 0, cus = 0, per_cu = 0;
        if (hipGetDevice(&dev) != hipSuccess || hipDeviceGetAttribute(&cus, hipDeviceAttributeMultiprocessorCount, dev) != hipSuccess) { grid = -1; return; }
        if (hipFuncSetAttribute((const void*)mk_fwd, hipFuncAttributeMaxDynamicSharedMemorySize, LDS_BYTES) != hipSuccess) { fprintf(stderr, "kernel_launch: hipFuncSetAttribute failed\n"); grid = -1; return; }
        if (hipOccupancyMaxActiveBlocksPerMultiprocessor(&per_cu, (const void*)mk_fwd, NTHR, LDS_BYTES) != hipSuccess || per_cu < 1) { fprintf(stderr, "kernel_launch: occupancy query says %d\n", per_cu); }
        (void)hipGetLastError();
        grid = cus;
    }
    if (grid < 0) return;
    (void)hipMemsetAsync(d_ws, 0, WS_ZERO_BYTES, stream);
    P prm;
    memset(&prm, 0, sizeof(prm));
    for (int i = 0; i < 43; ++i) prm.in[i] = (const float*)d_in[i];
    prm.out = (float*)d_out; prm.ws = (unsigned char*)d_ws;
#if MK_PER_PHASE
    for (int ph = 0; ph < N_PHASES; ++ph) { prm.ph_lo = ph; prm.ph_hi = ph + 1; hipLaunchKernelGGL(mk_fwd, dim3(grid), dim3(NTHR), LDS_BYTES, stream, prm); }
#else
    prm.ph_lo = 0; prm.ph_hi = N_PHASES; prm.dupa = PROBE_DUPA; prm.dupb = PROBE_DUPB;
    hipLaunchKernelGGL(mk_fwd, dim3(grid), dim3(NTHR), LDS_BYTES, stream, prm);
#endif
}
```
